# Optimizing an MI355X kernel written in HIP

```python
import math
import jax, jax.numpy as jnp
from jax import lax
import numpy as np

D_MODEL = 1024
BATCH = 2
SEQ = 16384
DEPTH = 1
DEC_BATCH = 32
DEC_SEQ = 32
PAST_LEN = 4096

CHUNK = 64
SSD_EXPAND = 2
SSD_INNER = SSD_EXPAND * D_MODEL
SSD_HEAD_DIM = 64
SSD_HEADS = SSD_INNER // SSD_HEAD_DIM
SSD_GROUPS = 4
D_STATE = 128
CONV_W = 4
CONV_DIM = SSD_INNER + 2 * SSD_GROUPS * D_STATE
SSD_BLOCK = 64
N_HEADS = 16
N_KV_HEADS = 4
HEAD_DIM = 64
IDX_HEADS = 8
IDX_DIM = 64
TOPK_MAX = 256
QUERY_BLOCK = 128
REL_BUCKETS = 32
REL_MAX_DIST = 128
D_FF = 4 * D_MODEL
ALPHA = (2.0 * DEPTH) ** 0.25
BETA = (8.0 * DEPTH) ** -0.25
LN_EPS = 1e-5
RMS_EPS = 1e-5
IN_SIZES = (SSD_INNER, CONV_DIM, SSD_HEADS,
            N_HEADS * HEAD_DIM, N_KV_HEADS * HEAD_DIM, N_KV_HEADS * HEAD_DIM,
            IDX_HEADS * IDX_DIM, IDX_DIM, IDX_HEADS,
            D_MODEL, D_MODEL)
IN_WIDTH = sum(IN_SIZES)
IN_SPLITS = tuple(int(v) for v in np.cumsum(IN_SIZES)[:-1])

kernel_name = 'hybrid_ssd_dsa_stream_step'


def layer_norm(x, g, b):
    xf = x.astype(jnp.float32)
    mu = jnp.mean(xf, axis=-1, keepdims=True)
    xc = xf - mu
    var = jnp.mean(xc * xc, axis=-1, keepdims=True)
    return (xc * lax.rsqrt(var + LN_EPS) * g.astype(jnp.float32) + b.astype(jnp.float32)).astype(x.dtype)


def gated_rmsnorm(y, z, w):
    h = (y * jax.nn.silu(z)).astype(jnp.float32)
    hg = h.reshape(h.shape[:-1] + (SSD_GROUPS, SSD_INNER // SSD_GROUPS))
    hg = hg * lax.rsqrt(jnp.mean(hg * hg, axis=-1, keepdims=True) + RMS_EPS)
    return (hg.reshape(h.shape) * w.astype(jnp.float32)).astype(y.dtype)


def t5_bucket(rel):
    half = REL_BUCKETS // 2
    max_exact = half // 2
    n = jnp.abs(rel)
    large = max_exact + (jnp.log(jnp.maximum(n, max_exact).astype(jnp.float32) / max_exact)
                         / math.log(REL_MAX_DIST / max_exact) * (half - max_exact)).astype(jnp.int32)
    large = jnp.minimum(large, half - 1)
    return jnp.where(rel > 0, half, 0) + jnp.where(n < max_exact, n, large)


def ssd_scan(x, dt, A, Bm, Cm, h0):
    b, l, h, p = x.shape
    g, n = Bm.shape[2], Bm.shape[3]
    r = h // g
    q = SSD_BLOCK
    pad = (-l) % q
    def padt(t):
        return jnp.pad(t, [(0, 0), (0, pad)] + [(0, 0)] * (t.ndim - 2))
    x, dt, Bm, Cm = padt(x), padt(dt), padt(Bm), padt(Cm)
    nc = (l + pad) // q
    xc = x.reshape(b, nc, q, g, r, p)
    dtc = dt.reshape(b, nc, q, g, r).astype(jnp.float32)
    Bc = Bm.reshape(b, nc, q, g, n)
    Cc = Cm.reshape(b, nc, q, g, n)
    a = dtc * A.reshape(g, r).astype(jnp.float32)
    acum = jnp.cumsum(a, axis=2)
    at = jnp.moveaxis(acum, 2, -1)
    seg = at[..., :, None] - at[..., None, :]
    causal = jnp.tril(jnp.ones((q, q), dtype=bool))
    decay = jnp.exp(jnp.where(causal, seg, -jnp.inf))
    cb = jnp.einsum('bcqgn,bcsgn->bcgqs', Cc, Bc).astype(jnp.float32)
    m = cb[:, :, :, None] * decay * jnp.moveaxis(dtc, 2, -1)[..., None, :]
    y_diag = jnp.einsum('bcgrqs,bcsgrp->bcqgrp', m, xc)
    w_end = jnp.exp(acum[:, :, -1:] - acum) * dtc
    s_c = jnp.einsum('bcsgn,bcsgrp->bcgrpn', Bc, xc * w_end[..., None])
    chunk_decay = jnp.exp(acum[:, :, -1])

    def step(hc, inp):
        dec, sc = inp
        return hc * dec[..., None, None] + sc, hc

    h_init = h0.reshape(b, g, r, p, n).astype(jnp.float32)
    h_last, h_prev = lax.scan(step, h_init, (jnp.moveaxis(chunk_decay, 1, 0), jnp.moveaxis(s_c, 1, 0)))
    h_prev = jnp.moveaxis(h_prev, 0, 1)
    y_off = jnp.einsum('bcqgn,bcgrpn->bcqgrp', Cc, h_prev) * jnp.exp(acum)[..., None]
    y = (y_diag + y_off).reshape(b, nc * q, h, p)[:, :l]
    return y, h_last.reshape(b, h, p, n)


def dsa_attention(q, qi, wi, k_all, v_all, ki_all, rel_bias, q_start):
    b, t = q.shape[0], q.shape[1]
    s = k_all.shape[1]
    n_sel = min(TOPK_MAX, s // 4)
    qb = QUERY_BLOCK if t % QUERY_BLOCK == 0 else t
    nb = t // qb
    grp = N_HEADS // N_KV_HEADS
    key_pos = jnp.arange(s, dtype=jnp.int32)
    bidx = jnp.arange(b)[:, None, None]

    def blocks(arr):
        return jnp.moveaxis(arr.reshape((b, nb, qb) + arr.shape[2:]), 1, 0)

    q_pos = (q_start + jnp.arange(t, dtype=jnp.int32)).reshape(nb, qb)

    def one_block(args):
        q_b, qi_b, wi_b, pos_b = args
        visible_end = (pos_b // CHUNK + 1) * CHUNK
        dots = jnp.einsum('bthd,bsd->bths', qi_b, ki_all).astype(jnp.float32) * IDX_DIM ** -0.5
        score = jnp.einsum('bth,bths->bts', wi_b.astype(jnp.float32) * IDX_HEADS ** -0.5, jax.nn.relu(dots))
        visible = key_pos[None, :] < visible_end[:, None]
        score = jnp.where(visible[None], score, -jnp.inf)
        _, sel = lax.top_k(score, n_sel)
        valid = sel < visible_end[None, :, None]
        k_sel = k_all[bidx, sel]
        v_sel = v_all[bidx, sel]
        qg = q_b.reshape(b, qb, N_KV_HEADS, grp, HEAD_DIM)
        logits = jnp.einsum('btkgd,btskd->btkgs', qg, k_sel).astype(jnp.float32) * HEAD_DIM ** -0.5
        bias = rel_bias[t5_bucket(sel - pos_b[None, :, None])]
        bias = jnp.moveaxis(bias, 2, 3).reshape(b, qb, N_KV_HEADS, grp, n_sel)
        logits = jnp.where(valid[:, :, None, None, :], logits + bias.astype(jnp.float32), -jnp.inf)
        probs = jax.nn.softmax(logits, axis=-1).astype(v_sel.dtype)
        out = jnp.einsum('btkgs,btskd->btkgd', probs, v_sel)
        return out.reshape(b, qb, N_HEADS * HEAD_DIM)

    out = lax.map(one_block, (blocks(q), blocks(qi), blocks(wi), q_pos))
    return jnp.moveaxis(out, 0, 1).reshape(b, t, N_HEADS * HEAD_DIM)


def hybrid_layer(x, cache_k, cache_v, cache_kidx, state_ssm, state_conv, rel_bias,
                 w_in, conv_w, conv_b, dt_bias, a_log, d_skip, ssd_norm_w, w_ssd_o, w_attn_o, w_out,
                 ln1_g, ln1_b, w_up, w_down, ln2_g, ln2_b):
    b, t, _ = x.shape
    past = cache_k.shape[1]
    proj = x @ w_in
    z, xbc, dt, q, k, v, qi, ki, wi, g_ssd, g_attn = jnp.split(proj, IN_SPLITS, axis=-1)

    xbc_pad = jnp.concatenate([state_conv.astype(xbc.dtype), xbc], axis=1)
    new_conv = xbc_pad[:, -(CONV_W - 1):]
    conv = conv_b
    for i in range(CONV_W):
        conv = conv + xbc_pad[:, i:i + t] * conv_w[i]
    xbc_act = jax.nn.silu(conv)
    xs, Bm, Cm = jnp.split(xbc_act, (SSD_INNER, SSD_INNER + SSD_GROUPS * D_STATE), axis=-1)
    xs = xs.reshape(b, t, SSD_HEADS, SSD_HEAD_DIM)
    Bm = Bm.reshape(b, t, SSD_GROUPS, D_STATE)
    Cm = Cm.reshape(b, t, SSD_GROUPS, D_STATE)
    dt_pos = jax.nn.softplus(dt.astype(jnp.float32) + dt_bias.astype(jnp.float32))
    A = -jnp.exp(a_log.astype(jnp.float32))
    y_ssd, new_ssm = ssd_scan(xs, dt_pos, A, Bm, Cm, state_ssm)
    y_ssd = (y_ssd + d_skip[:, None] * xs).astype(x.dtype).reshape(b, t, SSD_INNER)
    y_ssd = gated_rmsnorm(y_ssd, z, ssd_norm_w)
    y1 = y_ssd @ w_ssd_o

    k_new = k.reshape(b, t, N_KV_HEADS, HEAD_DIM)
    v_new = v.reshape(b, t, N_KV_HEADS, HEAD_DIM)
    k_all = jnp.concatenate([cache_k.astype(k_new.dtype), k_new], axis=1)
    v_all = jnp.concatenate([cache_v.astype(v_new.dtype), v_new], axis=1)
    ki_all = jnp.concatenate([cache_kidx.astype(ki.dtype), ki], axis=1)
    o = dsa_attention(q.reshape(b, t, N_HEADS, HEAD_DIM), qi.reshape(b, t, IDX_HEADS, IDX_DIM), wi,
                      k_all, v_all, ki_all, rel_bias, past)
    y2 = o @ w_attn_o

    mixed = (jax.nn.sigmoid(g_ssd) * y1 + jax.nn.sigmoid(g_attn) * y2) @ w_out
    h = layer_norm(ALPHA * x + mixed, ln1_g, ln1_b)
    f = jnp.square(jax.nn.relu(h @ w_up)) @ w_down
    out = layer_norm(ALPHA * h + f, ln2_g, ln2_b)
    return out, (k_new, v_new, ki, new_ssm.astype(x.dtype), new_conv)


def setup_inputs(seed: int = 0) -> dict:
    key = jax.random.key(seed)
    ks = jax.random.split(key, 32)
    f32 = jnp.float32

    def nrm(k, shape, scale):
        return jax.random.normal(k, shape, f32) * scale

    L = DEPTH
    dt0 = jnp.exp(jax.random.uniform(ks[11], (L, SSD_HEADS), f32, math.log(1e-3), math.log(1e-1)))
    return {
        'x_prompt': nrm(ks[0], (BATCH, SEQ, D_MODEL), 1.0),
        'x_sample': nrm(ks[1], (DEC_BATCH, DEC_SEQ, D_MODEL), 1.0),
        'cache_k': nrm(ks[2], (L, DEC_BATCH, PAST_LEN, N_KV_HEADS, HEAD_DIM), 1.0),
        'cache_v': nrm(ks[3], (L, DEC_BATCH, PAST_LEN, N_KV_HEADS, HEAD_DIM), 1.0),
        'cache_kidx': nrm(ks[4], (L, DEC_BATCH, PAST_LEN, IDX_DIM), 1.0),
        'state_ssm': nrm(ks[5], (L, DEC_BATCH, SSD_HEADS, SSD_HEAD_DIM, D_STATE), 0.1),
        'state_conv': nrm(ks[6], (L, DEC_BATCH, CONV_W - 1, CONV_DIM), 1.0),
        'rel_bias': nrm(ks[7], (REL_BUCKETS, N_HEADS), 0.5),
        'w_in': nrm(ks[8], (L, D_MODEL, IN_WIDTH), D_MODEL ** -0.5),
        'conv_w': nrm(ks[9], (L, CONV_W, CONV_DIM), CONV_W ** -0.5),
        'conv_b': nrm(ks[10], (L, CONV_DIM), 0.01),
        'dt_bias': dt0 + jnp.log(-jnp.expm1(-dt0)),
        'a_log': jnp.log(jax.random.uniform(ks[12], (L, SSD_HEADS), f32, 1.0, 16.0)),
        'd_skip': 1.0 + nrm(ks[13], (L, SSD_HEADS), 0.01),
        'ssd_norm_w': 1.0 + nrm(ks[14], (L, SSD_INNER), 0.01),
        'w_ssd_o': nrm(ks[15], (L, SSD_INNER, D_MODEL), SSD_INNER ** -0.5 * BETA),
        'w_attn_o': nrm(ks[16], (L, N_HEADS * HEAD_DIM, D_MODEL), (N_HEADS * HEAD_DIM) ** -0.5 * BETA),
        'w_out': nrm(ks[17], (L, D_MODEL, D_MODEL), D_MODEL ** -0.5 * BETA),
        'ln1_g': 1.0 + nrm(ks[18], (L, D_MODEL), 0.01),
        'ln1_b': nrm(ks[19], (L, D_MODEL), 0.01),
        'w_up': nrm(ks[20], (L, D_MODEL, D_FF), D_MODEL ** -0.5),
        'w_down': nrm(ks[21], (L, D_FF, D_MODEL), D_FF ** -0.5 * BETA),
        'ln2_g': 1.0 + nrm(ks[22], (L, D_MODEL), 0.01),
        'ln2_b': nrm(ks[23], (L, D_MODEL), 0.01),
    }


def reference(x_prompt, x_sample, cache_k, cache_v, cache_kidx, state_ssm, state_conv, rel_bias,
              w_in, conv_w, conv_b, dt_bias, a_log, d_skip, ssd_norm_w, w_ssd_o, w_attn_o, w_out,
              ln1_g, ln1_b, w_up, w_down, ln2_g, ln2_b):
    bp = x_prompt.shape[0]
    dtype = x_prompt.dtype
    empty_k = jnp.zeros((bp, 0, N_KV_HEADS, HEAD_DIM), dtype)
    empty_ki = jnp.zeros((bp, 0, IDX_DIM), dtype)
    zero_ssm = jnp.zeros((bp, SSD_HEADS, SSD_HEAD_DIM, D_STATE), dtype)
    zero_conv = jnp.zeros((bp, CONV_W - 1, CONV_DIM), dtype)
    yp, ys = x_prompt, x_sample
    st_p, st_s = [], []
    for l in range(DEPTH):
        yp, sp = hybrid_layer(yp, empty_k, empty_k, empty_ki, zero_ssm, zero_conv, rel_bias,
                              w_in[l], conv_w[l], conv_b[l], dt_bias[l], a_log[l], d_skip[l], ssd_norm_w[l],
                              w_ssd_o[l], w_attn_o[l], w_out[l], ln1_g[l], ln1_b[l], w_up[l], w_down[l],
                              ln2_g[l], ln2_b[l])
        ys, ss = hybrid_layer(ys, cache_k[l], cache_v[l], cache_kidx[l], state_ssm[l], state_conv[l], rel_bias,
                              w_in[l], conv_w[l], conv_b[l], dt_bias[l], a_log[l], d_skip[l], ssd_norm_w[l],
                              w_ssd_o[l], w_attn_o[l], w_out[l], ln1_g[l], ln1_b[l], w_up[l], w_down[l],
                              ln2_g[l], ln2_b[l])
        st_p.append(sp)
        st_s.append(ss)
    k_p = jnp.stack([s[0] for s in st_p])
    v_p = jnp.stack([s[1] for s in st_p])
    ki_p = jnp.stack([s[2] for s in st_p])
    ssm_p = jnp.stack([s[3] for s in st_p])
    conv_p = jnp.stack([s[4] for s in st_p])
    k_s = jnp.stack([s[0] for s in st_s])
    v_s = jnp.stack([s[1] for s in st_s])
    ki_s = jnp.stack([s[2] for s in st_s])
    ssm_s = jnp.stack([s[3] for s in st_s])
    conv_s = jnp.stack([s[4] for s in st_s])
    return (yp, ys, k_p, v_p, ki_p, ssm_p, conv_p, k_s, v_s, ki_s, ssm_s, conv_s)
```

```cpp
#include <hip/hip_runtime.h>
#include <hip/hip_cooperative_groups.h>
#include <cstdint>
#include <cstdio>
#include <cmath>
namespace cg = cooperative_groups;

constexpr int MP = 32768, MS = 1024, MT = MP + MS;
constexpr int DM = 1024, NIN = 9472;
constexpr int SEQP = 16384, PAST = 4096, SKEYS = 4128;
constexpr int NQC = 544;
constexpr int KROWS = MP + 32 * SKEYS;
constexpr float ALPHA = 1.189207115002721f;
constexpr float LN_EPS = 1e-5f, RMS_EPS = 1e-5f;

constexpr int OUT_YP = 0, OUT_YS = 33554432, OUT_KP = 34603008, OUT_VP = 42991616, OUT_KIP = 51380224, OUT_SSMP = 53477376,
              OUT_CONVP = 54001664, OUT_KS = 54020096, OUT_VS = 54282240, OUT_KIS = 54544384, OUT_SSMS = 54609920, OUT_CONVS = 62998528,
              OUT_TOTAL = 63293440;

constexpr size_t WS_CTL = 0;
constexpr size_t WS_WIN = 1048576;
constexpr size_t WS_WSSD = WS_WIN + (size_t)NIN * 1024 * 2;
constexpr size_t WS_WATT = WS_WSSD + 4194304;
constexpr size_t WS_WOUT = WS_WATT + 2097152;
constexpr size_t WS_WUP = WS_WOUT + 2097152;
constexpr size_t WS_WDN = WS_WUP + 8388608;
constexpr size_t WS_Q = WS_WDN + 8388608;
constexpr size_t WS_Z = WS_Q + (size_t)MT * 2048;
constexpr size_t WS_DT = WS_Z + (size_t)MT * 4096;
constexpr size_t WS_WI = WS_DT + (size_t)MT * 128;
constexpr size_t WS_R46 = WS_WI + (size_t)MT * 32;
constexpr size_t SZ_R46 = 258998272;
constexpr size_t WS_R57 = WS_R46 + SZ_R46;
constexpr size_t SZ_R57 = 285212672;
constexpr size_t WS_END = WS_R57 + SZ_R57;
constexpr size_t WS_KALL = WS_R46;
constexpr size_t WS_VALL = WS_KALL + (size_t)KROWS * 512;
constexpr size_t WS_KIALL = WS_VALL + (size_t)KROWS * 512;
constexpr size_t WS_QI = WS_KIALL + (size_t)KROWS * 128;
constexpr size_t WS_SEL = WS_QI + (size_t)MT * 1024;
static_assert(WS_SEL + (size_t)MT * 512 <= WS_R46 + SZ_R46, "region A life 1");
constexpr size_t WS_XT = WS_R46;
constexpr size_t WS_BN = WS_XT + (size_t)NQC * 64 * 2048 * 2;
constexpr size_t WS_BT = WS_BN + (size_t)NQC * 64 * 512 * 2;
constexpr size_t WS_CN = WS_BT + (size_t)NQC * 64 * 512 * 2;
constexpr size_t WS_ACUM = WS_CN + (size_t)NQC * 64 * 512 * 2;
constexpr size_t WS_DTS = WS_ACUM + (size_t)NQC * 32 * 64 * 4;
static_assert(WS_DTS + (size_t)NQC * 32 * 64 * 4 <= WS_R46 + SZ_R46, "region A life 2");
constexpr size_t WS_T = WS_R46;
constexpr size_t WS_MIX = WS_T + (size_t)MT * 4096;
constexpr size_t WS_H1 = WS_R46;
static_assert(WS_MIX + (size_t)MT * 2048 <= WS_R46 + SZ_R46, "region A life 3");
constexpr size_t WS_XB = WS_R57;
constexpr size_t WS_XBC = WS_XB + (size_t)MT * 2048;
static_assert(WS_XBC + (size_t)MT * 6144 <= WS_R57 + SZ_R57, "region B life 1");
constexpr size_t WS_STATES = WS_R57;
static_assert((size_t)NQC * 32 * 64 * 128 * 2 <= SZ_R57, "region B life 2");
constexpr size_t WS_PRE1 = WS_R57;
constexpr size_t WS_HID = WS_R57;
static_assert((size_t)MT * 8192 <= SZ_R57, "region B life 3");
constexpr int CW_QUEUE = 64;

constexpr int LDS_BYTES = 147456;
#define LAS __attribute__((address_space(3)))

typedef unsigned short bf16;
typedef unsigned u32x4 __attribute__((ext_vector_type(4)));
typedef unsigned u32x2 __attribute__((ext_vector_type(2)));
typedef float f32x16 __attribute__((ext_vector_type(16)));
typedef float f32x2v __attribute__((ext_vector_type(2)));
typedef __bf16 bf16x2_t __attribute__((ext_vector_type(2)));

__device__ __forceinline__ float bf2f(unsigned h) { return __uint_as_float(h << 16); }
__device__ __forceinline__ unsigned pk2(float lo, float hi) { f32x2v v = {lo, hi}; bf16x2_t b = __builtin_convertvector(v, bf16x2_t); return __builtin_bit_cast(unsigned, b); }
__device__ __forceinline__ unsigned short f2bf(float f) { return (unsigned short)(pk2(f, 0.f) & 0xffffu); }
__device__ __forceinline__ float lo_f(unsigned w) { return __uint_as_float(w << 16); }
__device__ __forceinline__ float hi_f(unsigned w) { return __uint_as_float(w & 0xffff0000u); }
__device__ __forceinline__ float sigmoidf_(float x) { return 1.0f / (1.0f + __expf(-x)); }
__device__ __forceinline__ float siluf_(float x) { return x / (1.0f + __expf(-x)); }
__device__ __forceinline__ float softplusf_(float x) { return x > 20.f ? x : log1pf(__expf(x)); }
namespace pg8 {
#define PG8_LAS __attribute__((address_space(3)))
typedef unsigned short bf16_t;
typedef short bf16x8 __attribute__((ext_vector_type(8)));
typedef float f32x4 __attribute__((ext_vector_type(4)));
typedef unsigned u32x4 __attribute__((ext_vector_type(4)));
constexpr int BM = 256, BK = 64, HALF = 128, HTB = HALF * BK * 2  , STAGE_BYTES = 8 * HTB, NXCD = 8, WGM = 8;

__host__ __device__ __forceinline__ int lds_byte(int r, int c) { const int st = (r >> 4) * 2 + (c >> 5), rr = r & 15, cc = c & 31, ob = rr * 64 + cc * 2; return st * 1024 + (ob ^ (((ob >> 9) & 1) << 5)); }
__host__ __device__ __forceinline__ void stage_rc(int b, int& R, int& C) { const int st = b / 1024, sb = b % 1024, swz = sb ^ (((sb >> 9) & 1) << 5); R = (st >> 1) * 16 + swz / 64; C = (st & 1) * 32 + (swz % 64) / 2; }
__host__ __device__ __forceinline__ int perm32(int rho) { const int n = rho >> 4, i = rho & 15; return 8 * (i >> 2) + 4 * n + (i & 3); }

struct Unit { int pm, pn; };
struct Gemm { const bf16_t* A; const bf16_t* Bt; int M, N, K; };

struct StaticOrder {
    int nM, nN, nwg, G, c;
    __host__ __device__ void init(int M, int N, int G_, int c_) { nM = M / BM; nN = N / BM; nwg = nM * nN; G = G_; c = c_; }
    __host__ __device__ bool next(int i, Unit& u) const {
        const long L = (long)i * G + c; if (L >= nwg) return false;
        int wgid = (int)L; { const int q = nwg / NXCD, r = nwg % NXCD, xcd = wgid % NXCD, off = wgid / NXCD; wgid = (xcd < r ? xcd * (q + 1) : r * (q + 1) + (xcd - r) * q) + off; }
        const int nig = WGM * nN, gid = wgid / nig, fm = gid * WGM, gsz = (nM - fm) < WGM ? (nM - fm) : WGM;
        u.pm = fm + ((wgid % nig) % gsz); u.pn = (wgid % nig) / gsz; return true;
    }
    __device__ __forceinline__ void a_ready(const Unit&) const {}
    __device__ __forceinline__ void done(const Unit&) const {}
};

__device__ __forceinline__ unsigned cvt_pk_bf16(float lo, float hi) { unsigned r; asm volatile("v_cvt_pk_bf16_f32 %0, %1, %2" : "=v"(r) : "v"(lo), "v"(hi)); return r; }
__device__ __forceinline__ u32x4 pack8(const f32x4 a, const f32x4 b) { u32x4 w; w.x = ::pk2(a[0], a[1]); w.y = ::pk2(a[2], a[3]); w.z = ::pk2(b[0], b[1]); w.w = ::pk2(b[2], b[3]); return w; }
#define EPI_LOOP8(...) _Pragma("unroll") for (int ai = 0; ai < 2; ++ai) _Pragma("unroll") for (int m = 0; m < 4; ++m) _Pragma("unroll") for (int bj = 0; bj < 2; ++bj) { \
    const int r = row0 + ai * HALF + m * 16, cl = cl0 + bj * HALF; const f32x4 a = acc[ai][bj][m][0], b = acc[ai][bj][m][1]; __VA_ARGS__ }
#define EPI_LOOP4(...) _Pragma("unroll") for (int ai = 0; ai < 2; ++ai) _Pragma("unroll") for (int m = 0; m < 4; ++m) _Pragma("unroll") for (int bj = 0; bj < 2; ++bj) _Pragma("unroll") for (int n = 0; n < 2; ++n) { \
    const int r = row0 + ai * HALF + m * 16, c = col0 + bj * HALF + n * 16; const f32x4 a = acc[ai][bj][m][n]; __VA_ARGS__ }

struct EpiInProj {
    static constexpr bool PERM = true, AFTER_DRAIN = false;
    bf16_t *Z, *XBC, *Q, *KALL, *VALL, *QI, *G, *KIALL; float *DT, *WI, *out; const float* dt_bias;
    __device__ __forceinline__ void operator()(const f32x4 (&acc)[2][2][4][2], const Unit& u, int wr, int wc, int fr, int fq) const {
        const int pn = u.pn, row0 = u.pm * BM + wr * 64 + fr, cl0 = wc * 32 + 8 * fq;
        if (pn < 8) { EPI_LOOP8( *(u32x4*)(Z + (size_t)r * 2048 + pn * 256 + cl) = pack8(a, b); ) }
        else if (pn < 20) { EPI_LOOP8( const int c = (pn - 8) * 256 + cl; *(u32x4*)(XBC + (size_t)r * 3072 + c) = pack8(a, b);
            int slot = -1;
            if (r < MP) { const int t = r & 16383; if (t >= 16381) slot = OUT_CONVP + ((r >> 14) * 3 + (t - 16381)) * 3072; }
            else { const int rs = r - MP, t = rs & 31; if (t >= 29) slot = OUT_CONVS + ((rs >> 5) * 3 + (t - 29)) * 3072; }
            if (slot >= 0) { *(f32x4*)(out + slot + c) = a; *(f32x4*)(out + slot + c + 4) = b; } ) }
        else if (pn < 24) { EPI_LOOP8( *(u32x4*)(Q + (size_t)r * 1024 + (pn - 20) * 256 + cl) = pack8(a, b); ) }
        else if (pn < 26) { bf16_t* KV = (pn == 24) ? KALL : VALL; const int op = (pn == 24) ? OUT_KP : OUT_VP, os = (pn == 24) ? OUT_KS : OUT_VS;
            EPI_LOOP8( int kr, o; if (r < MP) { kr = r; o = op + r * 256; } else { const int rs = r - MP; kr = MP + (rs >> 5) * SKEYS + PAST + (rs & 31); o = os + rs * 256; }
                *(u32x4*)(KV + (size_t)kr * 256 + cl) = pack8(a, b); *(f32x4*)(out + o + cl) = a; *(f32x4*)(out + o + cl + 4) = b; ) }
        else if (pn < 28) { EPI_LOOP8( *(u32x4*)(QI + (size_t)r * 512 + (pn - 26) * 256 + cl) = pack8(a, b); ) }
        else if (pn < 36) { EPI_LOOP8( f32x4 sa, sb;
            _Pragma("unroll") for (int e = 0; e < 4; ++e) { sa[e] = ::sigmoidf_(a[e]); sb[e] = ::sigmoidf_(b[e]); }
            *(u32x4*)(G + (size_t)r * 2048 + (pn - 28) * 256 + cl) = pack8(sa, sb); ) }
        else { EPI_LOOP8(
            if (cl < 32) { f32x4 sa, sb; const f32x4 ba = *(const f32x4*)(dt_bias + cl), bb = *(const f32x4*)(dt_bias + cl + 4);
                _Pragma("unroll") for (int e = 0; e < 4; ++e) { sa[e] = ::softplusf_(a[e] + ba[e]); sb[e] = ::softplusf_(b[e] + bb[e]); }
                *(f32x4*)(DT + (size_t)r * 32 + cl) = sa; *(f32x4*)(DT + (size_t)r * 32 + cl + 4) = sb; }
            else if (cl < 96) { int kr, o; if (r < MP) { kr = r; o = OUT_KIP + r * 64; } else { const int rs = r - MP; kr = MP + (rs >> 5) * SKEYS + PAST + (rs & 31); o = OUT_KIS + rs * 64; }
                *(u32x4*)(KIALL + (size_t)kr * 64 + (cl - 32)) = pack8(a, b); *(f32x4*)(out + o + (cl - 32)) = a; *(f32x4*)(out + o + (cl - 32) + 4) = b; }
            else if (cl < 104) { const float s = 0.04419417382415922f;
                *(f32x4*)(WI + (size_t)r * 8) = a * s; *(f32x4*)(WI + (size_t)r * 8 + 4) = b * s; } ) }
    }
};
struct EpiMixA {
    static constexpr bool PERM = true, AFTER_DRAIN = false;
    const bf16_t* G; float* T;
    __device__ __forceinline__ void operator()(const f32x4 (&acc)[2][2][4][2], const Unit& u, int wr, int wc, int fr, int fq) const {
        const int row0 = u.pm * BM + wr * 64 + fr, cl0 = u.pn * BM + wc * 32 + 8 * fq;
        EPI_LOOP8( const u32x4 g = *(const u32x4*)(G + (size_t)r * 2048 + cl); float* t = T + (size_t)r * 1024 + cl;
            f32x4 o0, o1; o0[0] = a[0] * ::lo_f(g.x); o0[1] = a[1] * ::hi_f(g.x); o0[2] = a[2] * ::lo_f(g.y); o0[3] = a[3] * ::hi_f(g.y);
            o1[0] = b[0] * ::lo_f(g.z); o1[1] = b[1] * ::hi_f(g.z); o1[2] = b[2] * ::lo_f(g.w); o1[3] = b[3] * ::hi_f(g.w);
            *(f32x4*)t = o0; *(f32x4*)(t + 4) = o1; )
    }
};
struct EpiMixB {
    static constexpr bool PERM = true, AFTER_DRAIN = false;
    const bf16_t* G; const float* T; bf16_t* MIX;
    __device__ __forceinline__ void operator()(const f32x4 (&acc)[2][2][4][2], const Unit& u, int wr, int wc, int fr, int fq) const {
        const int row0 = u.pm * BM + wr * 64 + fr, cl0 = u.pn * BM + wc * 32 + 8 * fq;
        EPI_LOOP8( const u32x4 g = *(const u32x4*)(G + (size_t)r * 2048 + 1024 + cl); const float* t = T + (size_t)r * 1024 + cl;
            const f32x4 t0 = *(const f32x4*)t, t1 = *(const f32x4*)(t + 4);
            f32x4 o0, o1; o0[0] = t0[0] + a[0] * ::lo_f(g.x); o0[1] = t0[1] + a[1] * ::hi_f(g.x); o0[2] = t0[2] + a[2] * ::lo_f(g.y); o0[3] = t0[3] + a[3] * ::hi_f(g.y);
            o1[0] = t1[0] + b[0] * ::lo_f(g.z); o1[1] = t1[1] + b[1] * ::hi_f(g.z); o1[2] = t1[2] + b[2] * ::lo_f(g.w); o1[3] = t1[3] + b[3] * ::hi_f(g.w);
            *(u32x4*)(MIX + (size_t)r * 1024 + cl) = pack8(o0, o1); )
    }
};
struct EpiResX {
    static constexpr bool PERM = false, AFTER_DRAIN = false;
    const float *xp, *xs; float* PRE;
    __device__ __forceinline__ void operator()(const f32x4 (&acc)[2][2][4][2], const Unit& u, int wr, int wc, int fr, int fq) const {
        const int row0 = u.pm * BM + wr * 64 + fr, col0 = u.pn * BM + wc * 32 + 4 * fq;
        EPI_LOOP4( const float* xr = (r < MP) ? xp + (size_t)r * 1024 : xs + (size_t)(r - MP) * 1024; const f32x4 xv = *(const f32x4*)(xr + c);
            *(f32x4*)(PRE + (size_t)r * 1024 + c) = xv * ALPHA + a; )
    }
};
struct EpiSqRelu {
    static constexpr bool PERM = true, AFTER_DRAIN = false;
    bf16_t* H;
    __device__ __forceinline__ void operator()(const f32x4 (&acc)[2][2][4][2], const Unit& u, int wr, int wc, int fr, int fq) const {
        const int row0 = u.pm * BM + wr * 64 + fr, cl0 = u.pn * BM + wc * 32 + 8 * fq;
        EPI_LOOP8( f32x4 sa, sb;
            _Pragma("unroll") for (int e = 0; e < 4; ++e) { const float x0 = fmaxf(a[e], 0.f), x1 = fmaxf(b[e], 0.f); sa[e] = x0 * x0; sb[e] = x1 * x1; }
            *(u32x4*)(H + (size_t)r * 4096 + cl) = pack8(sa, sb); )
    }
};
struct EpiResH {
    static constexpr bool PERM = false, AFTER_DRAIN = false;
    const bf16_t* H1; float* PRE;
    __device__ __forceinline__ void operator()(const f32x4 (&acc)[2][2][4][2], const Unit& u, int wr, int wc, int fr, int fq) const {
        const int row0 = u.pm * BM + wr * 64 + fr, col0 = u.pn * BM + wc * 32 + 4 * fq;
        EPI_LOOP4( const u32x2 hv = *(const u32x2*)(H1 + (size_t)r * 1024 + c);
            f32x4 o; o[0] = ::lo_f(hv.x) * ALPHA + a[0]; o[1] = ::hi_f(hv.x) * ALPHA + a[1]; o[2] = ::lo_f(hv.y) * ALPHA + a[2]; o[3] = ::hi_f(hv.y) * ALPHA + a[3];
            *(f32x4*)(PRE + (size_t)r * 1024 + c) = o; )
    }
};
template <class Epi, class Sched, bool ALIGN_EPI = false, bool SP2 = false>
__device__ __forceinline__ void gemm_phase(PG8_LAS unsigned char* lds, const Gemm g, const Sched& S, const Epi& E) {
    const int tid = threadIdx.x, wid = __builtin_amdgcn_readfirstlane(tid >> 6), lane = tid & 63, wr = wid >> 2, wc = wid & 3, fr = lane & 15, fq = lane >> 4;
    const int K = g.K, nt = K / BK;
    unsigned voffA[2], voffB[2];
#pragma unroll
    for (int i = 0; i < 2; ++i) { int R, C; stage_rc(tid * 16 + i * 8192, R, C); const int Rb = Epi::PERM ? ((R & ~31) + perm32(R & 31)) : R;
        voffA[i] = (unsigned)(R * K + C) * 2u; voffB[i] = (unsigned)(Rb * K + C) * 2u; }
    const size_t kstep = (size_t)(BK * 2);
    const size_t hstep = (size_t)HALF * K * 2;
    const size_t tstep = 2 * hstep;
    const unsigned ldsw = (unsigned)wid * 1024u;
    const int aoff = lds_byte(wr * 64 + fr, fq * 8), boff = lds_byte(wc * 32 + fr, fq * 8);
#define PG8_SA(b, h) (((b) * 2 + (h)) * HTB)
#define PG8_SB(b, h) ((4 + (b) * 2 + (h)) * HTB)
#define PG8_STAGE(bufoff, gbase, voff) do { _Pragma("unroll") for (int _i = 0; _i < 2; ++_i) \
        __builtin_amdgcn_global_load_lds((const unsigned*)((const char*)(gbase) + (voff)[_i]), (PG8_LAS unsigned*)(lds + (bufoff) + ldsw + _i * 8192), 16, 0, 0); } while (0)
#define PG8_LDA(dst, b, h) do { _Pragma("unroll") for (int m = 0; m < 4; ++m) _Pragma("unroll") for (int k = 0; k < 2; ++k) dst[m][k] = *(const PG8_LAS bf16x8*)(lds + PG8_SA(b, h) + aoff + m * 2048 + k * 1024); } while (0)
#define PG8_LDB(dst, b, h) do { _Pragma("unroll") for (int n = 0; n < 2; ++n) _Pragma("unroll") for (int k = 0; k < 2; ++k) dst[n][k] = *(const PG8_LAS bf16x8*)(lds + PG8_SB(b, h) + boff + n * 2048 + k * 1024); } while (0)
#define PG8_MMA(ai, bj, At, Bt) do { __builtin_amdgcn_s_setprio(1); _Pragma("unroll") for (int m = 0; m < 4; ++m) _Pragma("unroll") for (int n = 0; n < 2; ++n) _Pragma("unroll") for (int k = 0; k < 2; ++k) \
        acc[ai][bj][m][n] = __builtin_amdgcn_mfma_f32_16x16x32_bf16(Bt[n][k], At[m][k], acc[ai][bj][m][n], 0, 0, 0); __builtin_amdgcn_s_setprio(0); } while (0)
#define PG8_WAIT_V(n) asm volatile("s_waitcnt vmcnt(" #n ")" ::: "memory")
#define PG8_WAIT_L(n) asm volatile("s_waitcnt lgkmcnt(" #n ")" ::: "memory")
#define PG8_BAR __builtin_amdgcn_s_barrier()
#define PG8_SCHED __builtin_amdgcn_sched_barrier(0)
    Unit cur, nxt; int ui = 0;
    if (!S.next(0, cur)) return;
    f32x4 acc[2][2][4][2];
#pragma unroll
    for (int a = 0; a < 2; ++a)
#pragma unroll
        for (int b = 0; b < 2; ++b)
#pragma unroll
            for (int m = 0; m < 4; ++m)
#pragma unroll
                for (int n = 0; n < 2; ++n) acc[a][b][m][n] = (f32x4){0.f, 0.f, 0.f, 0.f};
    bf16x8 At[4][2], B0[2][2], B1[2][2];
    const char* cA = (const char*)g.A + (size_t)cur.pm * tstep; const char* cB = (const char*)g.Bt + (size_t)cur.pn * tstep;
    S.a_ready(cur);
    if constexpr (SP2) {
        PG8_STAGE(PG8_SB(0, 0), cB, voffB); PG8_STAGE(PG8_SB(0, 1), cB + hstep, voffB); PG8_STAGE(PG8_SA(0, 0), cA, voffA); PG8_STAGE(PG8_SA(0, 1), cA + hstep, voffA);
        if (wr == 1) PG8_BAR;
        PG8_WAIT_V(2); PG8_BAR;
        PG8_STAGE(PG8_SB(1, 0), cB + kstep, voffB); PG8_STAGE(PG8_SA(1, 0), cA + kstep, voffA); PG8_STAGE(PG8_SB(1, 1), cB + hstep + kstep, voffB);
        PG8_WAIT_V(6); PG8_BAR;
    } else {
        PG8_STAGE(PG8_SB(0, 0), cB, voffB); PG8_STAGE(PG8_SA(0, 0), cA, voffA); PG8_STAGE(PG8_SB(0, 1), cB + hstep, voffB); PG8_STAGE(PG8_SA(0, 1), cA + hstep, voffA);
        if (wr == 1) PG8_BAR;
        PG8_WAIT_V(4); PG8_BAR;
        PG8_STAGE(PG8_SB(1, 0), cB + kstep, voffB); PG8_STAGE(PG8_SA(1, 0), cA + kstep, voffA); PG8_STAGE(PG8_SB(1, 1), cB + hstep + kstep, voffB);
        PG8_WAIT_V(6); PG8_BAR;
    }
    for (;;) {
        const bool has_next = S.next(ui + 1, nxt);
        const char* nA = has_next ? (const char*)g.A + (size_t)nxt.pm * tstep : cA; const char* nB = has_next ? (const char*)g.Bt + (size_t)nxt.pn * tstep : cB;
        for (int t = 0; t < nt; t += 2) {
            const bool last = (t == nt - 2);
            const char* a1 = cA + (size_t)(t + 1) * kstep;
            const char* a2 = last ? nA : cA + (size_t)(t + 2) * kstep; const char* b2 = last ? nB : cB + (size_t)(t + 2) * kstep;
            const char* a3 = a2 + kstep; const char* b3 = b2 + kstep;
            if (last && has_next) S.a_ready(nxt);
            if constexpr (SP2) {
            PG8_LDB(B0, 0, 0); PG8_LDB(B1, 0, 1); PG8_SCHED; PG8_LDA(At, 0, 0); PG8_STAGE(PG8_SA(1, 1), a1 + hstep, voffA);
            PG8_WAIT_V(8); PG8_WAIT_L(0); PG8_BAR; PG8_MMA(0, 0, At, B0); PG8_MMA(0, 1, At, B1); PG8_BAR; PG8_SCHED;
            PG8_LDA(At, 0, 1); PG8_STAGE(PG8_SB(0, 0), b2, voffB); PG8_STAGE(PG8_SB(0, 1), b2 + hstep, voffB); PG8_STAGE(PG8_SA(0, 0), a2, voffA);
            PG8_WAIT_V(8); PG8_WAIT_L(0); PG8_BAR; PG8_MMA(1, 0, At, B0); PG8_MMA(1, 1, At, B1); PG8_BAR; PG8_SCHED;
            PG8_LDB(B0, 1, 0); PG8_LDB(B1, 1, 1); PG8_SCHED; PG8_LDA(At, 1, 0); PG8_STAGE(PG8_SA(0, 1), a2 + hstep, voffA);
            PG8_WAIT_V(8); PG8_WAIT_L(0); PG8_BAR; PG8_MMA(0, 0, At, B0); PG8_MMA(0, 1, At, B1); PG8_BAR; PG8_SCHED;
            PG8_LDA(At, 1, 1); PG8_STAGE(PG8_SB(1, 0), b3, voffB); PG8_STAGE(PG8_SB(1, 1), b3 + hstep, voffB); PG8_STAGE(PG8_SA(1, 0), a3, voffA);
            PG8_WAIT_V(8); PG8_WAIT_L(0); PG8_BAR; PG8_MMA(1, 0, At, B0); PG8_MMA(1, 1, At, B1); PG8_BAR; PG8_SCHED;
            } else {
            PG8_LDB(B0, 0, 0); PG8_SCHED; PG8_LDA(At, 0, 0); PG8_STAGE(PG8_SA(1, 1), a1 + hstep, voffA);
            PG8_WAIT_L(8); PG8_BAR; PG8_WAIT_L(0); PG8_MMA(0, 0, At, B0); PG8_BAR; PG8_SCHED;
            PG8_LDB(B1, 0, 1); PG8_STAGE(PG8_SB(0, 0), b2, voffB);
            PG8_BAR; PG8_WAIT_L(0); PG8_MMA(0, 1, At, B1); PG8_BAR;
            PG8_LDA(At, 0, 1); PG8_STAGE(PG8_SA(0, 0), a2, voffA);
            PG8_BAR; PG8_WAIT_L(0); PG8_MMA(1, 0, At, B0); PG8_BAR; PG8_SCHED;
            PG8_STAGE(PG8_SB(0, 1), b2 + hstep, voffB);
            PG8_WAIT_V(6); PG8_BAR; PG8_MMA(1, 1, At, B1); PG8_BAR;
            PG8_LDB(B0, 1, 0); PG8_SCHED; PG8_LDA(At, 1, 0); PG8_STAGE(PG8_SA(0, 1), a2 + hstep, voffA);
            PG8_WAIT_L(8); PG8_BAR; PG8_WAIT_L(0); PG8_MMA(0, 0, At, B0); PG8_BAR; PG8_SCHED;
            PG8_LDB(B1, 1, 1); PG8_STAGE(PG8_SB(1, 0), b3, voffB);
            PG8_BAR; PG8_WAIT_L(0); PG8_MMA(0, 1, At, B1); PG8_BAR;
            PG8_LDA(At, 1, 1); PG8_STAGE(PG8_SA(1, 0), a3, voffA);
            PG8_BAR; PG8_WAIT_L(0); PG8_MMA(1, 0, At, B0); PG8_BAR; PG8_SCHED;
            PG8_STAGE(PG8_SB(1, 1), b3 + hstep, voffB);
            PG8_WAIT_V(6); PG8_BAR; PG8_MMA(1, 1, At, B1); PG8_BAR;
            }
        }
        if constexpr (ALIGN_EPI) { if (wr == 0) PG8_BAR; }
        if constexpr (!Epi::AFTER_DRAIN) { E(acc, cur, wr, wc, fr, fq); S.done(cur); }
        if (!has_next) break;
#pragma unroll
        for (int a = 0; a < 2; ++a)
#pragma unroll
            for (int b = 0; b < 2; ++b)
#pragma unroll
                for (int m = 0; m < 4; ++m)
#pragma unroll
                    for (int n = 0; n < 2; ++n) acc[a][b][m][n] = (f32x4){0.f, 0.f, 0.f, 0.f};
        cur = nxt; cA = nA; cB = nB; ++ui;
        if constexpr (ALIGN_EPI) { if (wr == 1) PG8_BAR; }
    }
    PG8_WAIT_V(0);
    if constexpr (!ALIGN_EPI) { if (wr == 0) PG8_BAR; }
    PG8_BAR;
    if constexpr (Epi::AFTER_DRAIN) { E.fused(acc, cur, wr, wc, fr, fq, lds, wid, lane); S.done(cur); }
#undef PG8_SA
#undef PG8_SB
#undef PG8_STAGE
#undef PG8_LDA
#undef PG8_LDB
#undef PG8_MMA
#undef PG8_WAIT_V
#undef PG8_WAIT_L
#undef PG8_BAR
#undef PG8_SCHED
}
}
using pg8::bf16x8;
using pg8::f32x4;
#define MFMA32(a, b, c) __builtin_amdgcn_mfma_f32_32x32x16_bf16((a), (b), (c), 0, 0, 0)
#define MFMA16(a, b, c) __builtin_amdgcn_mfma_f32_16x16x32_bf16((a), (b), (c), 0, 0, 0)
#define LDS_WAIT() asm volatile("s_waitcnt lgkmcnt(0)" ::: "memory")

struct Params {
    const float* in[24];
    float* out;
    unsigned char* ws;
    int ph_lo, ph_hi;
};

__device__ __forceinline__ bf16x8 ldg8(const bf16* p) { return *(const bf16x8*)p; }
__device__ __forceinline__ float wave_sum(float v) {
#pragma unroll
    for (int o = 1; o < 64; o <<= 1) v += __shfl_xor(v, o);
    return v;
}

__device__ __forceinline__ int win_src_col(int n) {
    if (n < 5120) return n;
    if (n < 7168) return n + 32;
    if (n < 9216) return n + 104;
    if (n < 9248) return n - 4096;
    if (n < 9320) return n - 2048;
    return -1;
}
template <bool REMAP>
__device__ __forceinline__ void transpose_item(const float* W, int K, int Nsrc, bf16* WT, LAS float* scr, int kb, int nb, int lane) {
    const int k0 = 64 * kb, n0 = 32 * nb;
    int sc = n0 + (lane & 31); if (REMAP) sc = win_src_col(sc);
#pragma unroll 8
    for (int i = 0; i < 32; ++i) { const int kk = 2 * i + (lane >> 5); scr[kk * 33 + (lane & 31)] = (sc >= 0) ? W[(size_t)(k0 + kk) * Nsrc + sc] : 0.f; }
    LDS_WAIT(); asm volatile("" ::: "memory");
    const int c = lane & 7;
#pragma unroll
    for (int j = 0; j < 4; ++j) { const int n = (lane >> 3) + 8 * j; const LAS float* s = scr + (8 * c) * 33 + n;
        u32x4 o; o.x = pk2(s[0 * 33], s[1 * 33]); o.y = pk2(s[2 * 33], s[3 * 33]); o.z = pk2(s[4 * 33], s[5 * 33]); o.w = pk2(s[6 * 33], s[7 * 33]);
        *(u32x4*)(WT + (size_t)(n0 + n) * K + k0 + 8 * c) = o; }
    LDS_WAIT(); asm volatile("" ::: "memory");
}
__device__ __forceinline__ void cvt8(const float* src, bf16* dst) {
    const f32x4 a = *(const f32x4*)src, b = *(const f32x4*)(src + 4);
    u32x4 o; o.x = pk2(a[0], a[1]); o.y = pk2(a[2], a[3]); o.z = pk2(b[0], b[1]); o.w = pk2(b[2], b[3]);
    *(u32x4*)dst = o;
}
__device__ __forceinline__ void phase_prologue(const Params& p, LAS unsigned char* lds, int tid, int wave, int lane) {
    unsigned char* ws = p.ws;
    LAS float* scr = (LAS float*)(lds + wave * 16384);
    const int gw = blockIdx.x * 8 + wave, NGW = gridDim.x * 8;
    constexpr int I_IN = 16 * 296, I_SSD = 32 * 32, I_ATT = 16 * 32, I_OUT = 16 * 32, I_UP = 16 * 128, I_DN = 64 * 32;
    constexpr int NITEMS = I_IN + I_SSD + I_ATT + I_OUT + I_UP + I_DN;
    for (int it = gw; it < NITEMS; it += NGW) {
        int r = it;
        if (r < I_IN) { transpose_item<true>(p.in[8], 1024, 9320, (bf16*)(ws + WS_WIN), scr, r / 296, r % 296, lane); continue; } r -= I_IN;
        if (r < I_SSD) { transpose_item<false>(p.in[15], 2048, 1024, (bf16*)(ws + WS_WSSD), scr, r / 32, r % 32, lane); continue; } r -= I_SSD;
        if (r < I_ATT) { transpose_item<false>(p.in[16], 1024, 1024, (bf16*)(ws + WS_WATT), scr, r / 32, r % 32, lane); continue; } r -= I_ATT;
        if (r < I_OUT) { transpose_item<false>(p.in[17], 1024, 1024, (bf16*)(ws + WS_WOUT), scr, r / 32, r % 32, lane); continue; } r -= I_OUT;
        if (r < I_UP) { transpose_item<false>(p.in[20], 1024, 4096, (bf16*)(ws + WS_WUP), scr, r / 128, r % 128, lane); continue; } r -= I_UP;
        transpose_item<false>(p.in[21], 4096, 1024, (bf16*)(ws + WS_WDN), scr, r / 32, r % 32, lane);
    }
    const size_t gt = (size_t)blockIdx.x * 512 + tid, NT = (size_t)gridDim.x * 512;
    { bf16* XB = (bf16*)(ws + WS_XB);
      for (size_t i = gt; i < (size_t)MT * 128; i += NT) { const size_t e = i * 8; const float* s = (e < (size_t)MP * 1024) ? p.in[0] + e : p.in[1] + (e - (size_t)MP * 1024); cvt8(s, XB + e); } }
    { bf16* KA = (bf16*)(ws + WS_KALL); bf16* VA = (bf16*)(ws + WS_VALL); bf16* KI = (bf16*)(ws + WS_KIALL);
      for (size_t i = gt; i < (size_t)32 * PAST * 32; i += NT) { const size_t row = i >> 5, c8 = (i & 31) * 8; const size_t b = row >> 12, pos = row & 4095;
          const size_t dr = (size_t)MP + b * SKEYS + pos; cvt8(p.in[2] + row * 256 + c8, KA + dr * 256 + c8); cvt8(p.in[3] + row * 256 + c8, VA + dr * 256 + c8); }
      for (size_t i = gt; i < (size_t)32 * PAST * 8; i += NT) { const size_t row = i >> 3, c8 = (i & 7) * 8; const size_t b = row >> 12, pos = row & 4095;
          const size_t dr = (size_t)MP + b * SKEYS + pos; cvt8(p.in[4] + row * 64 + c8, KI + dr * 64 + c8); } }
}

__device__ __forceinline__ void phase_conv(const Params& p, int tid) {
    unsigned char* ws = p.ws;
    const bf16* XBC = (const bf16*)(ws + WS_XBC); const float* DT = (const float*)(ws + WS_DT);
    bf16* XT = (bf16*)(ws + WS_XT); bf16* BN = (bf16*)(ws + WS_BN); bf16* BT = (bf16*)(ws + WS_BT); bf16* CN = (bf16*)(ws + WS_CN);
    float* ACUM = (float*)(ws + WS_ACUM); float* DTS = (float*)(ws + WS_DTS);
    const float* conv_w = p.in[9]; const float* conv_b = p.in[10]; const float* a_log = p.in[12]; const float* state_conv = p.in[6];
    for (int q = blockIdx.x; q < NQC; q += gridDim.x) {
        const bool samp = q >= 512; const int b = samp ? q - 512 : (q >> 8), c = samp ? 0 : (q & 255);
        const int row0 = samp ? MP + b * 32 : q * 64, nvalid = samp ? 32 : 64;
        if (tid < 32) { const int h = tid; const float A = -__expf(a_log[h]); float a = 0.f;
#pragma unroll 1
            for (int s0 = 0; s0 < 64; s0 += 16) { float dv[16];
#pragma unroll
                for (int i = 0; i < 16; ++i) dv[i] = (s0 + i < nvalid) ? DT[(size_t)(row0 + s0 + i) * 32 + h] : 0.f;
#pragma unroll
                for (int i = 0; i < 16; ++i) { a += dv[i] * A; ACUM[(q * 32 + h) * 64 + s0 + i] = a; DTS[(q * 32 + h) * 64 + s0 + i] = dv[i]; } } }
#pragma unroll 1
        for (int j = 0; j < 3; ++j) {
            const int ch = 2 * (tid + 512 * j);
            float w0[4], w1[4];
#pragma unroll
            for (int i = 0; i < 4; ++i) { w0[i] = conv_w[i * 3072 + ch]; w1[i] = conv_w[i * 3072 + ch + 1]; }
            const float bias0 = conv_b[ch], bias1 = conv_b[ch + 1];
            float h0[3], h1[3];
            if (samp) {
#pragma unroll
                for (int k = 0; k < 3; ++k) { h0[k] = state_conv[(size_t)(b * 3 + k) * 3072 + ch]; h1[k] = state_conv[(size_t)(b * 3 + k) * 3072 + ch + 1]; }
            } else if (c == 0) {
#pragma unroll
                for (int k = 0; k < 3; ++k) { h0[k] = 0.f; h1[k] = 0.f; }
            } else {
#pragma unroll
                for (int k = 0; k < 3; ++k) { const unsigned w = *(const unsigned*)(XBC + (size_t)(row0 - 3 + k) * 3072 + ch); h0[k] = lo_f(w); h1[k] = hi_f(w); }
            }
#pragma unroll 1
            for (int s0 = 0; s0 < 64; s0 += 8) {
                unsigned raw[8];
#pragma unroll
                for (int i = 0; i < 8; ++i) raw[i] = (s0 + i < nvalid) ? *(const unsigned*)(XBC + (size_t)(row0 + s0 + i) * 3072 + ch) : 0u;
                float o0[8], o1[8];
#pragma unroll
                for (int i = 0; i < 8; ++i) {
                    const float c0 = lo_f(raw[i]), c1 = hi_f(raw[i]);
                    const float v0 = bias0 + w0[0] * h0[0] + w0[1] * h0[1] + w0[2] * h0[2] + w0[3] * c0;
                    const float v1 = bias1 + w1[0] * h1[0] + w1[1] * h1[1] + w1[2] * h1[2] + w1[3] * c1;
                    const bool ok = (s0 + i) < nvalid;
                    o0[i] = ok ? siluf_(v0) : 0.f; o1[i] = ok ? siluf_(v1) : 0.f;
                    h0[0] = h0[1]; h0[1] = h0[2]; h0[2] = c0; h1[0] = h1[1]; h1[1] = h1[2]; h1[2] = c1;
                }
                u32x4 t0, t1;
                t0.x = pk2(o0[0], o0[1]); t0.y = pk2(o0[2], o0[3]); t0.z = pk2(o0[4], o0[5]); t0.w = pk2(o0[6], o0[7]);
                t1.x = pk2(o1[0], o1[1]); t1.y = pk2(o1[2], o1[3]); t1.z = pk2(o1[4], o1[5]); t1.w = pk2(o1[6], o1[7]);
                if (ch < 2048) {
                    const int h = ch >> 6, pp = ch & 63;
                    *(u32x4*)(XT + ((size_t)(q * 32 + h) * 64 + pp) * 64 + s0) = t0; *(u32x4*)(XT + ((size_t)(q * 32 + h) * 64 + pp + 1) * 64 + s0) = t1;
                } else if (ch < 2560) {
                    const int g = (ch - 2048) >> 7, n = (ch - 2048) & 127;
                    *(u32x4*)(BT + ((size_t)(q * 4 + g) * 128 + n) * 64 + s0) = t0; *(u32x4*)(BT + ((size_t)(q * 4 + g) * 128 + n + 1) * 64 + s0) = t1;
#pragma unroll
                    for (int i = 0; i < 8; ++i) *(unsigned*)(BN + ((size_t)(q * 4 + g) * 64 + s0 + i) * 128 + n) = pk2(o0[i], o1[i]);
                } else {
                    const int g = (ch - 2560) >> 7, n = (ch - 2560) & 127;
#pragma unroll
                    for (int i = 0; i < 8; ++i) *(unsigned*)(CN + ((size_t)(q * 4 + g) * 64 + s0 + i) * 128 + n) = pk2(o0[i], o1[i]);
                }
            }
        }
    }
}

__device__ __forceinline__ bf16x8 scale8(bf16x8 v, const float (&w)[8]) {
    const u32x4 u = __builtin_bit_cast(u32x4, v); u32x4 o;
    o.x = pk2(lo_f(u.x) * w[0], hi_f(u.x) * w[1]); o.y = pk2(lo_f(u.y) * w[2], hi_f(u.y) * w[3]);
    o.z = pk2(lo_f(u.z) * w[4], hi_f(u.z) * w[5]); o.w = pk2(lo_f(u.w) * w[6], hi_f(u.w) * w[7]);
    return __builtin_bit_cast(bf16x8, o);
}
__device__ __forceinline__ void phase_s1(const Params& p, int wave, int lane) {
    unsigned char* ws = p.ws;
    const bf16* XT = (const bf16*)(ws + WS_XT); const bf16* BT = (const bf16*)(ws + WS_BT);
    const float* ACUM = (const float*)(ws + WS_ACUM); const float* DTS = (const float*)(ws + WS_DTS);
    bf16* ST = (bf16*)(ws + WS_STATES);
    const int gw = blockIdx.x * 8 + wave, NGW = gridDim.x * 8, l32 = lane & 31, hh = lane >> 5;
#pragma unroll 1
    for (int it = gw; it < NQC * 32; it += NGW) {
        const int q = it >> 5, h = it & 31, g = h >> 3;
        const float* ac = ACUM + (q * 32 + h) * 64; const float* dts = DTS + (q * 32 + h) * 64;
        const float alast = ac[63];
#pragma unroll 1
        for (int pb = 0; pb < 2; ++pb) {
            f32x16 acc[4];
#pragma unroll
            for (int n = 0; n < 4; ++n)
#pragma unroll
                for (int e = 0; e < 16; ++e) acc[n][e] = 0.f;
#pragma unroll
            for (int kk = 0; kk < 4; ++kk) {
                const int s0 = 16 * kk + 8 * hh;
                float w[8];
                { const f32x4 a0 = *(const f32x4*)(ac + s0), a1 = *(const f32x4*)(ac + s0 + 4), d0 = *(const f32x4*)(dts + s0), d1 = *(const f32x4*)(dts + s0 + 4);
#pragma unroll
                  for (int e = 0; e < 4; ++e) { w[e] = __expf(alast - a0[e]) * d0[e]; w[4 + e] = __expf(alast - a1[e]) * d1[e]; } }
                const bf16x8 af = scale8(ldg8(XT + ((size_t)(q * 32 + h) * 64 + pb * 32 + l32) * 64 + s0), w);
#pragma unroll
                for (int nb = 0; nb < 4; ++nb) { const bf16x8 bfr = ldg8(BT + ((size_t)(q * 4 + g) * 128 + nb * 32 + l32) * 64 + s0); acc[nb] = MFMA32(af, bfr, acc[nb]); }
            }
            bf16* sp = ST + ((size_t)(q * 32 + h) * 64 + pb * 32 + 4 * hh) * 128 + l32;
#pragma unroll
            for (int nb = 0; nb < 4; ++nb)
#pragma unroll
                for (int e = 0; e < 16; ++e) sp[((e & 3) + 8 * (e >> 2)) * 128 + nb * 32] = f2bf(acc[nb][e]);
        }
    }
}

__device__ __forceinline__ void phase_s2(const Params& p, int tid) {
    unsigned char* ws = p.ws;
    bf16* ST = (bf16*)(ws + WS_STATES); const float* ACUM = (const float*)(ws + WS_ACUM);
    const size_t gt = (size_t)blockIdx.x * 512 + tid, NT = (size_t)gridDim.x * 512;
    for (size_t u = gt; u < 131072; u += NT) {
        const int b = (int)(u >> 16), e = (int)(u & 65535) * 4, h = e >> 13;
        f32x4 st = {0.f, 0.f, 0.f, 0.f};
#pragma unroll 1
        for (int c0 = 0; c0 < 256; c0 += 8) {
            u32x2 raw[8]; float dec[8];
#pragma unroll
            for (int i = 0; i < 8; ++i) { const int q = b * 256 + c0 + i; raw[i] = *(const u32x2*)(ST + (size_t)q * 262144 + e); dec[i] = ACUM[(q * 32 + h) * 64 + 63]; }
#pragma unroll
            for (int i = 0; i < 8; ++i) { const int q = b * 256 + c0 + i; u32x2 o; o.x = pk2(st[0], st[1]); o.y = pk2(st[2], st[3]); *(u32x2*)(ST + (size_t)q * 262144 + e) = o;
                const float d = __expf(dec[i]); st[0] = st[0] * d + lo_f(raw[i].x); st[1] = st[1] * d + hi_f(raw[i].x); st[2] = st[2] * d + lo_f(raw[i].y); st[3] = st[3] * d + hi_f(raw[i].y); }
        }
        *(f32x4*)(p.out + OUT_SSMP + (size_t)b * 262144 + e) = st;
    }
    for (size_t u = gt; u < (size_t)32 * 65536; u += NT) {
        const int b = (int)(u >> 16), e = (int)(u & 65535) * 4, h = e >> 13, q = 512 + b;
        const f32x4 h0 = *(const f32x4*)(p.in[5] + (size_t)b * 262144 + e);
        const u32x2 raw = *(const u32x2*)(ST + (size_t)q * 262144 + e);
        const float d = __expf(ACUM[(q * 32 + h) * 64 + 63]);
        u32x2 o; o.x = pk2(h0[0], h0[1]); o.y = pk2(h0[2], h0[3]); *(u32x2*)(ST + (size_t)q * 262144 + e) = o;
        f32x4 r; r[0] = h0[0] * d + lo_f(raw.x); r[1] = h0[1] * d + hi_f(raw.x); r[2] = h0[2] * d + lo_f(raw.y); r[3] = h0[3] * d + hi_f(raw.y);
        *(f32x4*)(p.out + OUT_SSMS + (size_t)b * 262144 + e) = r;
    }
}

constexpr int S3_MROW = 144;
constexpr int S3_YROW = 272;
constexpr int S3_WBYTES = 64 * S3_YROW;
constexpr int S3_SSQ_OFF = 8 * S3_WBYTES;
static_assert(S3_SSQ_OFF + 2048 <= LDS_BYTES, "S3 LDS");
__device__ __forceinline__ void phase_s3(const Params& p, LAS unsigned char* lds, int wave, int lane) {
    unsigned char* ws = p.ws;
    const bf16* XT = (const bf16*)(ws + WS_XT); const bf16* BN = (const bf16*)(ws + WS_BN); const bf16* CN = (const bf16*)(ws + WS_CN);
    const float* ACUM = (const float*)(ws + WS_ACUM); const float* DTS = (const float*)(ws + WS_DTS); const bf16* ST = (const bf16*)(ws + WS_STATES);
    bf16* ZY = (bf16*)(ws + WS_Z);
    const float* d_skip = p.in[13]; const float* norm_w = p.in[14];
    const int l32 = lane & 31, hh = lane >> 5;
    LAS unsigned char* Mw = lds + wave * S3_WBYTES;
    LAS float* SSQ = (LAS float*)(lds + S3_SSQ_OFF);
#pragma unroll 1
    for (int it = blockIdx.x; it < NQC * 4; it += gridDim.x) {
        const int q = it >> 2, g = it & 3, h = g * 8 + wave;
        const bool samp = q >= 512; const int row0 = samp ? MP + (q - 512) * 32 : q * 64, nvalid = samp ? 32 : 64;
        const float* ac = ACUM + (q * 32 + h) * 64; const float* dts = DTS + (q * 32 + h) * 64;
        const bf16* Cb = CN + (size_t)(q * 4 + g) * 64 * 128; const bf16* Bb = BN + (size_t)(q * 4 + g) * 64 * 128;
        const bf16* Xb = XT + (size_t)(q * 32 + h) * 64 * 64; const bf16* Hb = ST + (size_t)(q * 32 + h) * 64 * 128;
        bf16x8 cf[2][8];
#pragma unroll
        for (int tb = 0; tb < 2; ++tb)
#pragma unroll
            for (int kk = 0; kk < 8; ++kk) cf[tb][kk] = ldg8(Cb + (size_t)(tb * 32 + l32) * 128 + 16 * kk + 8 * hh);
        {
            f32x16 cb00, cb10, cb11;
#pragma unroll
            for (int e = 0; e < 16; ++e) { cb00[e] = 0.f; cb10[e] = 0.f; cb11[e] = 0.f; }
#pragma unroll
            for (int kk = 0; kk < 8; ++kk) {
                const bf16x8 b0 = ldg8(Bb + (size_t)(l32) * 128 + 16 * kk + 8 * hh), b1 = ldg8(Bb + (size_t)(32 + l32) * 128 + 16 * kk + 8 * hh);
                cb00 = MFMA32(cf[0][kk], b0, cb00); cb10 = MFMA32(cf[1][kk], b0, cb10); cb11 = MFMA32(cf[1][kk], b1, cb11);
            }
            const float as0 = ac[l32], as1 = ac[32 + l32], ds0 = dts[l32], ds1 = dts[32 + l32]; const float Dh = d_skip[h];
#pragma unroll
            for (int e = 0; e < 16; ++e) { const int tl = (e & 3) + 8 * (e >> 2) + 4 * hh; const float at0 = ac[tl], at1 = ac[32 + tl];
                { const int t = tl, s_ = l32; float m = (s_ <= t) ? cb00[e] * __expf(fminf(at0 - as0, 0.f)) * ds0 : 0.f; if (s_ == t) m += Dh; *(LAS unsigned short*)(Mw + t * S3_MROW + s_ * 2) = f2bf(m); }
                { const int t = tl; *(LAS unsigned short*)(Mw + t * S3_MROW + (32 + l32) * 2) = 0; }
                { const int t = 32 + tl, s_ = l32; const float m = cb10[e] * __expf(fminf(at1 - as0, 0.f)) * ds0; *(LAS unsigned short*)(Mw + t * S3_MROW + s_ * 2) = f2bf(m); }
                { const int t = 32 + tl, s_ = 32 + l32; float m = (s_ <= t) ? cb11[e] * __expf(fminf(at1 - as1, 0.f)) * ds1 : 0.f; if (s_ == t) m += Dh; *(LAS unsigned short*)(Mw + t * S3_MROW + s_ * 2) = f2bf(m); } }
        }
        f32x16 y[2][2];
#pragma unroll
        for (int a = 0; a < 2; ++a)
#pragma unroll
            for (int b = 0; b < 2; ++b)
#pragma unroll
                for (int e = 0; e < 16; ++e) y[a][b][e] = 0.f;
#pragma unroll
        for (int kk = 0; kk < 8; ++kk) {
            const bf16x8 h0 = ldg8(Hb + (size_t)(l32) * 128 + 16 * kk + 8 * hh), h1 = ldg8(Hb + (size_t)(32 + l32) * 128 + 16 * kk + 8 * hh);
            y[0][0] = MFMA32(cf[0][kk], h0, y[0][0]); y[0][1] = MFMA32(cf[0][kk], h1, y[0][1]);
            y[1][0] = MFMA32(cf[1][kk], h0, y[1][0]); y[1][1] = MFMA32(cf[1][kk], h1, y[1][1]);
        }
#pragma unroll
        for (int tb = 0; tb < 2; ++tb)
#pragma unroll
            for (int e = 0; e < 16; ++e) { const float sc = __expf(ac[tb * 32 + (e & 3) + 8 * (e >> 2) + 4 * hh]); y[tb][0][e] *= sc; y[tb][1][e] *= sc; }
        __syncthreads();
#pragma unroll
        for (int kk = 0; kk < 4; ++kk) {
            const bf16x8 x0 = ldg8(Xb + (size_t)(l32) * 64 + 16 * kk + 8 * hh), x1 = ldg8(Xb + (size_t)(32 + l32) * 64 + 16 * kk + 8 * hh);
            const bf16x8 m0 = *(const LAS bf16x8*)(Mw + (l32) * S3_MROW + (16 * kk + 8 * hh) * 2), m1 = *(const LAS bf16x8*)(Mw + (32 + l32) * S3_MROW + (16 * kk + 8 * hh) * 2);
            y[0][0] = MFMA32(m0, x0, y[0][0]); y[0][1] = MFMA32(m0, x1, y[0][1]);
            y[1][0] = MFMA32(m1, x0, y[1][0]); y[1][1] = MFMA32(m1, x1, y[1][1]);
        }
        asm volatile("s_waitcnt lgkmcnt(0)" ::: "memory"); __builtin_amdgcn_wave_barrier();
#pragma unroll
        for (int tb = 0; tb < 2; ++tb)
#pragma unroll
            for (int pb = 0; pb < 2; ++pb)
#pragma unroll
                for (int e = 0; e < 16; ++e) *(LAS float*)(Mw + (tb * 32 + (e & 3) + 8 * (e >> 2) + 4 * hh) * S3_YROW + (pb * 32 + l32) * 4) = y[tb][pb][e];
        asm volatile("s_waitcnt lgkmcnt(0)" ::: "memory"); __builtin_amdgcn_wave_barrier();
        const int r8 = lane >> 3, c8 = lane & 7;
        float hv[8][8];
#pragma unroll
        for (int it = 0; it < 8; ++it) { const int t = it * 8 + r8; const int tr = (t < nvalid) ? t : 0;
            const f32x4 y0 = *(const LAS f32x4*)(Mw + t * S3_YROW + c8 * 32), y1 = *(const LAS f32x4*)(Mw + t * S3_YROW + c8 * 32 + 16);
            const u32x4 zw = *(const u32x4*)(ZY + (size_t)(row0 + tr) * 2048 + h * 64 + c8 * 8);
            float zf[8]; zf[0] = lo_f(zw.x); zf[1] = hi_f(zw.x); zf[2] = lo_f(zw.y); zf[3] = hi_f(zw.y); zf[4] = lo_f(zw.z); zf[5] = hi_f(zw.z); zf[6] = lo_f(zw.w); zf[7] = hi_f(zw.w);
            float sq = 0.f;
#pragma unroll
            for (int k = 0; k < 4; ++k) { hv[it][k] = y0[k] * siluf_(zf[k]); hv[it][4 + k] = y1[k] * siluf_(zf[4 + k]); sq += hv[it][k] * hv[it][k] + hv[it][4 + k] * hv[it][4 + k]; }
            sq += __shfl_xor(sq, 1); sq += __shfl_xor(sq, 2); sq += __shfl_xor(sq, 4);
            if (c8 == 0) SSQ[wave * 64 + t] = sq; }
        __syncthreads();
        float nw[8];
        { const f32x4 n0 = *(const f32x4*)(norm_w + h * 64 + c8 * 8), n1 = *(const f32x4*)(norm_w + h * 64 + c8 * 8 + 4);
#pragma unroll
          for (int k = 0; k < 4; ++k) { nw[k] = n0[k]; nw[4 + k] = n1[k]; } }
#pragma unroll
        for (int it = 0; it < 8; ++it) { const int t = it * 8 + r8;
            float sm = 0.f;
#pragma unroll
            for (int w = 0; w < 8; ++w) sm += SSQ[w * 64 + t];
            const float rs = rsqrtf(sm * (1.0f / 512.0f) + RMS_EPS);
            if (t < nvalid) { u32x4 o; o.x = pk2(hv[it][0] * rs * nw[0], hv[it][1] * rs * nw[1]); o.y = pk2(hv[it][2] * rs * nw[2], hv[it][3] * rs * nw[3]);
                o.z = pk2(hv[it][4] * rs * nw[4], hv[it][5] * rs * nw[5]); o.w = pk2(hv[it][6] * rs * nw[6], hv[it][7] * rs * nw[7]);
                *(u32x4*)(ZY + (size_t)(row0 + t) * 2048 + h * 64 + c8 * 8) = o; } }
    }
}

constexpr int IX_HIST_OFF = 131072;
constexpr int IX_CNT_OFF = IX_HIST_OFF + 8192;
constexpr int IX_TAU_OFF = IX_CNT_OFF + 256;
constexpr int IX_MISC_OFF = IX_TAU_OFF + 256;
static_assert(IX_MISC_OFF + 16 <= LDS_BYTES, "indexer LDS");
#define WAVE_LDS_FENCE() do { asm volatile("s_waitcnt lgkmcnt(0)" ::: "memory"); __builtin_amdgcn_wave_barrier(); } while (0)

__device__ __forceinline__ void ix_prune(LAS unsigned* cr, LAS unsigned* hist, LAS unsigned* cntp, LAS unsigned* taup, int n, int lane) {
    unsigned v[8];
#pragma unroll
    for (int i = 0; i < 8; ++i) { const int idx = lane + 64 * i; v[i] = (idx < n) ? cr[idx] : 0u; }
    unsigned prefix = 0u, mask = 0u, kth = 256u;
#pragma unroll 1
    for (int r = 0; r < 4; ++r) {
        const int shift = 24 - 8 * r;
#pragma unroll
        for (int j = 0; j < 4; ++j) hist[lane * 4 + j] = 0u;
        WAVE_LDS_FENCE();
#pragma unroll
        for (int i = 0; i < 8; ++i) if (v[i] != 0u && (v[i] & mask) == prefix) __hip_atomic_fetch_add(&hist[(v[i] >> shift) & 255u], 1u, __ATOMIC_RELAXED, __HIP_MEMORY_SCOPE_WORKGROUP);
        WAVE_LDS_FENCE();
        const unsigned h0 = hist[lane * 4 + 0], h1 = hist[lane * 4 + 1], h2 = hist[lane * 4 + 2], h3 = hist[lane * 4 + 3];
        const unsigned lsum = h0 + h1 + h2 + h3;
        unsigned s = lsum;
#pragma unroll
        for (int o = 1; o < 64; o <<= 1) { const unsigned t = __shfl_down(s, o); if (lane + o < 64) s += t; }
        const unsigned a3 = s - lsum, a2 = a3 + h3, a1 = a2 + h2, a0 = a1 + h1;
        int found = -1; unsigned abv = 0u;
        if (a3 < kth && kth <= a3 + h3) { found = 3; abv = a3; }
        else if (a2 < kth && kth <= a2 + h2) { found = 2; abv = a2; }
        else if (a1 < kth && kth <= a1 + h1) { found = 1; abv = a1; }
        else if (a0 < kth && kth <= a0 + h0) { found = 0; abv = a0; }
        const unsigned long long bal = __ballot(found >= 0);
        const int src = (bal != 0ull) ? (__ffsll((long long)bal) - 1) : 0;
        const int bin = __shfl(lane * 4 + (found < 0 ? 0 : found), src); const unsigned ab = __shfl(abv, src);
        kth -= ab; prefix |= (unsigned)bin << shift; mask |= 0xFFu << shift;
        WAVE_LDS_FENCE();
    }
    unsigned base = 0u;
#pragma unroll
    for (int i = 0; i < 8; ++i) { const bool keep = (v[i] != 0u) && (v[i] >= prefix); const unsigned long long bal = __ballot(keep);
        const unsigned pos = base + (unsigned)__popcll(bal & ((1ull << lane) - 1ull)); if (keep) cr[pos] = v[i]; base += (unsigned)__popcll(bal); }
    if (lane == 0) { *cntp = base; *taup = prefix; }
    WAVE_LDS_FENCE();
}

__device__ __forceinline__ void phase_indexer(const Params& p, LAS unsigned char* lds, int tid, int wave, int lane) {
    unsigned char* ws = p.ws;
    const bf16* QI = (const bf16*)(ws + WS_QI); const bf16* KI = (const bf16*)(ws + WS_KIALL); const float* WI = (const float*)(ws + WS_WI);
    unsigned short* SEL = (unsigned short*)(ws + WS_SEL);
    unsigned* queue = (unsigned*)(ws + WS_CTL) + CW_QUEUE;
    LAS unsigned* cand = (LAS unsigned*)lds; LAS unsigned* hist = (LAS unsigned*)(lds + IX_HIST_OFF) + wave * 256;
    LAS unsigned* cnt = (LAS unsigned*)(lds + IX_CNT_OFF); LAS unsigned* tau = (LAS unsigned*)(lds + IX_TAU_OFF); LAS unsigned* misc = (LAS unsigned*)(lds + IX_MISC_OFF);
    const int fr = lane & 15, fq = lane >> 4, rb = wave >> 1, cbase = (wave & 1) * 32;
#pragma unroll 1
    for (;;) {
        if (tid == 0) misc[0] = __hip_atomic_fetch_add(queue, 1u, __ATOMIC_RELAXED, __HIP_MEMORY_SCOPE_AGENT);
        __syncthreads();
        const int item = (int)misc[0];
        __syncthreads();
        if (item >= NQC) break;
        bool samp = false; int b, c = 0;
        if (item < 384) { b = item & 1; c = 255 - (item >> 1); }
        else if (item < 416) { samp = true; b = item - 384; }
        else { const int j = item - 32; b = j & 1; c = 255 - (j >> 1); }
        const int qrow0 = samp ? MP + b * 32 : b * SEQP + c * 64, nrows = samp ? 32 : 64;
        const int krow0 = samp ? MP + b * SKEYS : b * SEQP, nkeys = samp ? SKEYS : 64 * (c + 1), ntiles = (nkeys + 63) >> 6;
        if (tid < 64) { cnt[tid] = 0u; tau[tid] = 0u; }
        const bool active = rb * 16 < nrows;
        bf16x8 af[8][2]; float wv[8][4];
        { int ar = rb * 16 + fr; if (ar > nrows - 1) ar = nrows - 1; const bf16* qp = QI + (size_t)(qrow0 + ar) * 512 + 8 * fq;
#pragma unroll
          for (int h = 0; h < 8; ++h) { af[h][0] = ldg8(qp + h * 64); af[h][1] = ldg8(qp + h * 64 + 32); }
#pragma unroll
          for (int r = 0; r < 4; ++r) { int wr_ = rb * 16 + 4 * fq + r; if (wr_ > nrows - 1) wr_ = nrows - 1; const float* wp = WI + (size_t)(qrow0 + wr_) * 8;
              const f32x4 w0 = *(const f32x4*)wp, w1 = *(const f32x4*)(wp + 4);
#pragma unroll
              for (int e = 0; e < 4; ++e) { wv[e][r] = w0[e]; wv[4 + e][r] = w1[e]; } } }
        __syncthreads();
        bf16x8 bc[2][2], bn[2][2];
#pragma unroll
        for (int cbi = 0; cbi < 2; ++cbi) { int key = cbase + 16 * cbi + fr; if (key > nkeys - 1) key = nkeys - 1; const bf16* kp = KI + (size_t)(krow0 + key) * 64 + 8 * fq; bc[cbi][0] = ldg8(kp); bc[cbi][1] = ldg8(kp + 32); }
#pragma unroll 1
        for (int tile = 0; tile < ntiles; ++tile) {
            if (tile + 1 < ntiles) {
#pragma unroll
                for (int cbi = 0; cbi < 2; ++cbi) { int key = (tile + 1) * 64 + cbase + 16 * cbi + fr; if (key > nkeys - 1) key = nkeys - 1; const bf16* kp = KI + (size_t)(krow0 + key) * 64 + 8 * fq; bn[cbi][0] = ldg8(kp); bn[cbi][1] = ldg8(kp + 32); }
            }
            if (active) {
                unsigned tq[4];
#pragma unroll
                for (int r = 0; r < 4; ++r) tq[r] = tau[rb * 16 + 4 * fq + r];
#pragma unroll
                for (int cbi = 0; cbi < 2; ++cbi) {
                    f32x4 sc = {0.f, 0.f, 0.f, 0.f};
#pragma unroll
                    for (int h = 0; h < 8; ++h) { f32x4 d = {0.f, 0.f, 0.f, 0.f}; d = MFMA16(af[h][0], bc[cbi][0], d); d = MFMA16(af[h][1], bc[cbi][1], d);
#pragma unroll
                        for (int r = 0; r < 4; ++r) sc[r] += wv[h][r] * fmaxf(d[r], 0.f); }
                    const int kidx = tile * 64 + cbase + 16 * cbi + fr;
                    if (kidx < nkeys) {
#pragma unroll
                        for (int r = 0; r < 4; ++r) { const int row = rb * 16 + 4 * fq + r;
                            const unsigned u = __float_as_uint(sc[r] + 0.0f); const unsigned mono = (u & 0x80000000u) ? ~u : (u | 0x80000000u);
                            const unsigned packed = (mono & 0xFFFFC000u) | (unsigned)(16383 - kidx);
                            if (packed > tq[r] && row < nrows) { const unsigned slot = __hip_atomic_fetch_add(&cnt[row], 1u, __ATOMIC_RELAXED, __HIP_MEMORY_SCOPE_WORKGROUP); cand[row * 512 + slot] = packed; } }
                    }
                }
            }
            __syncthreads();
#pragma unroll 1
            for (int rr = 0; rr < 8; ++rr) { const int row = wave * 8 + rr; const int n = (int)cnt[row]; if (n > 448) ix_prune(cand + row * 512, hist, cnt + row, tau + row, n, lane); }
            __syncthreads();
#pragma unroll
            for (int cbi = 0; cbi < 2; ++cbi) { bc[cbi][0] = bn[cbi][0]; bc[cbi][1] = bn[cbi][1]; }
        }
#pragma unroll 1
        for (int rr = 0; rr < 8; ++rr) { const int row = wave * 8 + rr;
            if (row < nrows) { int n = (int)cnt[row]; if (n > 256) { ix_prune(cand + row * 512, hist, cnt + row, tau + row, n, lane); n = 256; }
                unsigned short* sp = SEL + (size_t)(qrow0 + row) * 256;
#pragma unroll
                for (int i = 0; i < 4; ++i) { const int k = lane + 64 * i; if (k < n) sp[k] = (unsigned short)(16383u - (cand[row * 512 + k] & 16383u)); } } }
        __syncthreads();
    }
}

constexpr int AT_BIAS_OFF = 131072;
constexpr int AT_T5_OFF = AT_BIAS_OFF + 2048;
constexpr int AT_SEL_OFF = AT_T5_OFF + 512;
static_assert(AT_SEL_OFF + 4096 <= LDS_BYTES, "attention LDS");
__device__ __forceinline__ void unpack8(const u32x4 w, float (&f)[8]) { f[0] = lo_f(w.x); f[1] = hi_f(w.x); f[2] = lo_f(w.y); f[3] = hi_f(w.y); f[4] = lo_f(w.z); f[5] = hi_f(w.z); f[6] = lo_f(w.w); f[7] = hi_f(w.w); }
__device__ __forceinline__ void phase_attn(const Params& p, LAS unsigned char* lds, int tid, int wave, int lane) {
    unsigned char* ws = p.ws;
    bf16* QO = (bf16*)(ws + WS_Q); const bf16* KA = (const bf16*)(ws + WS_KALL); const bf16* VA = (const bf16*)(ws + WS_VALL);
    const unsigned short* SEL = (const unsigned short*)(ws + WS_SEL);
    LAS float* bias = (LAS float*)(lds + AT_BIAS_OFF); LAS int* t5 = (LAS int*)(lds + AT_T5_OFF);
    LAS float* L = (LAS float*)lds + wave * 4096; LAS unsigned short* S = (LAS unsigned short*)(lds + AT_SEL_OFF) + wave * 256;
    bias[tid] = p.in[7][tid];
    if (tid < 128) { const int n = tid; int v; if (n < 8) v = n; else { int k2 = 0; while (k2 < 12 && n * n >= (64 << (k2 + 1))) ++k2; v = 8 + k2; if (v > 15) v = 15; } t5[n] = v; }
    __syncthreads();
    const int half = lane >> 5, l32 = lane & 31, j = l32 >> 3, sub = l32 & 7, d0 = 8 * sub;
    const int gw = blockIdx.x * 8 + wave, NGW = gridDim.x * 8;
#pragma unroll 1
    for (int qr = gw; qr < MT; qr += NGW) {
        int krow0, pos, nsel;
        if (qr < MP) { const int b = qr >> 14, t = qr & 16383; krow0 = b * SEQP; pos = t; nsel = 64 * ((t >> 6) + 1); if (nsel > 256) nsel = 256; }
        else { const int rs = qr - MP, b = rs >> 5, t = rs & 31; krow0 = MP + b * SKEYS; pos = PAST + t; nsel = 256; }
#pragma unroll
        for (int i = 0; i < 4; ++i) { const int k = lane + 64 * i; S[k] = (k < nsel) ? SEL[(size_t)qr * 256 + k] : (unsigned short)0; }
        float qf[4][8];
#pragma unroll
        for (int g = 0; g < 4; ++g) { const u32x4 w = *(const u32x4*)(QO + (size_t)qr * 1024 + (4 * j + g) * 64 + d0); unpack8(w, qf[g]);
#pragma unroll
            for (int e = 0; e < 8; ++e) qf[g][e] *= 0.125f; }
        WAVE_LDS_FENCE();
#pragma unroll 2
        for (int i = 0; i < 128; ++i) {
            const int ks = 2 * i + half; const bool valid = ks < nsel; const int idx = valid ? (int)S[ks] : 0;
            const u32x4 kraw = *(const u32x4*)(KA + (size_t)(krow0 + idx) * 256 + 8 * l32);
            float kf[8]; unpack8(kraw, kf);
            float pt[4];
#pragma unroll
            for (int g = 0; g < 4; ++g) { float s = 0.f;
#pragma unroll
                for (int e = 0; e < 8; ++e) s += qf[g][e] * kf[e];
                pt[g] = s; }
#pragma unroll
            for (int g = 0; g < 4; ++g) { pt[g] += __shfl_xor(pt[g], 1); pt[g] += __shfl_xor(pt[g], 2); pt[g] += __shfl_xor(pt[g], 4); }
            if (sub < 4) { const float mine = (sub == 0) ? pt[0] : (sub == 1) ? pt[1] : (sub == 2) ? pt[2] : pt[3];
                const int h = 4 * j + sub, rel = idx - pos, n = rel < 0 ? -rel : rel; const int bk = (rel > 0 ? 16 : 0) + (n < 128 ? t5[n] : 15);
                L[ks * 16 + h] = valid ? mine + bias[bk * 16 + h] : -INFINITY; }
        }
        WAVE_LDS_FENCE();
        { const int h = lane & 15, kq = lane >> 4; LAS float* lp = L + (kq * 64) * 16 + h;
          float v[64]; float m = -INFINITY;
#pragma unroll
          for (int k = 0; k < 64; ++k) { v[k] = lp[k * 16]; m = fmaxf(m, v[k]); }
          m = fmaxf(m, __shfl_xor(m, 16)); m = fmaxf(m, __shfl_xor(m, 32));
          float s = 0.f;
#pragma unroll
          for (int k = 0; k < 64; ++k) { v[k] = __expf(v[k] - m); s += v[k]; }
          s += __shfl_xor(s, 16); s += __shfl_xor(s, 32);
          const float inv = 1.0f / s;
#pragma unroll
          for (int k = 0; k < 64; ++k) lp[k * 16] = v[k] * inv; }
        WAVE_LDS_FENCE();
        float acc[4][8];
#pragma unroll
        for (int g = 0; g < 4; ++g)
#pragma unroll
            for (int e = 0; e < 8; ++e) acc[g][e] = 0.f;
#pragma unroll 2
        for (int i = 0; i < 128; ++i) {
            const int ks = 2 * i + half; const int idx = (ks < nsel) ? (int)S[ks] : 0;
            const u32x4 vraw = *(const u32x4*)(VA + (size_t)(krow0 + idx) * 256 + 8 * l32);
            const f32x4 pr = *(const LAS f32x4*)(L + ks * 16 + 4 * j);
            float vf[8]; unpack8(vraw, vf);
#pragma unroll
            for (int g = 0; g < 4; ++g)
#pragma unroll
                for (int e = 0; e < 8; ++e) acc[g][e] += pr[g] * vf[e];
        }
#pragma unroll
        for (int g = 0; g < 4; ++g)
#pragma unroll
            for (int e = 0; e < 8; ++e) acc[g][e] += __shfl_xor(acc[g][e], 32);
        if (half == 0) {
#pragma unroll
            for (int g = 0; g < 4; ++g) { u32x4 o; o.x = pk2(acc[g][0], acc[g][1]); o.y = pk2(acc[g][2], acc[g][3]); o.z = pk2(acc[g][4], acc[g][5]); o.w = pk2(acc[g][6], acc[g][7]);
                *(u32x4*)(QO + (size_t)qr * 1024 + (4 * j + g) * 64 + d0) = o; }
        }
        WAVE_LDS_FENCE();
    }
}

template <bool TO_BF16>
__device__ __forceinline__ void phase_ln(const float* src, void* dst, const float* gam, const float* bet, int wave, int lane) {
    const int gw = blockIdx.x * 8 + wave, NGW = gridDim.x * 8;
    f32x4 gv[4], bv[4];
#pragma unroll
    for (int jj = 0; jj < 4; ++jj) { gv[jj] = *(const f32x4*)(gam + lane * 4 + 256 * jj); bv[jj] = *(const f32x4*)(bet + lane * 4 + 256 * jj); }
#pragma unroll 1
    for (int r = gw; r < MT; r += NGW) {
        const float* xr = src + (size_t)r * 1024 + lane * 4;
        f32x4 v[4]; float s = 0.f;
#pragma unroll
        for (int jj = 0; jj < 4; ++jj) { v[jj] = *(const f32x4*)(xr + 256 * jj); s += (v[jj][0] + v[jj][1]) + (v[jj][2] + v[jj][3]); }
        const float mean = wave_sum(s) * (1.0f / 1024.0f); float s2 = 0.f;
#pragma unroll
        for (int jj = 0; jj < 4; ++jj) { v[jj] = v[jj] - mean; s2 += (v[jj][0] * v[jj][0] + v[jj][1] * v[jj][1]) + (v[jj][2] * v[jj][2] + v[jj][3] * v[jj][3]); }
        const float rstd = rsqrtf(wave_sum(s2) * (1.0f / 1024.0f) + LN_EPS);
#pragma unroll
        for (int jj = 0; jj < 4; ++jj) { const f32x4 o = v[jj] * rstd * gv[jj] + bv[jj];
            if (TO_BF16) { u32x2 w; w.x = pk2(o[0], o[1]); w.y = pk2(o[2], o[3]); *(u32x2*)((bf16*)dst + (size_t)r * 1024 + lane * 4 + 256 * jj) = w; }
            else *(f32x4*)((float*)dst + (size_t)r * 1024 + lane * 4 + 256 * jj) = o; }
    }
}

__global__ void __launch_bounds__(512, 2) hybrid_fwd(Params p) {
    extern __shared__ __attribute__((aligned(16))) unsigned char lds_raw[];
    LAS unsigned char* lds = (LAS unsigned char*)lds_raw;
    cg::grid_group grid = cg::this_grid();
    const int tid = threadIdx.x, lane = tid & 63, wave = __builtin_amdgcn_readfirstlane(tid >> 6);
    unsigned char* ws = p.ws;
#ifndef PHASE_MASK
#define PHASE_MASK 0x7fff
#endif
#define IN(k) (((PHASE_MASK >> (k)) & 1) && p.ph_lo <= (k) && (k) < p.ph_hi)
    if (IN(0)) phase_prologue(p, lds, tid, wave, lane);
    grid.sync();
    if (IN(1)) {
        pg8::Gemm g{(const bf16*)(ws + WS_XB), (const bf16*)(ws + WS_WIN), MT, NIN, 1024}; pg8::StaticOrder S; S.init(MT, NIN, gridDim.x, blockIdx.x);
        pg8::EpiInProj E{(bf16*)(ws + WS_Z), (bf16*)(ws + WS_XBC), (bf16*)(ws + WS_Q), (bf16*)(ws + WS_KALL), (bf16*)(ws + WS_VALL), (bf16*)(ws + WS_QI), (bf16*)p.out, (bf16*)(ws + WS_KIALL),
                         (float*)(ws + WS_DT), (float*)(ws + WS_WI), p.out, p.in[11]};
        pg8::gemm_phase<pg8::EpiInProj, pg8::StaticOrder, true, true>(lds, g, S, E);
    }
    grid.sync();
    if (IN(2)) phase_indexer(p, lds, tid, wave, lane);
    grid.sync();
    if (IN(3)) phase_attn(p, lds, tid, wave, lane);
    grid.sync();
    if (IN(4)) phase_conv(p, tid);
    grid.sync();
    if (IN(5)) phase_s1(p, wave, lane);
    grid.sync();
    if (IN(6)) phase_s2(p, tid);
    grid.sync();
    if (IN(7)) phase_s3(p, lds, wave, lane);
    grid.sync();
    if (IN(8)) {
        pg8::Gemm g{(const bf16*)(ws + WS_Z), (const bf16*)(ws + WS_WSSD), MT, 1024, 2048}; pg8::StaticOrder S; S.init(MT, 1024, gridDim.x, blockIdx.x);
        pg8::EpiMixA E{(const bf16*)p.out, (float*)(ws + WS_T)};
        pg8::gemm_phase<pg8::EpiMixA, pg8::StaticOrder, true, true>(lds, g, S, E);
    }
    grid.sync();
    if (IN(9)) {
        pg8::Gemm g{(const bf16*)(ws + WS_Q), (const bf16*)(ws + WS_WATT), MT, 1024, 1024}; pg8::StaticOrder S; S.init(MT, 1024, gridDim.x, blockIdx.x);
        pg8::EpiMixB E{(const bf16*)p.out, (const float*)(ws + WS_T), (bf16*)(ws + WS_MIX)};
        pg8::gemm_phase<pg8::EpiMixB, pg8::StaticOrder, true, true>(lds, g, S, E);
    }
    grid.sync();
    if (IN(10)) {
        pg8::Gemm g{(const bf16*)(ws + WS_MIX), (const bf16*)(ws + WS_WOUT), MT, 1024, 1024}; pg8::StaticOrder S; S.init(MT, 1024, gridDim.x, blockIdx.x);
        pg8::EpiResX E{p.in[0], p.in[1], (float*)(ws + WS_PRE1)};
        pg8::gemm_phase<pg8::EpiResX, pg8::StaticOrder, true, true>(lds, g, S, E);
    }
    grid.sync();
    if (IN(11)) phase_ln<true>((const float*)(ws + WS_PRE1), (void*)(ws + WS_H1), p.in[18], p.in[19], wave, lane);
    grid.sync();
    if (IN(12)) {
        pg8::Gemm g{(const bf16*)(ws + WS_H1), (const bf16*)(ws + WS_WUP), MT, 4096, 1024}; pg8::StaticOrder S; S.init(MT, 4096, gridDim.x, blockIdx.x);
        pg8::EpiSqRelu E{(bf16*)(ws + WS_HID)};
        pg8::gemm_phase<pg8::EpiSqRelu, pg8::StaticOrder, true, true>(lds, g, S, E);
    }
    grid.sync();
    if (IN(13)) {
        pg8::Gemm g{(const bf16*)(ws + WS_HID), (const bf16*)(ws + WS_WDN), MT, 1024, 4096}; pg8::StaticOrder S; S.init(MT, 1024, gridDim.x, blockIdx.x);
        pg8::EpiResH E{(const bf16*)(ws + WS_H1), p.out};
        pg8::gemm_phase<pg8::EpiResH, pg8::StaticOrder, true, true>(lds, g, S, E);
    }
    grid.sync();
    if (IN(14)) phase_ln<false>(p.out, (void*)p.out, p.in[22], p.in[23], wave, lane);
#undef IN
}

extern "C" void kernel_launch(void* const* d_in, const int* in_sizes, int n_in, void* d_out, int out_size, void* d_ws, size_t ws_size, hipStream_t stream) {
    static int grid = 0;
    if (grid == 0) {
        int dev = 0, cus = 0, per_cu = 0;
        if (n_in != 24 || out_size != OUT_TOTAL || ws_size < WS_END) { fprintf(stderr, "kernel_launch: unexpected shapes (n_in %d out %d ws %zu, need %zu)\n", n_in, out_size, ws_size, (size_t)WS_END); grid = -1; return; }
        (void)hipGetDevice(&dev);
        (void)hipDeviceGetAttribute(&cus, hipDeviceAttributeMultiprocessorCount, dev);
        (void)hipFuncSetAttribute((const void*)hybrid_fwd, hipFuncAttributeMaxDynamicSharedMemorySize, LDS_BYTES);
        (void)hipOccupancyMaxActiveBlocksPerMultiprocessor(&per_cu, (const void*)hybrid_fwd, 512, LDS_BYTES);
        if (per_cu < 1) { fprintf(stderr, "kernel_launch: occupancy query says %d blocks per CU\n", per_cu); grid = -1; return; }
        grid = cus;
    }
    if (grid < 0) return;
    (void)hipMemsetAsync(d_ws, 0, 4096, stream);
    Params p{};
    for (int i = 0; i < 24; ++i) p.in[i] = (const float*)d_in[i];
    p.out = (float*)d_out; p.ws = (unsigned char*)d_ws; p.ph_lo = 0; p.ph_hi = 100;
    void* args[] = {&p};
    hipError_t e = hipLaunchCooperativeKernel((const void*)hybrid_fwd, dim3(grid), dim3(512), args, LDS_BYTES, stream);
    if (e != hipSuccess) fprintf(stderr, "cooperative launch failed: %s (grid %d)\n", hipGetErrorString(e), grid);
}
```

```cpp
#include <hip/hip_runtime.h>
#include <hip/hip_cooperative_groups.h>
#include <cstdint>
#include <cstdio>
#include <cmath>
namespace cg = cooperative_groups;

constexpr int MP = 32768, MS = 1024, MT = MP + MS;
constexpr int DM = 1024, NIN = 9472;
constexpr int SEQP = 16384, PAST = 4096, SKEYS = 4128;
constexpr int NQC = 544;
constexpr int KROWS = MP + 32 * SKEYS;
constexpr float ALPHA = 1.189207115002721f;
constexpr float LN_EPS = 1e-5f, RMS_EPS = 1e-5f;

constexpr int OUT_YP = 0, OUT_YS = 33554432, OUT_KP = 34603008, OUT_VP = 42991616, OUT_KIP = 51380224, OUT_SSMP = 53477376,
              OUT_CONVP = 54001664, OUT_KS = 54020096, OUT_VS = 54282240, OUT_KIS = 54544384, OUT_SSMS = 54609920, OUT_CONVS = 62998528,
              OUT_TOTAL = 63293440;

constexpr size_t WS_CTL = 0;
constexpr size_t WS_WIN = 1048576;
constexpr size_t WS_WSSD = WS_WIN + (size_t)NIN * 1024 * 2;
constexpr size_t WS_WATT = WS_WSSD + 4194304;
constexpr size_t WS_WOUT = WS_WATT + 2097152;
constexpr size_t WS_WUP = WS_WOUT + 2097152;
constexpr size_t WS_WDN = WS_WUP + 8388608;
constexpr size_t WS_Q = WS_WDN + 8388608;
constexpr size_t WS_Z = WS_Q + (size_t)MT * 2048;
constexpr size_t WS_DT = WS_Z + (size_t)MT * 4096;
constexpr size_t WS_WI = WS_DT + (size_t)MT * 128;
constexpr size_t WS_R46 = WS_WI + (size_t)MT * 32;
constexpr size_t SZ_R46 = 258998272;
constexpr size_t WS_R57 = WS_R46 + SZ_R46;
constexpr size_t SZ_R57 = 285212672;
constexpr size_t WS_END = WS_R57 + SZ_R57;
constexpr size_t WS_KALL = WS_R46;
constexpr size_t WS_VALL = WS_KALL + (size_t)KROWS * 256;
constexpr size_t WS_KIALL = WS_VALL + (size_t)KROWS * 256;
constexpr size_t WS_QI = WS_KIALL + (size_t)KROWS * 128;
constexpr size_t WS_SEL = WS_QI + (size_t)MT * 1024;
static_assert(WS_SEL + (size_t)MT * 512 <= WS_R46 + SZ_R46, "region A life 1");
constexpr size_t WS_XT = WS_R46;
constexpr size_t WS_BN = WS_XT + (size_t)NQC * 64 * 2048 * 2;
constexpr size_t WS_BT = WS_BN + (size_t)NQC * 64 * 512 * 2;
constexpr size_t WS_CN = WS_BT + (size_t)NQC * 64 * 512 * 2;
constexpr size_t WS_ACUM = WS_CN + (size_t)NQC * 64 * 512 * 2;
constexpr size_t WS_DTS = WS_ACUM + (size_t)NQC * 32 * 64 * 4;
static_assert(WS_DTS + (size_t)NQC * 32 * 64 * 4 <= WS_R46 + SZ_R46, "region A life 2");
constexpr size_t WS_T = WS_R46;
constexpr size_t WS_MIX = WS_T + (size_t)MT * 4096;
constexpr size_t WS_H1 = WS_R46;
static_assert(WS_MIX + (size_t)MT * 2048 <= WS_R46 + SZ_R46, "region A life 3");
constexpr size_t WS_XB = WS_R57;
constexpr size_t WS_XBC = WS_XB + (size_t)MT * 2048;
static_assert(WS_XBC + (size_t)MT * 6144 <= WS_R57 + SZ_R57, "region B life 1");
constexpr size_t WS_STATES = WS_R57;
static_assert((size_t)NQC * 32 * 64 * 128 * 2 <= SZ_R57, "region B life 2");
constexpr size_t WS_PRE1 = WS_R57;
constexpr size_t WS_HID = WS_R57;
static_assert((size_t)MT * 8192 <= SZ_R57, "region B life 3");
constexpr int CW_QUEUE = 64, CW_ATT = 1024, CW_BAR = 4096;

constexpr int LDS_BYTES = 159744;
#define LAS __attribute__((address_space(3)))

typedef unsigned short bf16;
typedef unsigned u32x4 __attribute__((ext_vector_type(4)));
typedef unsigned u32x2 __attribute__((ext_vector_type(2)));
typedef float f32x16 __attribute__((ext_vector_type(16)));
typedef float f32x2v __attribute__((ext_vector_type(2)));
typedef __bf16 bf16x2_t __attribute__((ext_vector_type(2)));

__device__ __forceinline__ float bf2f(unsigned h) { return __uint_as_float(h << 16); }
__device__ __forceinline__ unsigned pk2(float lo, float hi) { f32x2v v = {lo, hi}; bf16x2_t b = __builtin_convertvector(v, bf16x2_t); return __builtin_bit_cast(unsigned, b); }
__device__ __forceinline__ unsigned short f2bf(float f) { return (unsigned short)(pk2(f, 0.f) & 0xffffu); }
__device__ __forceinline__ float lo_f(unsigned w) { return __uint_as_float(w << 16); }
__device__ __forceinline__ float hi_f(unsigned w) { return __uint_as_float(w & 0xffff0000u); }
__device__ __forceinline__ unsigned pk4_fp8(float a, float b, float c, float d) { int w = 0; w = __builtin_amdgcn_cvt_pk_fp8_f32(a, b, w, false); w = __builtin_amdgcn_cvt_pk_fp8_f32(c, d, w, true); return (unsigned)w; }
__device__ __forceinline__ float sigmoidf_(float x) { return 1.0f / (1.0f + __expf(-x)); }
__device__ __forceinline__ float siluf_(float x) { return x / (1.0f + __expf(-x)); }
__device__ __forceinline__ float softplusf_(float x) { return x > 20.f ? x : log1pf(__expf(x)); }
namespace pg8 {
#define PG8_LAS __attribute__((address_space(3)))
typedef unsigned short bf16_t;
typedef short bf16x8 __attribute__((ext_vector_type(8)));
typedef float f32x4 __attribute__((ext_vector_type(4)));
typedef unsigned u32x4 __attribute__((ext_vector_type(4)));
constexpr int BM = 256, BK = 64, HALF = 128, HTB = HALF * BK * 2  , STAGE_BYTES = 8 * HTB, NXCD = 8, WGM = 8;

__host__ __device__ __forceinline__ int lds_byte(int r, int c) { const int st = (r >> 4) * 2 + (c >> 5), rr = r & 15, cc = c & 31, ob = rr * 64 + cc * 2; return st * 1024 + (ob ^ (((ob >> 9) & 1) << 5)); }
__host__ __device__ __forceinline__ void stage_rc(int b, int& R, int& C) { const int st = b / 1024, sb = b % 1024, swz = sb ^ (((sb >> 9) & 1) << 5); R = (st >> 1) * 16 + swz / 64; C = (st & 1) * 32 + (swz % 64) / 2; }
__host__ __device__ __forceinline__ int perm32(int rho) { const int n = rho >> 4, i = rho & 15; return 8 * (i >> 2) + 4 * n + (i & 3); }

struct Unit { int pm, pn, kofs, nt; };
struct Gemm { const bf16_t* A; const bf16_t* Bt; int M, N, K; };

struct StaticOrder {
    int nM, nN, nwg, G, c;
    __host__ __device__ void init(int M, int N, int G_, int c_) { nM = M / BM; nN = N / BM; nwg = nM * nN; G = G_; c = c_; }
    __host__ __device__ bool next(int i, Unit& u) const {
        const long L = (long)i * G + c; if (L >= nwg) return false;
        int wgid = (int)L; { const int q = nwg / NXCD, r = nwg % NXCD, xcd = wgid % NXCD, off = wgid / NXCD; wgid = (xcd < r ? xcd * (q + 1) : r * (q + 1) + (xcd - r) * q) + off; }
        const int nig = WGM * nN, gid = wgid / nig, fm = gid * WGM, gsz = (nM - fm) < WGM ? (nM - fm) : WGM;
        u.pm = fm + ((wgid % nig) % gsz); u.pn = (wgid % nig) / gsz; u.kofs = 0; u.nt = 0; return true;
    }
    __device__ __forceinline__ void a_ready(const Unit&) const {}
    __device__ __forceinline__ void done(const Unit&) const {}
};
struct SlicedOrder {
    StaticOrder so; int npt, pm0, nN, nsl, slnt, ntot;
    __host__ __device__ void init(int Mp, int Mall, int N, int K, int SLK, int G_, int c_) { so.init(Mp, N, G_, c_); npt = so.nwg; pm0 = Mp / BM; nN = N / BM; nsl = K / SLK; slnt = SLK / BK; ntot = npt + ((Mall - Mp) / BM) * nN * nsl; }
    __host__ __device__ bool next(int i, Unit& u) const {
        const long L = (long)i * so.G + so.c; if (L >= ntot) return false;
        if (L < npt) return so.next(i, u);
        const int s = (int)L - npt, tile = s / nsl, sl = s - tile * nsl; u.pm = pm0 + tile / nN; u.pn = tile % nN; u.kofs = sl * slnt * BK; u.nt = slnt; return true;
    }
    __device__ __forceinline__ void a_ready(const Unit&) const {}
    __device__ __forceinline__ void done(const Unit&) const {}
};

__device__ __forceinline__ unsigned cvt_pk_bf16(float lo, float hi) { unsigned r; asm volatile("v_cvt_pk_bf16_f32 %0, %1, %2" : "=v"(r) : "v"(lo), "v"(hi)); return r; }
__device__ __forceinline__ u32x4 pack8(const f32x4 a, const f32x4 b) { u32x4 w; w.x = ::pk2(a[0], a[1]); w.y = ::pk2(a[2], a[3]); w.z = ::pk2(b[0], b[1]); w.w = ::pk2(b[2], b[3]); return w; }
#define EPI_LOOP8(...) _Pragma("unroll") for (int ai = 0; ai < 2; ++ai) _Pragma("unroll") for (int m = 0; m < 4; ++m) _Pragma("unroll") for (int bj = 0; bj < 2; ++bj) { \
    const int r = row0 + ai * HALF + m * 16, cl = cl0 + bj * HALF; const f32x4 a = acc[ai][bj][m][0], b = acc[ai][bj][m][1]; __VA_ARGS__ }
#define EPI_LOOP4(...) _Pragma("unroll") for (int ai = 0; ai < 2; ++ai) _Pragma("unroll") for (int m = 0; m < 4; ++m) _Pragma("unroll") for (int bj = 0; bj < 2; ++bj) _Pragma("unroll") for (int n = 0; n < 2; ++n) { \
    const int r = row0 + ai * HALF + m * 16, c = col0 + bj * HALF + n * 16; const f32x4 a = acc[ai][bj][m][n]; __VA_ARGS__ }

#define EPI_HALF8(ai, ...) _Pragma("unroll") for (int m = 0; m < 4; ++m) _Pragma("unroll") for (int bj = 0; bj < 2; ++bj) { \
    const int ix = m * 2 + bj, r = row0 + (ai) * HALF + m * 16, cl = cl0 + bj * HALF; const f32x4 a = acc[ai][bj][m][0], b = acc[ai][bj][m][1]; (void)ix; (void)a; (void)b; __VA_ARGS__ }
#define EPI_HALF4(ai, ...) _Pragma("unroll") for (int m = 0; m < 4; ++m) _Pragma("unroll") for (int bj = 0; bj < 2; ++bj) _Pragma("unroll") for (int n = 0; n < 2; ++n) { \
    const int ix = (m * 2 + bj) * 2 + n, r = row0 + (ai) * HALF + m * 16, c = col0 + bj * HALF + n * 16; const f32x4 a = acc[ai][bj][m][n]; (void)ix; (void)a; __VA_ARGS__ }

struct EpiInProj {
    static constexpr bool PERM = true, AFTER_DRAIN = false;
    bf16_t *Z, *XBC, *Q; unsigned char *KALL, *VALL; bf16_t *QI, *G, *KIALL; float *DT, *WI, *out; const float* dt_bias;
    __device__ __forceinline__ void operator()(const f32x4 (&acc)[2][2][4][2], const Unit& u, int wr, int wc, int fr, int fq) const {
        const int pn = u.pn, row0 = u.pm * BM + wr * 64 + fr, cl0 = wc * 32 + 8 * fq;
        if (pn < 8) { EPI_LOOP8( *(u32x4*)(Z + (size_t)r * 2048 + pn * 256 + cl) = pack8(a, b); ) }
        else if (pn < 20) { EPI_LOOP8( const int c = (pn - 8) * 256 + cl; *(u32x4*)(XBC + (size_t)r * 3072 + c) = pack8(a, b);
            int slot = -1;
            if (r < MP) { const int t = r & 16383; if (t >= 16381) slot = OUT_CONVP + ((r >> 14) * 3 + (t - 16381)) * 3072; }
            else { const int rs = r - MP, t = rs & 31; if (t >= 29) slot = OUT_CONVS + ((rs >> 5) * 3 + (t - 29)) * 3072; }
            if (slot >= 0) { *(f32x4*)(out + slot + c) = a; *(f32x4*)(out + slot + c + 4) = b; } ) }
        else if (pn < 24) { EPI_LOOP8( *(u32x4*)(Q + (size_t)r * 1024 + (pn - 20) * 256 + cl) = pack8(a, b); ) }
        else if (pn < 26) { unsigned char* KV = (pn == 24) ? KALL : VALL; const int op = (pn == 24) ? OUT_KP : OUT_VP, os = (pn == 24) ? OUT_KS : OUT_VS;
            EPI_LOOP8( int kr, o; if (r < MP) { kr = r; o = op + r * 256; } else { const int rs = r - MP; kr = MP + (rs >> 5) * SKEYS + PAST + (rs & 31); o = os + rs * 256; }
                { ::u32x2 w8; w8.x = ::pk4_fp8(a[0], a[1], a[2], a[3]); w8.y = ::pk4_fp8(b[0], b[1], b[2], b[3]); *(::u32x2*)(KV + (size_t)kr * 256 + cl) = w8; } *(f32x4*)(out + o + cl) = a; *(f32x4*)(out + o + cl + 4) = b; ) }
        else if (pn < 28) { EPI_LOOP8( *(u32x4*)(QI + (size_t)r * 512 + (pn - 26) * 256 + cl) = pack8(a, b); ) }
        else if (pn < 36) { EPI_LOOP8( f32x4 sa, sb;
            _Pragma("unroll") for (int e = 0; e < 4; ++e) { sa[e] = ::sigmoidf_(a[e]); sb[e] = ::sigmoidf_(b[e]); }
            *(u32x4*)(G + (size_t)r * 2048 + (pn - 28) * 256 + cl) = pack8(sa, sb); ) }
        else { EPI_LOOP8(
            if (cl < 32) { f32x4 sa, sb; const f32x4 ba = *(const f32x4*)(dt_bias + cl), bb = *(const f32x4*)(dt_bias + cl + 4);
                _Pragma("unroll") for (int e = 0; e < 4; ++e) { sa[e] = ::softplusf_(a[e] + ba[e]); sb[e] = ::softplusf_(b[e] + bb[e]); }
                *(f32x4*)(DT + (size_t)r * 32 + cl) = sa; *(f32x4*)(DT + (size_t)r * 32 + cl + 4) = sb; }
            else if (cl < 96) { int kr, o; if (r < MP) { kr = r; o = OUT_KIP + r * 64; } else { const int rs = r - MP; kr = MP + (rs >> 5) * SKEYS + PAST + (rs & 31); o = OUT_KIS + rs * 64; }
                *(u32x4*)(KIALL + (size_t)kr * 64 + (cl - 32)) = pack8(a, b); *(f32x4*)(out + o + (cl - 32)) = a; *(f32x4*)(out + o + (cl - 32) + 4) = b; }
            else if (cl < 104) { const float s = 0.04419417382415922f;
                *(f32x4*)(WI + (size_t)r * 8) = a * s; *(f32x4*)(WI + (size_t)r * 8 + 4) = b * s; } ) }
    }
};
struct EpiMixA {
    static constexpr bool PERM = true, AFTER_DRAIN = false;
    const bf16_t* G; bf16_t* T; float* SLAB;
    __device__ __forceinline__ void operator()(const f32x4 (&acc)[2][2][4][2], const Unit& u, int wr, int wc, int fr, int fq) const {
        const int row0 = u.pm * BM + wr * 64 + fr, cl0 = u.pn * BM + wc * 32 + 8 * fq;
        if (u.nt != 0) { float* sl = SLAB + (size_t)(u.kofs / (u.nt * BK)) * MS * 1024; EPI_LOOP8( float* t = sl + (size_t)(r - MP) * 1024 + cl; *(f32x4*)t = a; *(f32x4*)(t + 4) = b; ) return; }
        _Pragma("unroll") for (int ai = 0; ai < 2; ++ai) { u32x4 gq[8];
          EPI_HALF8(ai, gq[ix] = *(const u32x4*)(G + (size_t)r * 2048 + cl); )
          EPI_HALF8(ai, const u32x4 g = gq[ix];
            f32x4 o0, o1; o0[0] = a[0] * ::lo_f(g.x); o0[1] = a[1] * ::hi_f(g.x); o0[2] = a[2] * ::lo_f(g.y); o0[3] = a[3] * ::hi_f(g.y);
            o1[0] = b[0] * ::lo_f(g.z); o1[1] = b[1] * ::hi_f(g.z); o1[2] = b[2] * ::lo_f(g.w); o1[3] = b[3] * ::hi_f(g.w);
            *(u32x4*)(T + (size_t)r * 1024 + cl) = pack8(o0, o1); ) }
    }
};
struct EpiMixB {
    static constexpr bool PERM = true, AFTER_DRAIN = false;
    const bf16_t* G; const bf16_t* T; bf16_t* MIX; float* SLAB;
    __device__ __forceinline__ void operator()(const f32x4 (&acc)[2][2][4][2], const Unit& u, int wr, int wc, int fr, int fq) const {
        const int row0 = u.pm * BM + wr * 64 + fr, cl0 = u.pn * BM + wc * 32 + 8 * fq;
        if (u.nt != 0) { float* sl = SLAB + (size_t)(u.kofs / (u.nt * BK)) * MS * 1024; EPI_LOOP8( float* t = sl + (size_t)(r - MP) * 1024 + cl; *(f32x4*)t = a; *(f32x4*)(t + 4) = b; ) return; }
        _Pragma("unroll") for (int ai = 0; ai < 2; ++ai) { u32x4 gq[8], tq[8];
          EPI_HALF8(ai, gq[ix] = *(const u32x4*)(G + (size_t)r * 2048 + 1024 + cl); tq[ix] = *(const u32x4*)(T + (size_t)r * 1024 + cl); )
          EPI_HALF8(ai, const u32x4 g = gq[ix], t = tq[ix];
            f32x4 o0, o1; o0[0] = ::lo_f(t.x) + a[0] * ::lo_f(g.x); o0[1] = ::hi_f(t.x) + a[1] * ::hi_f(g.x); o0[2] = ::lo_f(t.y) + a[2] * ::lo_f(g.y); o0[3] = ::hi_f(t.y) + a[3] * ::hi_f(g.y);
            o1[0] = ::lo_f(t.z) + b[0] * ::lo_f(g.z); o1[1] = ::hi_f(t.z) + b[1] * ::hi_f(g.z); o1[2] = ::lo_f(t.w) + b[2] * ::lo_f(g.w); o1[3] = ::hi_f(t.w) + b[3] * ::hi_f(g.w);
            *(u32x4*)(MIX + (size_t)r * 1024 + cl) = pack8(o0, o1); ) }
    }
};
struct EpiResX {
    static constexpr bool PERM = false, AFTER_DRAIN = false;
    const float *xp, *xs; bf16_t* PRE; float* SLAB;
    __device__ __forceinline__ void operator()(const f32x4 (&acc)[2][2][4][2], const Unit& u, int wr, int wc, int fr, int fq) const {
        const int row0 = u.pm * BM + wr * 64 + fr, col0 = u.pn * BM + wc * 32 + 4 * fq;
        if (u.nt != 0) { float* sl = SLAB + (size_t)(u.kofs / (u.nt * BK)) * MS * 1024; EPI_LOOP4( *(f32x4*)(sl + (size_t)(r - MP) * 1024 + c) = a; ) return; }
        _Pragma("unroll") for (int ai = 0; ai < 2; ++ai) { f32x4 xq[16];
          EPI_HALF4(ai, const float* xr = (r < MP) ? xp + (size_t)r * 1024 : xs + (size_t)(r - MP) * 1024; xq[ix] = *(const f32x4*)(xr + c); )
          EPI_HALF4(ai, const f32x4 o = xq[ix] * ALPHA + a; ::u32x2 w; w.x = ::pk2(o[0], o[1]); w.y = ::pk2(o[2], o[3]); *(::u32x2*)(PRE + (size_t)r * 1024 + c) = w; ) }
    }
};
struct EpiSqRelu {
    static constexpr bool PERM = true, AFTER_DRAIN = false;
    bf16_t* H;
    __device__ __forceinline__ void operator()(const f32x4 (&acc)[2][2][4][2], const Unit& u, int wr, int wc, int fr, int fq) const {
        const int row0 = u.pm * BM + wr * 64 + fr, cl0 = u.pn * BM + wc * 32 + 8 * fq;
        EPI_LOOP8( f32x4 sa, sb;
            _Pragma("unroll") for (int e = 0; e < 4; ++e) { const float x0 = fmaxf(a[e], 0.f), x1 = fmaxf(b[e], 0.f); sa[e] = x0 * x0; sb[e] = x1 * x1; }
            *(u32x4*)(H + (size_t)r * 4096 + cl) = pack8(sa, sb); )
    }
};
struct EpiResH {
    static constexpr bool PERM = false, AFTER_DRAIN = false;
    const bf16_t* H1; bf16_t* PRE; float* SLAB;
    __device__ __forceinline__ void operator()(const f32x4 (&acc)[2][2][4][2], const Unit& u, int wr, int wc, int fr, int fq) const {
        const int row0 = u.pm * BM + wr * 64 + fr, col0 = u.pn * BM + wc * 32 + 4 * fq;
        if (u.nt != 0) { float* sl = SLAB + (size_t)(u.kofs / (u.nt * BK)) * MS * 1024; EPI_LOOP4( *(f32x4*)(sl + (size_t)(r - MP) * 1024 + c) = a; ) return; }
        _Pragma("unroll") for (int ai = 0; ai < 2; ++ai) { ::u32x2 hq[16];
          EPI_HALF4(ai, hq[ix] = *(const ::u32x2*)(H1 + (size_t)r * 1024 + c); )
          EPI_HALF4(ai, const ::u32x2 hv = hq[ix];
            f32x4 o; o[0] = ::lo_f(hv.x) * ALPHA + a[0]; o[1] = ::hi_f(hv.x) * ALPHA + a[1]; o[2] = ::lo_f(hv.y) * ALPHA + a[2]; o[3] = ::hi_f(hv.y) * ALPHA + a[3];
            ::u32x2 w; w.x = ::pk2(o[0], o[1]); w.y = ::pk2(o[2], o[3]); *(::u32x2*)(PRE + (size_t)r * 1024 + c) = w; ) }
    }
};
template <class Epi, class Sched, bool ALIGN_EPI = false, bool SP2 = false>
__device__ __forceinline__ void gemm_phase(PG8_LAS unsigned char* lds, const Gemm g, const Sched& S, const Epi& E) {
    const int tid = threadIdx.x, wid = __builtin_amdgcn_readfirstlane(tid >> 6), lane = tid & 63, wr = wid >> 2, wc = wid & 3, fr = lane & 15, fq = lane >> 4;
    const int K = g.K, nt = K / BK;
    unsigned voffA[2], voffB[2];
#pragma unroll
    for (int i = 0; i < 2; ++i) { int R, C; stage_rc(tid * 16 + i * 8192, R, C); const int Rb = Epi::PERM ? ((R & ~31) + perm32(R & 31)) : R;
        voffA[i] = (unsigned)(R * K + C) * 2u; voffB[i] = (unsigned)(Rb * K + C) * 2u; }
    const size_t kstep = (size_t)(BK * 2);
    const size_t hstep = (size_t)HALF * K * 2;
    const size_t tstep = 2 * hstep;
    const unsigned ldsw = (unsigned)wid * 1024u;
    const int aoff = lds_byte(wr * 64 + fr, fq * 8), boff = lds_byte(wc * 32 + fr, fq * 8);
#define PG8_SA(b, h) (((b) * 2 + (h)) * HTB)
#define PG8_SB(b, h) ((4 + (b) * 2 + (h)) * HTB)
#define PG8_STAGE(bufoff, gbase, voff) do { _Pragma("unroll") for (int _i = 0; _i < 2; ++_i) \
        __builtin_amdgcn_global_load_lds((const unsigned*)((const char*)(gbase) + (voff)[_i]), (PG8_LAS unsigned*)(lds + (bufoff) + ldsw + _i * 8192), 16, 0, 0); } while (0)
#define PG8_LDA(dst, b, h) do { _Pragma("unroll") for (int m = 0; m < 4; ++m) _Pragma("unroll") for (int k = 0; k < 2; ++k) dst[m][k] = *(const PG8_LAS bf16x8*)(lds + PG8_SA(b, h) + aoff + m * 2048 + k * 1024); } while (0)
#define PG8_LDB(dst, b, h) do { _Pragma("unroll") for (int n = 0; n < 2; ++n) _Pragma("unroll") for (int k = 0; k < 2; ++k) dst[n][k] = *(const PG8_LAS bf16x8*)(lds + PG8_SB(b, h) + boff + n * 2048 + k * 1024); } while (0)
#define PG8_MMA(ai, bj, At, Bt) do { __builtin_amdgcn_s_setprio(1); _Pragma("unroll") for (int m = 0; m < 4; ++m) _Pragma("unroll") for (int n = 0; n < 2; ++n) _Pragma("unroll") for (int k = 0; k < 2; ++k) \
        acc[ai][bj][m][n] = __builtin_amdgcn_mfma_f32_16x16x32_bf16(Bt[n][k], At[m][k], acc[ai][bj][m][n], 0, 0, 0); __builtin_amdgcn_s_setprio(0); } while (0)
#define PG8_WAIT_V(n) asm volatile("s_waitcnt vmcnt(" #n ")" ::: "memory")
#define PG8_WAIT_L(n) asm volatile("s_waitcnt lgkmcnt(" #n ")" ::: "memory")
#define PG8_BAR __builtin_amdgcn_s_barrier()
#define PG8_SCHED __builtin_amdgcn_sched_barrier(0)
    Unit cur, nxt; int ui = 0;
    if (!S.next(0, cur)) return;
    f32x4 acc[2][2][4][2];
#pragma unroll
    for (int a = 0; a < 2; ++a)
#pragma unroll
        for (int b = 0; b < 2; ++b)
#pragma unroll
            for (int m = 0; m < 4; ++m)
#pragma unroll
                for (int n = 0; n < 2; ++n) acc[a][b][m][n] = (f32x4){0.f, 0.f, 0.f, 0.f};
    bf16x8 At[4][2], B0[2][2], B1[2][2];
    const char* cA = (const char*)g.A + (size_t)cur.pm * tstep + (size_t)cur.kofs * 2; const char* cB = (const char*)g.Bt + (size_t)cur.pn * tstep + (size_t)cur.kofs * 2;
    S.a_ready(cur);
    if constexpr (SP2) {
        PG8_STAGE(PG8_SB(0, 0), cB, voffB); PG8_STAGE(PG8_SB(0, 1), cB + hstep, voffB); PG8_STAGE(PG8_SA(0, 0), cA, voffA); PG8_STAGE(PG8_SA(0, 1), cA + hstep, voffA);
        if (wr == 1) PG8_BAR;
        PG8_WAIT_V(2); PG8_BAR;
        PG8_STAGE(PG8_SB(1, 0), cB + kstep, voffB); PG8_STAGE(PG8_SA(1, 0), cA + kstep, voffA); PG8_STAGE(PG8_SB(1, 1), cB + hstep + kstep, voffB);
        PG8_WAIT_V(6); PG8_BAR;
    } else {
        PG8_STAGE(PG8_SB(0, 0), cB, voffB); PG8_STAGE(PG8_SA(0, 0), cA, voffA); PG8_STAGE(PG8_SB(0, 1), cB + hstep, voffB); PG8_STAGE(PG8_SA(0, 1), cA + hstep, voffA);
        if (wr == 1) PG8_BAR;
        PG8_WAIT_V(4); PG8_BAR;
        PG8_STAGE(PG8_SB(1, 0), cB + kstep, voffB); PG8_STAGE(PG8_SA(1, 0), cA + kstep, voffA); PG8_STAGE(PG8_SB(1, 1), cB + hstep + kstep, voffB);
        PG8_WAIT_V(6); PG8_BAR;
    }
    for (;;) {
        const bool has_next = S.next(ui + 1, nxt);
        const char* nA = has_next ? (const char*)g.A + (size_t)nxt.pm * tstep + (size_t)nxt.kofs * 2 : cA; const char* nB = has_next ? (const char*)g.Bt + (size_t)nxt.pn * tstep + (size_t)nxt.kofs * 2 : cB;
        const int unt = cur.nt ? cur.nt : nt;
        for (int t = 0; t < unt; t += 2) {
            const bool last = (t == unt - 2);
            const char* a1 = cA + (size_t)(t + 1) * kstep;
            const char* a2 = last ? nA : cA + (size_t)(t + 2) * kstep; const char* b2 = last ? nB : cB + (size_t)(t + 2) * kstep;
            const char* a3 = a2 + kstep; const char* b3 = b2 + kstep;
            if (last && has_next) S.a_ready(nxt);
            if constexpr (SP2) {
            PG8_LDB(B0, 0, 0); PG8_LDB(B1, 0, 1); PG8_SCHED; PG8_LDA(At, 0, 0); PG8_STAGE(PG8_SA(1, 1), a1 + hstep, voffA);
            PG8_WAIT_V(8); PG8_WAIT_L(0); PG8_BAR; PG8_MMA(0, 0, At, B0); PG8_MMA(0, 1, At, B1); PG8_BAR; PG8_SCHED;
            PG8_LDA(At, 0, 1); PG8_STAGE(PG8_SB(0, 0), b2, voffB); PG8_STAGE(PG8_SB(0, 1), b2 + hstep, voffB); PG8_STAGE(PG8_SA(0, 0), a2, voffA);
            PG8_WAIT_V(8); PG8_WAIT_L(0); PG8_BAR; PG8_MMA(1, 0, At, B0); PG8_MMA(1, 1, At, B1); PG8_BAR; PG8_SCHED;
            PG8_LDB(B0, 1, 0); PG8_LDB(B1, 1, 1); PG8_SCHED; PG8_LDA(At, 1, 0); PG8_STAGE(PG8_SA(0, 1), a2 + hstep, voffA);
            PG8_WAIT_V(8); PG8_WAIT_L(0); PG8_BAR; PG8_MMA(0, 0, At, B0); PG8_MMA(0, 1, At, B1); PG8_BAR; PG8_SCHED;
            PG8_LDA(At, 1, 1); PG8_STAGE(PG8_SB(1, 0), b3, voffB); PG8_STAGE(PG8_SB(1, 1), b3 + hstep, voffB); PG8_STAGE(PG8_SA(1, 0), a3, voffA);
            PG8_WAIT_V(8); PG8_WAIT_L(0); PG8_BAR; PG8_MMA(1, 0, At, B0); PG8_MMA(1, 1, At, B1); PG8_BAR; PG8_SCHED;
            } else {
            PG8_LDB(B0, 0, 0); PG8_SCHED; PG8_LDA(At, 0, 0); PG8_STAGE(PG8_SA(1, 1), a1 + hstep, voffA);
            PG8_WAIT_L(8); PG8_BAR; PG8_WAIT_L(0); PG8_MMA(0, 0, At, B0); PG8_BAR; PG8_SCHED;
            PG8_LDB(B1, 0, 1); PG8_STAGE(PG8_SB(0, 0), b2, voffB);
            PG8_BAR; PG8_WAIT_L(0); PG8_MMA(0, 1, At, B1); PG8_BAR;
            PG8_LDA(At, 0, 1); PG8_STAGE(PG8_SA(0, 0), a2, voffA);
            PG8_BAR; PG8_WAIT_L(0); PG8_MMA(1, 0, At, B0); PG8_BAR; PG8_SCHED;
            PG8_STAGE(PG8_SB(0, 1), b2 + hstep, voffB);
            PG8_WAIT_V(6); PG8_BAR; PG8_MMA(1, 1, At, B1); PG8_BAR;
            PG8_LDB(B0, 1, 0); PG8_SCHED; PG8_LDA(At, 1, 0); PG8_STAGE(PG8_SA(0, 1), a2 + hstep, voffA);
            PG8_WAIT_L(8); PG8_BAR; PG8_WAIT_L(0); PG8_MMA(0, 0, At, B0); PG8_BAR; PG8_SCHED;
            PG8_LDB(B1, 1, 1); PG8_STAGE(PG8_SB(1, 0), b3, voffB);
            PG8_BAR; PG8_WAIT_L(0); PG8_MMA(0, 1, At, B1); PG8_BAR;
            PG8_LDA(At, 1, 1); PG8_STAGE(PG8_SA(1, 0), a3, voffA);
            PG8_BAR; PG8_WAIT_L(0); PG8_MMA(1, 0, At, B0); PG8_BAR; PG8_SCHED;
            PG8_STAGE(PG8_SB(1, 1), b3 + hstep, voffB);
            PG8_WAIT_V(6); PG8_BAR; PG8_MMA(1, 1, At, B1); PG8_BAR;
            }
        }
        if constexpr (ALIGN_EPI) { if (wr == 0) PG8_BAR; }
        if constexpr (!Epi::AFTER_DRAIN) { E(acc, cur, wr, wc, fr, fq); S.done(cur); }
        if (!has_next) break;
#pragma unroll
        for (int a = 0; a < 2; ++a)
#pragma unroll
            for (int b = 0; b < 2; ++b)
#pragma unroll
                for (int m = 0; m < 4; ++m)
#pragma unroll
                    for (int n = 0; n < 2; ++n) acc[a][b][m][n] = (f32x4){0.f, 0.f, 0.f, 0.f};
        cur = nxt; cA = nA; cB = nB; ++ui;
        if constexpr (ALIGN_EPI) { if (wr == 1) PG8_BAR; }
    }
    PG8_WAIT_V(0);
    if constexpr (!ALIGN_EPI) { if (wr == 0) PG8_BAR; }
    PG8_BAR;
    if constexpr (Epi::AFTER_DRAIN) { E.fused(acc, cur, wr, wc, fr, fq, lds, wid, lane); S.done(cur); }
#undef PG8_SA
#undef PG8_SB
#undef PG8_STAGE
#undef PG8_LDA
#undef PG8_LDB
#undef PG8_MMA
#undef PG8_WAIT_V
#undef PG8_WAIT_L
#undef PG8_BAR
#undef PG8_SCHED
}
}
using pg8::bf16x8;
using pg8::f32x4;
#define MFMA32(a, b, c) __builtin_amdgcn_mfma_f32_32x32x16_bf16((a), (b), (c), 0, 0, 0)
#define MFMA16(a, b, c) __builtin_amdgcn_mfma_f32_16x16x32_bf16((a), (b), (c), 0, 0, 0)
#define LDS_WAIT() asm volatile("s_waitcnt lgkmcnt(0)" ::: "memory")

struct Params {
    const float* in[24];
    float* out;
    unsigned char* ws;
    int ph_lo, ph_hi;
};

__device__ __forceinline__ bf16x8 ldg8(const bf16* p) { return *(const bf16x8*)p; }
__device__ __forceinline__ float wave_sum(float v) {
#pragma unroll
    for (int o = 1; o < 64; o <<= 1) v += __shfl_xor(v, o);
    return v;
}

__device__ __forceinline__ int win_src_col(int n) {
    if (n < 5120) return n;
    if (n < 7168) return n + 32;
    if (n < 9216) return n + 104;
    if (n < 9248) return n - 4096;
    if (n < 9320) return n - 2048;
    return -1;
}
template <bool REMAP>
__device__ __forceinline__ void transpose_item(const float* W, int K, int Nsrc, bf16* WT, LAS float* scr, int kb, int nb, int lane) {
    const int k0 = 64 * kb, n0 = 32 * nb;
    int sc = n0 + (lane & 31); if (REMAP) sc = win_src_col(sc);
#pragma unroll 8
    for (int i = 0; i < 32; ++i) { const int kk = 2 * i + (lane >> 5); scr[kk * 33 + (lane & 31)] = (sc >= 0) ? W[(size_t)(k0 + kk) * Nsrc + sc] : 0.f; }
    LDS_WAIT(); asm volatile("" ::: "memory");
    const int c = lane & 7;
#pragma unroll
    for (int j = 0; j < 4; ++j) { const int n = (lane >> 3) + 8 * j; const LAS float* s = scr + (8 * c) * 33 + n;
        u32x4 o; o.x = pk2(s[0 * 33], s[1 * 33]); o.y = pk2(s[2 * 33], s[3 * 33]); o.z = pk2(s[4 * 33], s[5 * 33]); o.w = pk2(s[6 * 33], s[7 * 33]);
        *(u32x4*)(WT + (size_t)(n0 + n) * K + k0 + 8 * c) = o; }
    LDS_WAIT(); asm volatile("" ::: "memory");
}
__device__ __forceinline__ void cvt8(const float* src, bf16* dst) {
    const f32x4 a = *(const f32x4*)src, b = *(const f32x4*)(src + 4);
    u32x4 o; o.x = pk2(a[0], a[1]); o.y = pk2(a[2], a[3]); o.z = pk2(b[0], b[1]); o.w = pk2(b[2], b[3]);
    *(u32x4*)dst = o;
}
__device__ __forceinline__ void phase_prologue(const Params& p, LAS unsigned char* lds, int tid, int wave, int lane) {
    unsigned char* ws = p.ws;
    LAS float* scr = (LAS float*)(lds + wave * 16384);
    const int gw = blockIdx.x * 8 + wave, NGW = gridDim.x * 8;
    constexpr int I_IN = 16 * 296, I_SSD = 32 * 32, I_ATT = 16 * 32, I_OUT = 16 * 32, I_UP = 16 * 128, I_DN = 64 * 32;
    constexpr int NITEMS = I_IN + I_SSD + I_ATT + I_OUT + I_UP + I_DN;
    for (int it = gw; it < NITEMS; it += NGW) {
        int r = it;
        if (r < I_IN) { transpose_item<true>(p.in[8], 1024, 9320, (bf16*)(ws + WS_WIN), scr, r / 296, r % 296, lane); continue; } r -= I_IN;
        if (r < I_SSD) { transpose_item<false>(p.in[15], 2048, 1024, (bf16*)(ws + WS_WSSD), scr, r / 32, r % 32, lane); continue; } r -= I_SSD;
        if (r < I_ATT) { transpose_item<false>(p.in[16], 1024, 1024, (bf16*)(ws + WS_WATT), scr, r / 32, r % 32, lane); continue; } r -= I_ATT;
        if (r < I_OUT) { transpose_item<false>(p.in[17], 1024, 1024, (bf16*)(ws + WS_WOUT), scr, r / 32, r % 32, lane); continue; } r -= I_OUT;
        if (r < I_UP) { transpose_item<false>(p.in[20], 1024, 4096, (bf16*)(ws + WS_WUP), scr, r / 128, r % 128, lane); continue; } r -= I_UP;
        transpose_item<false>(p.in[21], 4096, 1024, (bf16*)(ws + WS_WDN), scr, r / 32, r % 32, lane);
    }
    const size_t gt = (size_t)blockIdx.x * 512 + tid, NT = (size_t)gridDim.x * 512;
    { bf16* XB = (bf16*)(ws + WS_XB);
      for (size_t i = gt; i < (size_t)MT * 128; i += NT) { const size_t e = i * 8; const float* s = (e < (size_t)MP * 1024) ? p.in[0] + e : p.in[1] + (e - (size_t)MP * 1024); cvt8(s, XB + e); } }
    { unsigned char* KA = ws + WS_KALL; unsigned char* VA = ws + WS_VALL; bf16* KI = (bf16*)(ws + WS_KIALL);
      for (size_t i = gt; i < (size_t)32 * PAST * 16; i += NT) { const size_t row = i >> 4, c16 = (i & 15) * 16; const size_t b = row >> 12, pos = row & 4095;
          const size_t dr = (size_t)MP + b * SKEYS + pos;
          { const float* s = p.in[2] + row * 256 + c16; const f32x4 a = *(const f32x4*)s, b4 = *(const f32x4*)(s + 4), c = *(const f32x4*)(s + 8), d = *(const f32x4*)(s + 12);
            u32x4 o; o.x = pk4_fp8(a[0], a[1], a[2], a[3]); o.y = pk4_fp8(b4[0], b4[1], b4[2], b4[3]); o.z = pk4_fp8(c[0], c[1], c[2], c[3]); o.w = pk4_fp8(d[0], d[1], d[2], d[3]); *(u32x4*)(KA + dr * 256 + c16) = o; }
          { const float* s = p.in[3] + row * 256 + c16; const f32x4 a = *(const f32x4*)s, b4 = *(const f32x4*)(s + 4), c = *(const f32x4*)(s + 8), d = *(const f32x4*)(s + 12);
            u32x4 o; o.x = pk4_fp8(a[0], a[1], a[2], a[3]); o.y = pk4_fp8(b4[0], b4[1], b4[2], b4[3]); o.z = pk4_fp8(c[0], c[1], c[2], c[3]); o.w = pk4_fp8(d[0], d[1], d[2], d[3]); *(u32x4*)(VA + dr * 256 + c16) = o; } }
      for (size_t i = gt; i < (size_t)32 * PAST * 8; i += NT) { const size_t row = i >> 3, c8 = (i & 7) * 8; const size_t b = row >> 12, pos = row & 4095;
          const size_t dr = (size_t)MP + b * SKEYS + pos; cvt8(p.in[4] + row * 64 + c8, KI + dr * 64 + c8); } }
}

constexpr int CV_ROW = 2064;
static_assert(64 * CV_ROW <= LDS_BYTES - 256, "conv LDS");
__device__ __forceinline__ void phase_conv(const Params& p, LAS unsigned char* lds, int tid) {
    unsigned char* ws = p.ws;
    const bf16* XBC = (const bf16*)(ws + WS_XBC); const float* DT = (const float*)(ws + WS_DT);
    bf16* XT = (bf16*)(ws + WS_XT); bf16* BN = (bf16*)(ws + WS_BN); bf16* BT = (bf16*)(ws + WS_BT); bf16* CN = (bf16*)(ws + WS_CN);
    float* ACUM = (float*)(ws + WS_ACUM); float* DTS = (float*)(ws + WS_DTS);
    const float* conv_w = p.in[9]; const float* conv_b = p.in[10]; const float* a_log = p.in[12]; const float* state_conv = p.in[6];
    for (int it = blockIdx.x; it < NQC * 3; it += gridDim.x) {
        const int q = it / 3, j = it - 3 * q;
        const bool samp = q >= 512; const int b = samp ? q - 512 : (q >> 8), c = samp ? 0 : (q & 255);
        const int row0 = samp ? MP + b * 32 : q * 64, nvalid = samp ? 32 : 64;
        if (j == 0) {
            const int ln_ = tid & 63, wv_ = tid >> 6; const int rr_ = (ln_ < nvalid) ? ln_ : 0;
            float dvv[4];
#pragma unroll
            for (int k = 0; k < 4; ++k) dvv[k] = DT[(size_t)(row0 + rr_) * 32 + wv_ * 4 + k];
#pragma unroll
            for (int k = 0; k < 4; ++k) { const int h = wv_ * 4 + k; const float A = -__expf(a_log[h]); const float dv = (ln_ < nvalid) ? dvv[k] : 0.f;
                float x = dv * A;
                x += __builtin_bit_cast(float, __builtin_amdgcn_update_dpp(0, __builtin_bit_cast(int, x), 0x111, 0xF, 0xF, true));
                x += __builtin_bit_cast(float, __builtin_amdgcn_update_dpp(0, __builtin_bit_cast(int, x), 0x112, 0xF, 0xF, true));
                x += __builtin_bit_cast(float, __builtin_amdgcn_update_dpp(0, __builtin_bit_cast(int, x), 0x114, 0xF, 0xF, true));
                x += __builtin_bit_cast(float, __builtin_amdgcn_update_dpp(0, __builtin_bit_cast(int, x), 0x118, 0xF, 0xF, true));
                const float T0 = __builtin_bit_cast(float, __builtin_amdgcn_readlane(__builtin_bit_cast(int, x), 15)), T1 = __builtin_bit_cast(float, __builtin_amdgcn_readlane(__builtin_bit_cast(int, x), 31)),
                            T2 = __builtin_bit_cast(float, __builtin_amdgcn_readlane(__builtin_bit_cast(int, x), 47));
                const int row_ = ln_ >> 4; x += (row_ == 1 ? T0 : row_ == 2 ? T0 + T1 : row_ == 3 ? (T0 + T1) + T2 : 0.f);
                ACUM[(q * 32 + h) * 64 + ln_] = x; DTS[(q * 32 + h) * 64 + ln_] = dv; } }
        {
            const int ch = 2 * (tid + 512 * j);
            float w0[4], w1[4];
#pragma unroll
            for (int i = 0; i < 4; ++i) { w0[i] = conv_w[i * 3072 + ch]; w1[i] = conv_w[i * 3072 + ch + 1]; }
            const float bias0 = conv_b[ch], bias1 = conv_b[ch + 1];
            float h0[3], h1[3];
            if (samp) {
#pragma unroll
                for (int k = 0; k < 3; ++k) { h0[k] = state_conv[(size_t)(b * 3 + k) * 3072 + ch]; h1[k] = state_conv[(size_t)(b * 3 + k) * 3072 + ch + 1]; }
            } else if (c == 0) {
#pragma unroll
                for (int k = 0; k < 3; ++k) { h0[k] = 0.f; h1[k] = 0.f; }
            } else {
#pragma unroll
                for (int k = 0; k < 3; ++k) { const unsigned w = *(const unsigned*)(XBC + (size_t)(row0 - 3 + k) * 3072 + ch); h0[k] = lo_f(w); h1[k] = hi_f(w); }
            }
            unsigned rawall[64];
#pragma unroll
            for (int i = 0; i < 64; ++i) rawall[i] = (i < nvalid) ? *(const unsigned*)(XBC + (size_t)(row0 + i) * 3072 + ch) : 0u;
#pragma unroll
            for (int s0 = 0; s0 < 64; s0 += 8) {
                unsigned raw[8];
#pragma unroll
                for (int i = 0; i < 8; ++i) raw[i] = rawall[s0 + i];
                float o0[8], o1[8];
#pragma unroll
                for (int i = 0; i < 8; ++i) {
                    const float c0 = lo_f(raw[i]), c1 = hi_f(raw[i]);
                    const float v0 = bias0 + w0[0] * h0[0] + w0[1] * h0[1] + w0[2] * h0[2] + w0[3] * c0;
                    const float v1 = bias1 + w1[0] * h1[0] + w1[1] * h1[1] + w1[2] * h1[2] + w1[3] * c1;
                    const bool ok = (s0 + i) < nvalid;
                    o0[i] = ok ? siluf_(v0) : 0.f; o1[i] = ok ? siluf_(v1) : 0.f;
                    h0[0] = h0[1]; h0[1] = h0[2]; h0[2] = c0; h1[0] = h1[1]; h1[1] = h1[2]; h1[2] = c1;
                }
                u32x4 t0, t1;
                t0.x = pk2(o0[0], o0[1]); t0.y = pk2(o0[2], o0[3]); t0.z = pk2(o0[4], o0[5]); t0.w = pk2(o0[6], o0[7]);
                t1.x = pk2(o1[0], o1[1]); t1.y = pk2(o1[2], o1[3]); t1.z = pk2(o1[4], o1[5]); t1.w = pk2(o1[6], o1[7]);
                if (ch < 2048) {
                    const int h = ch >> 6, pp = ch & 63;
                    bf16* xp_ = XT + (size_t)(q * 32 + h) * 4096 + ((s0 >> 3) * 64 + pp) * 8; *(u32x4*)xp_ = t0; *(u32x4*)(xp_ + 8) = t1;
                } else if (ch < 2560) {
                    const int g = (ch - 2048) >> 7, n = (ch - 2048) & 127;
                    bf16* bp_ = BT + (size_t)(q * 4 + g) * 8192 + ((s0 >> 3) * 128 + n) * 8; *(u32x4*)bp_ = t0; *(u32x4*)(bp_ + 8) = t1;
#pragma unroll
                    for (int i = 0; i < 8; ++i) *(LAS unsigned*)(lds + (s0 + i) * CV_ROW + (ch - 2048) * 2) = pk2(o0[i], o1[i]);
                } else {
                    const int g = (ch - 2560) >> 7, n = (ch - 2560) & 127;
#pragma unroll
                    for (int i = 0; i < 8; ++i) *(LAS unsigned*)(lds + (s0 + i) * CV_ROW + (ch - 2048) * 2) = pk2(o0[i], o1[i]);
                }
            }
        }
        if (j == 2) {
            __syncthreads();
            const int wv_ = tid >> 6, ln_ = tid & 63;
#pragma unroll 4
            for (int oc = 0; oc < 16; ++oc) { const int octet = wv_ * 16 + oc; const u32x4 v = *(const LAS u32x4*)(lds + ln_ * CV_ROW + octet * 16);
                bf16* dst = ((octet < 64) ? BN : CN) + (size_t)(q * 4 + ((octet & 63) >> 4)) * 8192 + ((octet & 15) * 64 + ln_) * 8; *(u32x4*)dst = v; }
            __syncthreads();
        }
    }
}

__device__ __forceinline__ bf16x8 scale8(bf16x8 v, const float (&w)[8]) {
    const u32x4 u = __builtin_bit_cast(u32x4, v); u32x4 o;
    o.x = pk2(lo_f(u.x) * w[0], hi_f(u.x) * w[1]); o.y = pk2(lo_f(u.y) * w[2], hi_f(u.y) * w[3]);
    o.z = pk2(lo_f(u.z) * w[4], hi_f(u.z) * w[5]); o.w = pk2(lo_f(u.w) * w[6], hi_f(u.w) * w[7]);
    return __builtin_bit_cast(bf16x8, o);
}
__device__ __forceinline__ void phase_s1(const Params& p, int wave, int lane) {
    unsigned char* ws = p.ws;
    const bf16* XT = (const bf16*)(ws + WS_XT); const bf16* BT = (const bf16*)(ws + WS_BT);
    const float* ACUM = (const float*)(ws + WS_ACUM); const float* DTS = (const float*)(ws + WS_DTS);
    bf16* ST = (bf16*)(ws + WS_STATES);
    const int gw = blockIdx.x * 8 + wave, NGW = gridDim.x * 8, l32 = lane & 31, hh = lane >> 5;
#pragma unroll 1
    for (int it = gw; it < NQC * 32; it += NGW) {
        const int q = it >> 5, h = it & 31, g = h >> 3;
        const float* ac = ACUM + (q * 32 + h) * 64 + 8 * hh; const float* dts = DTS + (q * 32 + h) * 64 + 8 * hh;
        f32x4 av[4][2], dv[4][2]; bf16x8 af[2][4], bfr[4][4];
#pragma unroll
        for (int kk = 0; kk < 4; ++kk) { av[kk][0] = *(const f32x4*)(ac + 16 * kk); av[kk][1] = *(const f32x4*)(ac + 16 * kk + 4); dv[kk][0] = *(const f32x4*)(dts + 16 * kk); dv[kk][1] = *(const f32x4*)(dts + 16 * kk + 4); }
        const float alast = ACUM[(q * 32 + h) * 64 + 63];
#pragma unroll
        for (int pb = 0; pb < 2; ++pb)
#pragma unroll
            for (int kk = 0; kk < 4; ++kk) af[pb][kk] = ldg8(XT + (size_t)(q * 32 + h) * 4096 + ((2 * kk + hh) * 64 + pb * 32 + l32) * 8);
        float w[4][8];
#pragma unroll
        for (int kk = 0; kk < 4; ++kk)
#pragma unroll
            for (int e = 0; e < 4; ++e) { w[kk][e] = __expf(alast - av[kk][0][e]) * dv[kk][0][e]; w[kk][4 + e] = __expf(alast - av[kk][1][e]) * dv[kk][1][e]; }
        asm volatile("" ::: "memory");
#pragma unroll
        for (int nb = 0; nb < 4; ++nb)
#pragma unroll
            for (int kk = 0; kk < 4; ++kk) bfr[nb][kk] = ldg8(BT + (size_t)(q * 4 + g) * 8192 + ((2 * kk + hh) * 128 + nb * 32 + l32) * 8);
#pragma unroll
        for (int pb = 0; pb < 2; ++pb) {
            f32x16 acc[4];
#pragma unroll
            for (int n = 0; n < 4; ++n)
#pragma unroll
                for (int e = 0; e < 16; ++e) acc[n][e] = 0.f;
#pragma unroll
            for (int kk = 0; kk < 4; ++kk) { const bf16x8 a = scale8(af[pb][kk], w[kk]);
#pragma unroll
                for (int nb = 0; nb < 4; ++nb) acc[nb] = MFMA32(bfr[nb][kk], a, acc[nb]); }
            bf16* sp = ST + (size_t)(q * 32 + h) * 8192 + (pb * 32 + l32) * 8 + 4 * hh;
#pragma unroll
            for (int nb = 0; nb < 4; ++nb)
#pragma unroll
                for (int e4 = 0; e4 < 4; ++e4) { u32x2 o; o.x = pk2(acc[nb][4 * e4], acc[nb][4 * e4 + 1]); o.y = pk2(acc[nb][4 * e4 + 2], acc[nb][4 * e4 + 3]); *(u32x2*)(sp + (nb * 4 + e4) * 512) = o; }
        }
    }
}

__device__ __forceinline__ void phase_s2(const Params& p, int tid) {
    unsigned char* ws = p.ws;
    bf16* ST = (bf16*)(ws + WS_STATES); const float* ACUM = (const float*)(ws + WS_ACUM);
    const size_t gt = (size_t)blockIdx.x * 512 + tid, NT = (size_t)gridDim.x * 512;
    for (size_t u = gt; u < 131072; u += NT) {
        const int b = (int)(u >> 16), e = (int)(u & 65535) * 4, h = e >> 13;
        f32x4 st = {0.f, 0.f, 0.f, 0.f};
#pragma unroll 1
        for (int c0 = 0; c0 < 256; c0 += 16) {
            u32x2 raw[16]; float dec[16];
#pragma unroll
            for (int i = 0; i < 16; ++i) { const int q = b * 256 + c0 + i; raw[i] = *(const u32x2*)(ST + (size_t)q * 262144 + e); dec[i] = ACUM[(q * 32 + h) * 64 + 63]; }
#pragma unroll
            for (int i = 0; i < 16; ++i) { const int q = b * 256 + c0 + i; u32x2 o; o.x = pk2(st[0], st[1]); o.y = pk2(st[2], st[3]); *(u32x2*)(ST + (size_t)q * 262144 + e) = o;
                const float d = __expf(dec[i]); st[0] = st[0] * d + lo_f(raw[i].x); st[1] = st[1] * d + hi_f(raw[i].x); st[2] = st[2] * d + lo_f(raw[i].y); st[3] = st[3] * d + hi_f(raw[i].y); }
        }
        { const int eh = e & 8191; *(f32x4*)(p.out + OUT_SSMP + (size_t)b * 262144 + (e - eh) + ((eh >> 3) & 63) * 128 + (eh >> 9) * 8 + (eh & 7)) = st; }
    }
    for (size_t u = gt; u < (size_t)32 * 65536; u += NT) {
        const int b = (int)(u >> 16), e = (int)(u & 65535) * 4, h = e >> 13, q = 512 + b;
        const int eh = e & 8191; const size_t nat = (size_t)b * 262144 + (e - eh) + ((eh >> 3) & 63) * 128 + (eh >> 9) * 8 + (eh & 7);
        const f32x4 h0 = *(const f32x4*)(p.in[5] + nat);
        const u32x2 raw = *(const u32x2*)(ST + (size_t)q * 262144 + e);
        const float d = __expf(ACUM[(q * 32 + h) * 64 + 63]);
        u32x2 o; o.x = pk2(h0[0], h0[1]); o.y = pk2(h0[2], h0[3]); *(u32x2*)(ST + (size_t)q * 262144 + e) = o;
        f32x4 r; r[0] = h0[0] * d + lo_f(raw.x); r[1] = h0[1] * d + hi_f(raw.x); r[2] = h0[2] * d + lo_f(raw.y); r[3] = h0[3] * d + hi_f(raw.y);
        *(f32x4*)(p.out + OUT_SSMS + nat) = r;
    }
}

constexpr int S3_MROW = 144;
constexpr int S3_YROW = 272;
constexpr int S3_WBYTES = 64 * S3_YROW;
constexpr int S3_SSQ_OFF = 8 * S3_WBYTES;
constexpr int S3_AC_OFF = S3_SSQ_OFF + 2048;
static_assert(S3_AC_OFF + 4096 <= LDS_BYTES - 256, "S3 LDS");
__device__ __forceinline__ void phase_s3(const Params& p, LAS unsigned char* lds, int wave, int lane) {
    unsigned char* ws = p.ws;
    const bf16* XT = (const bf16*)(ws + WS_XT); const bf16* BN = (const bf16*)(ws + WS_BN); const bf16* CN = (const bf16*)(ws + WS_CN);
    const float* ACUM = (const float*)(ws + WS_ACUM); const float* DTS = (const float*)(ws + WS_DTS); const bf16* ST = (const bf16*)(ws + WS_STATES);
    bf16* ZY = (bf16*)(ws + WS_Z);
    const float* d_skip = p.in[13]; const float* norm_w = p.in[14];
    const int l32 = lane & 31, hh = lane >> 5;
    LAS unsigned char* Mw = lds + wave * S3_WBYTES;
    LAS float* SSQ = (LAS float*)(lds + S3_SSQ_OFF);
    LAS float* acl = (LAS float*)(lds + S3_AC_OFF) + wave * 128; LAS float* dtl = acl + 64;
#pragma unroll 1
    for (int it = blockIdx.x; it < NQC * 4; it += gridDim.x) {
        const int q = it >> 2, g = it & 3, h = g * 8 + wave;
        const bool samp = q >= 512; const int row0 = samp ? MP + (q - 512) * 32 : q * 64, nvalid = samp ? 32 : 64;
        const float* ac = ACUM + (q * 32 + h) * 64; const float* dts = DTS + (q * 32 + h) * 64;
        acl[lane] = ac[lane]; dtl[lane] = dts[lane];
        const bf16* Cb = CN + (size_t)(q * 4 + g) * 8192; const bf16* Bb = BN + (size_t)(q * 4 + g) * 8192;
        const bf16* Xb = XT + (size_t)(q * 32 + h) * 4096; const bf16* Hb = ST + (size_t)(q * 32 + h) * 8192;
        bf16x8 cf[2][8];
#pragma unroll
        for (int tb = 0; tb < 2; ++tb)
#pragma unroll
            for (int kk = 0; kk < 8; ++kk) cf[tb][kk] = ldg8(Cb + ((2 * kk + hh) * 64 + tb * 32 + l32) * 8);
        {
            f32x16 cb00, cb10, cb11;
#pragma unroll
            for (int e = 0; e < 16; ++e) { cb00[e] = 0.f; cb10[e] = 0.f; cb11[e] = 0.f; }
            { bf16x8 bq_[2][8];
#pragma unroll
              for (int kk = 0; kk < 8; ++kk) { bq_[0][kk] = ldg8(Bb + ((2 * kk + hh) * 64 + l32) * 8); bq_[1][kk] = ldg8(Bb + ((2 * kk + hh) * 64 + 32 + l32) * 8); }
#pragma unroll
              for (int kk = 0; kk < 8; ++kk) { cb00 = MFMA32(cf[0][kk], bq_[0][kk], cb00); cb10 = MFMA32(cf[1][kk], bq_[0][kk], cb10); cb11 = MFMA32(cf[1][kk], bq_[1][kk], cb11); } }
            asm volatile("s_waitcnt lgkmcnt(0)" ::: "memory"); __builtin_amdgcn_wave_barrier();
            const float as0 = acl[l32], as1 = acl[32 + l32], ds0 = dtl[l32], ds1 = dtl[32 + l32]; const float Dh = d_skip[h];
#pragma unroll
            for (int e = 0; e < 16; ++e) { const int tl = (e & 3) + 8 * (e >> 2) + 4 * hh; const float at0 = acl[tl], at1 = acl[32 + tl];
                { const int t = tl, s_ = l32; float m = (s_ <= t) ? cb00[e] * __expf(fminf(at0 - as0, 0.f)) * ds0 : 0.f; if (s_ == t) m += Dh; *(LAS unsigned short*)(Mw + t * S3_MROW + s_ * 2) = f2bf(m); }
                { const int t = tl; *(LAS unsigned short*)(Mw + t * S3_MROW + (32 + l32) * 2) = 0; }
                { const int t = 32 + tl, s_ = l32; const float m = cb10[e] * __expf(fminf(at1 - as0, 0.f)) * ds0; *(LAS unsigned short*)(Mw + t * S3_MROW + s_ * 2) = f2bf(m); }
                { const int t = 32 + tl, s_ = 32 + l32; float m = (s_ <= t) ? cb11[e] * __expf(fminf(at1 - as1, 0.f)) * ds1 : 0.f; if (s_ == t) m += Dh; *(LAS unsigned short*)(Mw + t * S3_MROW + s_ * 2) = f2bf(m); } }
        }
        f32x16 y[2][2];
#pragma unroll
        for (int a = 0; a < 2; ++a)
#pragma unroll
            for (int b = 0; b < 2; ++b)
#pragma unroll
                for (int e = 0; e < 16; ++e) y[a][b][e] = 0.f;
        bf16x8 hq_[2][5];
#pragma unroll
        for (int kk = 0; kk < 5; ++kk) { hq_[0][kk] = ldg8(Hb + ((2 * kk + hh) * 64 + l32) * 8); hq_[1][kk] = ldg8(Hb + ((2 * kk + hh) * 64 + 32 + l32) * 8); }
#pragma unroll
        for (int kk = 0; kk < 8; ++kk) {
            const int sl = kk < 5 ? kk : kk - 5;
            const bf16x8 h0 = hq_[0][sl], h1 = hq_[1][sl];
            y[0][0] = MFMA32(cf[0][kk], h0, y[0][0]); y[0][1] = MFMA32(cf[0][kk], h1, y[0][1]);
            y[1][0] = MFMA32(cf[1][kk], h0, y[1][0]); y[1][1] = MFMA32(cf[1][kk], h1, y[1][1]);
            if (kk < 3) { hq_[0][kk] = ldg8(Hb + ((2 * (kk + 5) + hh) * 64 + l32) * 8); hq_[1][kk] = ldg8(Hb + ((2 * (kk + 5) + hh) * 64 + 32 + l32) * 8); }
        }
        __builtin_amdgcn_sched_barrier(0);
        bf16x8 xq[2][4];
#pragma unroll
        for (int kk = 0; kk < 4; ++kk) { xq[0][kk] = ldg8(Xb + ((2 * kk + hh) * 64 + l32) * 8); xq[1][kk] = ldg8(Xb + ((2 * kk + hh) * 64 + 32 + l32) * 8); }
        const int r8 = lane >> 3, c8 = lane & 7;
        u32x4 zq[8];
#pragma unroll
        for (int it8 = 0; it8 < 8; ++it8) { const int t = it8 * 8 + r8; const int tr = (t < nvalid) ? t : 0; zq[it8] = *(const u32x4*)(ZY + (size_t)(row0 + tr) * 2048 + h * 64 + c8 * 8); }
#pragma unroll
        for (int tb = 0; tb < 2; ++tb)
#pragma unroll
            for (int e = 0; e < 16; ++e) { const float sc = __expf(acl[tb * 32 + (e & 3) + 8 * (e >> 2) + 4 * hh]); y[tb][0][e] *= sc; y[tb][1][e] *= sc; }
        __syncthreads();
#pragma unroll
        for (int kk = 0; kk < 4; ++kk) {
            const bf16x8 x0 = xq[0][kk], x1 = xq[1][kk];
            const bf16x8 m0 = *(const LAS bf16x8*)(Mw + (l32) * S3_MROW + (16 * kk + 8 * hh) * 2), m1 = *(const LAS bf16x8*)(Mw + (32 + l32) * S3_MROW + (16 * kk + 8 * hh) * 2);
            y[0][0] = MFMA32(m0, x0, y[0][0]); y[0][1] = MFMA32(m0, x1, y[0][1]);
            y[1][0] = MFMA32(m1, x0, y[1][0]); y[1][1] = MFMA32(m1, x1, y[1][1]);
        }
        asm volatile("s_waitcnt lgkmcnt(0)" ::: "memory"); __builtin_amdgcn_wave_barrier();
#pragma unroll
        for (int tb = 0; tb < 2; ++tb)
#pragma unroll
            for (int pb = 0; pb < 2; ++pb)
#pragma unroll
                for (int e = 0; e < 16; ++e) *(LAS float*)(Mw + (tb * 32 + (e & 3) + 8 * (e >> 2) + 4 * hh) * S3_YROW + (pb * 32 + l32) * 4) = y[tb][pb][e];
        asm volatile("s_waitcnt lgkmcnt(0)" ::: "memory"); __builtin_amdgcn_wave_barrier();
        float hv[8][8];
#pragma unroll
        for (int it = 0; it < 8; ++it) { const int t = it * 8 + r8; const int tr = (t < nvalid) ? t : 0;
            const f32x4 y0 = *(const LAS f32x4*)(Mw + t * S3_YROW + c8 * 32), y1 = *(const LAS f32x4*)(Mw + t * S3_YROW + c8 * 32 + 16);
            const u32x4 zw = zq[it]; (void)tr;
            float zf[8]; zf[0] = lo_f(zw.x); zf[1] = hi_f(zw.x); zf[2] = lo_f(zw.y); zf[3] = hi_f(zw.y); zf[4] = lo_f(zw.z); zf[5] = hi_f(zw.z); zf[6] = lo_f(zw.w); zf[7] = hi_f(zw.w);
            float sq = 0.f;
#pragma unroll
            for (int k = 0; k < 4; ++k) { hv[it][k] = y0[k] * siluf_(zf[k]); hv[it][4 + k] = y1[k] * siluf_(zf[4 + k]); sq += hv[it][k] * hv[it][k] + hv[it][4 + k] * hv[it][4 + k]; }
            sq += __shfl_xor(sq, 1); sq += __shfl_xor(sq, 2); sq += __shfl_xor(sq, 4);
            if (c8 == 0) SSQ[wave * 64 + t] = sq; }
        __syncthreads();
        float nw[8];
        { const f32x4 n0 = *(const f32x4*)(norm_w + h * 64 + c8 * 8), n1 = *(const f32x4*)(norm_w + h * 64 + c8 * 8 + 4);
#pragma unroll
          for (int k = 0; k < 4; ++k) { nw[k] = n0[k]; nw[4 + k] = n1[k]; } }
#pragma unroll
        for (int it = 0; it < 8; ++it) { const int t = it * 8 + r8;
            float sm = 0.f;
#pragma unroll
            for (int w = 0; w < 8; ++w) sm += SSQ[w * 64 + t];
            const float rs = rsqrtf(sm * (1.0f / 512.0f) + RMS_EPS);
            if (t < nvalid) { u32x4 o; o.x = pk2(hv[it][0] * rs * nw[0], hv[it][1] * rs * nw[1]); o.y = pk2(hv[it][2] * rs * nw[2], hv[it][3] * rs * nw[3]);
                o.z = pk2(hv[it][4] * rs * nw[4], hv[it][5] * rs * nw[5]); o.w = pk2(hv[it][6] * rs * nw[6], hv[it][7] * rs * nw[7]);
                *(u32x4*)(ZY + (size_t)(row0 + t) * 2048 + h * 64 + c8 * 8) = o; } }
    }
}

constexpr int IX_CAP = 896, IX_THR = 768, IX_KEEP = 320;
constexpr int IX_RING_OFF = 32 * IX_CAP * 4;
constexpr int IX_HIST_OFF = IX_RING_OFF + 32768;
constexpr int IX_CNT_OFF = IX_HIST_OFF + 8192;
constexpr int IX_TAU_OFF = IX_CNT_OFF + 128;
constexpr int IX_TAUF_OFF = IX_TAU_OFF + 128;
constexpr int IX_MISC_OFF = IX_TAUF_OFF + 128;
constexpr int IX_NITEMS = 1056;
static_assert(IX_MISC_OFF + 16 <= LDS_BYTES - 256, "indexer LDS");
#define WAVE_LDS_FENCE() do { asm volatile("s_waitcnt lgkmcnt(0)" ::: "memory"); __builtin_amdgcn_wave_barrier(); } while (0)

__device__ __forceinline__ float ix_tau_float(unsigned tau) {
    const unsigned m = tau & 0xFFFFC000u;
    const unsigned u = (m & 0x80000000u) ? (m ^ 0x80000000u) : ~m;
    return tau == 0u ? -INFINITY : __uint_as_float(u);
}
__device__ __forceinline__ unsigned wave_max_u32(unsigned x) {
    unsigned t;
    t = (unsigned)__builtin_amdgcn_update_dpp(0, (int)x, 0xB1, 0xF, 0xF, true); x = x > t ? x : t;
    t = (unsigned)__builtin_amdgcn_update_dpp(0, (int)x, 0x4E, 0xF, 0xF, true); x = x > t ? x : t;
    t = (unsigned)__builtin_amdgcn_update_dpp(0, (int)x, 0x141, 0xF, 0xF, true); x = x > t ? x : t;
    t = (unsigned)__builtin_amdgcn_update_dpp(0, (int)x, 0x140, 0xF, 0xF, true); x = x > t ? x : t;
    { const auto r = __builtin_amdgcn_permlane16_swap(x, x, false, false); x = r[0] > r[1] ? r[0] : r[1]; }
    { const auto r = __builtin_amdgcn_permlane32_swap(x, x, false, false); x = r[0] > r[1] ? r[0] : r[1]; }
    return x;
}
__device__ __forceinline__ unsigned wave_suffix_sum_u32(unsigned s, int lane) {
    s += (unsigned)__builtin_amdgcn_update_dpp(0, (int)s, 0x101, 0xF, 0xF, true);
    s += (unsigned)__builtin_amdgcn_update_dpp(0, (int)s, 0x102, 0xF, 0xF, true);
    s += (unsigned)__builtin_amdgcn_update_dpp(0, (int)s, 0x104, 0xF, 0xF, true);
    s += (unsigned)__builtin_amdgcn_update_dpp(0, (int)s, 0x108, 0xF, 0xF, true);
    const unsigned T1 = (unsigned)__builtin_amdgcn_readlane((int)s, 16), T2 = (unsigned)__builtin_amdgcn_readlane((int)s, 32), T3 = (unsigned)__builtin_amdgcn_readlane((int)s, 48);
    const int row = lane >> 4;
    return s + (row == 0 ? T1 + T2 + T3 : row == 1 ? T2 + T3 : row == 2 ? T3 : 0u);
}
__device__ __forceinline__ void ix_select(LAS unsigned* cr, LAS unsigned* hist, LAS unsigned* cntp, LAS unsigned* taup, LAS float* taufp, int n, unsigned tau_old, bool exact, int lane) {
    unsigned v[14]; unsigned mx = 0u;
#pragma unroll
    for (int i = 0; i < 14; ++i) { const int idx = lane + 64 * i; v[i] = (idx < n) ? cr[idx] : 0u; mx = v[i] > mx ? v[i] : mx; }
    mx = wave_max_u32(mx);
    unsigned lo = tau_old, hi = mx, kth = 256u, above_total = 0u;
#pragma unroll 1
    for (int round = 0; round < 6; ++round) {
        const unsigned span = hi - lo - 1u;
        const int shift = (span >> 8) ? (32 - __clz(span) - 8) : 0;
#pragma unroll
        for (int j = 0; j < 4; ++j) hist[lane * 4 + j] = 0u;
        WAVE_LDS_FENCE();
#pragma unroll
        for (int i = 0; i < 14; ++i) if (v[i] > lo && v[i] <= hi) __hip_atomic_fetch_add(&hist[(v[i] - lo - 1u) >> shift], 1u, __ATOMIC_RELAXED, __HIP_MEMORY_SCOPE_WORKGROUP);
        WAVE_LDS_FENCE();
        const unsigned h0 = hist[lane * 4 + 0], h1 = hist[lane * 4 + 1], h2 = hist[lane * 4 + 2], h3 = hist[lane * 4 + 3];
        const unsigned lsum = h0 + h1 + h2 + h3;
        const unsigned s = wave_suffix_sum_u32(lsum, lane);
        const unsigned a3 = s - lsum, a2 = a3 + h3, a1 = a2 + h2, a0 = a1 + h1;
        int found = -1; unsigned abv = 0u, inb = 0u;
        if (a3 < kth && kth <= a3 + h3) { found = 3; abv = a3; inb = h3; }
        else if (a2 < kth && kth <= a2 + h2) { found = 2; abv = a2; inb = h2; }
        else if (a1 < kth && kth <= a1 + h1) { found = 1; abv = a1; inb = h1; }
        else if (a0 < kth && kth <= a0 + h0) { found = 0; abv = a0; inb = h0; }
        const unsigned long long bal = __ballot(found >= 0);
        const int src = (bal != 0ull) ? (__ffsll((long long)bal) - 1) : 0;
        const unsigned bin = (unsigned)__builtin_amdgcn_readlane(lane * 4 + (found < 0 ? 0 : found), src); const unsigned ab = (unsigned)__builtin_amdgcn_readlane((int)abv, src), ib = (unsigned)__builtin_amdgcn_readlane((int)inb, src);
        WAVE_LDS_FENCE();
        kth -= ab; above_total += ab;
        const unsigned nlo = lo + (bin << shift);
        hi = (shift == 0) ? nlo + 1u : lo + ((bin + 1u) << shift); if (hi > mx) hi = mx;
        lo = nlo;
        if (shift == 0) break;
        if (!exact && above_total + ib <= (unsigned)IX_KEEP) break;
        if (exact && ib <= 64u) {
            unsigned base_ = 0u;
#pragma unroll
            for (int i = 0; i < 14; ++i) { const bool in_ = v[i] > lo && v[i] <= hi; const unsigned long long bal_ = __ballot(in_);
                const unsigned pos_ = base_ + (unsigned)__popcll(bal_ & ((1ull << lane) - 1ull)); if (in_) hist[pos_] = v[i]; base_ += (unsigned)__popcll(bal_); }
            WAVE_LDS_FENCE();
            const unsigned x_ = ((unsigned)lane < ib) ? hist[lane] : 0u; unsigned rank_ = 0u;
            for (unsigned m_ = 0; m_ < ib; ++m_) rank_ += (hist[m_] > x_) ? 1u : 0u;
            const unsigned long long hit_ = __ballot((unsigned)lane < ib && rank_ == kth - 1u);
            const int src_ = (hit_ != 0ull) ? (__ffsll((long long)hit_) - 1) : 0;
            lo = (unsigned)__builtin_amdgcn_readlane((int)x_, src_) - 1u;
            WAVE_LDS_FENCE();
            break;
        }
    }
    unsigned base = 0u;
#pragma unroll
    for (int i = 0; i < 14; ++i) { const bool keep = v[i] > lo; const unsigned long long bal = __ballot(keep);
        const unsigned pos = base + (unsigned)__popcll(bal & ((1ull << lane) - 1ull)); if (keep) cr[pos] = v[i]; base += (unsigned)__popcll(bal); }
    if (lane == 0) { *cntp = base; *taup = lo; *taufp = ix_tau_float(lo); }
    WAVE_LDS_FENCE();
}

#ifdef IXT
#define IXT_BEGIN(k) unsigned long long _t##k = (IXT == k) ? __builtin_amdgcn_s_memrealtime() : 0ull
#define IXT_END(k) do { if (IXT == k) ixt_acc += __builtin_amdgcn_s_memrealtime() - _t##k; } while (0)
#else
#define IXT_BEGIN(k) do {} while (0)
#define IXT_END(k) do {} while (0)
#endif
template <int VARIANT>
__device__ __forceinline__ void phase_indexer(const Params& p, LAS unsigned char* lds, int tid, int wave, int lane) {
    unsigned char* ws = p.ws;
    const bf16* QI = (const bf16*)(ws + WS_QI); const bf16* KI = (const bf16*)(ws + WS_KIALL); const float* WI = (const float*)(ws + WS_WI);
    unsigned short* SEL = (unsigned short*)(ws + WS_SEL);
    unsigned* queue = (unsigned*)(ws + WS_CTL) + CW_QUEUE + 64 * VARIANT;
    LAS unsigned* cand = (LAS unsigned*)lds; LAS unsigned* hist = (LAS unsigned*)(lds + IX_HIST_OFF) + wave * 256;
    LAS unsigned* cnt = (LAS unsigned*)(lds + IX_CNT_OFF); LAS unsigned* tau = (LAS unsigned*)(lds + IX_TAU_OFF); LAS float* tauf = (LAS float*)(lds + IX_TAUF_OFF);
    LAS unsigned* misc = (LAS unsigned*)(lds + IX_MISC_OFF);
    const int fr = lane & 15, fq = lane >> 4, rb = wave >> 2, cq = wave & 3;
    unsigned long long ixt_acc = 0ull; (void)ixt_acc;
#pragma unroll 1
    for (;;) {
        if (tid == 0) misc[0] = __hip_atomic_fetch_add(queue, 1u, __ATOMIC_RELAXED, __HIP_MEMORY_SCOPE_AGENT);
        __syncthreads();
        const int item = (int)misc[0];
        __syncthreads();
        if (item >= IX_NITEMS) break;
        bool samp = false; int b, c = 0, hf = 0;
        if (item < 764) { b = item & 1; hf = (item >> 1) & 1; c = 255 - (item >> 2); }
        else if (item < 796) { samp = true; b = item - 764; }
        else { const int j = item - 32; b = j & 1; hf = (j >> 1) & 1; c = 255 - (j >> 2); }
        const int qrow0 = samp ? MP + b * 32 : b * SEQP + c * 64 + hf * 32;
        const int krow0 = samp ? MP + b * SKEYS : b * SEQP, nkeys = samp ? SKEYS : 64 * (c + 1), nsteps = (nkeys + 127) >> 7;
        if (tid < 32) { cnt[tid] = 0u; tau[tid] = (VARIANT >= 1) ? 0xFFFFFFFFu : 0u; tauf[tid] = (VARIANT >= 1) ? __uint_as_float(0x7FFFC000u) : -INFINITY; }
        if (tid >= 32 && tid < 34) misc[tid - 30] = 0u;
        bf16x8 af[8][2], qt[2]; float wh[8][4];
        { const bf16* qp = QI + (size_t)(qrow0 + rb * 16 + fr) * 512 + 8 * fq;
#pragma unroll
          for (int h = 0; h < 8; ++h) { af[h][0] = ldg8(qp + h * 64); af[h][1] = ldg8(qp + h * 64 + 32); }
#pragma unroll
          for (int r = 0; r < 4; ++r) { const float* wp = WI + (size_t)(qrow0 + rb * 16 + 4 * fq + r) * 8;
              const f32x4 w0 = *(const f32x4*)wp, w1 = *(const f32x4*)(wp + 4);
#pragma unroll
              for (int e = 0; e < 4; ++e) { wh[e][r] = 0.5f * w0[e]; wh[4 + e][r] = 0.5f * w1[e]; } }
          const float* wp = WI + (size_t)(qrow0 + rb * 16 + fr) * 8; const f32x4 w0 = *(const f32x4*)wp, w1 = *(const f32x4*)(wp + 4);
          float wr_[8]; wr_[0] = w0[0]; wr_[1] = w0[1]; wr_[2] = w0[2]; wr_[3] = w0[3]; wr_[4] = w1[0]; wr_[5] = w1[1]; wr_[6] = w1[2]; wr_[7] = w1[3];
#pragma unroll
          for (int ks = 0; ks < 2; ++ks) { float a8[8];
#pragma unroll
              for (int e = 0; e < 8; ++e) a8[e] = 0.f;
#pragma unroll
              for (int h = 0; h < 8; ++h) { const u32x4 u = __builtin_bit_cast(u32x4, af[h][ks]); const float s_ = 0.5f * wr_[h];
                  a8[0] += s_ * lo_f(u.x); a8[1] += s_ * hi_f(u.x); a8[2] += s_ * lo_f(u.y); a8[3] += s_ * hi_f(u.y);
                  a8[4] += s_ * lo_f(u.z); a8[5] += s_ * hi_f(u.z); a8[6] += s_ * lo_f(u.w); a8[7] += s_ * hi_f(u.w); }
              u32x4 o; o.x = pk2(a8[0], a8[1]); o.y = pk2(a8[2], a8[3]); o.z = pk2(a8[4], a8[5]); o.w = pk2(a8[6], a8[7]); qt[ks] = __builtin_bit_cast(bf16x8, o); } }
        __syncthreads();
        const char* kib = (const char*)(KI + (size_t)krow0 * 64);
        const int srow = tid >> 3, sch = tid & 7;
#define IX_GLOAD(R, step) do { _Pragma("unroll") for (int i = 0; i < 2; ++i) { int key = (step) * 128 + srow + 64 * i; if (key > nkeys - 1) key = nkeys - 1; \
            R[i] = *(const u32x4*)(kib + ((unsigned)key * 128u + (unsigned)sch * 16u)); } } while (0)
#define IX_SWRITE(R, slot) do { _Pragma("unroll") for (int i = 0; i < 2; ++i) { const int k = srow + 64 * i; \
            *(LAS u32x4*)(lds + IX_RING_OFF + (slot) * 16384 + k * 128 + ((sch ^ (k & 7)) << 4)) = R[i]; } } while (0)
#define IX_COMPUTE(slot, step) do { \
            float sc[2][4]; unsigned long long pm = 0ull; \
            _Pragma("unroll") for (int cbi = 0; cbi < 2; ++cbi) { const int kl = cq * 32 + 16 * cbi + fr; \
                const bf16x8 b0 = *(const LAS bf16x8*)(lds + IX_RING_OFF + (slot) * 16384 + kl * 128 + ((fq ^ (kl & 7)) << 4)); \
                const bf16x8 b1 = *(const LAS bf16x8*)(lds + IX_RING_OFF + (slot) * 16384 + kl * 128 + (((4 + fq) ^ (kl & 7)) << 4)); \
                f32x4 acc = {0.f, 0.f, 0.f, 0.f}; acc = MFMA16(qt[0], b0, acc); acc = MFMA16(qt[1], b1, acc); \
                f32x4 dq = {0.f, 0.f, 0.f, 0.f}; dq = MFMA16(af[0][0], b0, dq); dq = MFMA16(af[0][1], b1, dq); \
                float a0_ = acc[0], a1_ = acc[1], a2_ = acc[2], a3_ = acc[3]; \
                  \
                _Pragma("unroll") for (int h = 0; h < (VARIANT == 2 ? 4 : 8); ++h) { f32x4 dn = {0.f, 0.f, 0.f, 0.f}; \
                    if (h + 1 < (VARIANT == 2 ? 4 : 8)) { dn = MFMA16(af[(h + 1) & 7][0], b0, dn); dn = MFMA16(af[(h + 1) & 7][1], b1, dn); } \
                    __builtin_amdgcn_sched_barrier(0); \
                    a0_ = __builtin_fmaf(wh[h][0], __builtin_fabsf(dq[0]), a0_); asm("" : "+v"(a0_)); a1_ = __builtin_fmaf(wh[h][1], __builtin_fabsf(dq[1]), a1_); asm("" : "+v"(a1_)); \
                    a2_ = __builtin_fmaf(wh[h][2], __builtin_fabsf(dq[2]), a2_); asm("" : "+v"(a2_)); a3_ = __builtin_fmaf(wh[h][3], __builtin_fabsf(dq[3]), a3_); asm("" : "+v"(a3_)); \
                    __builtin_amdgcn_sched_barrier(0); \
                    dq = dn; } \
                sc[cbi][0] = a0_; sc[cbi][1] = a1_; sc[cbi][2] = a2_; sc[cbi][3] = a3_; \
                pm |= __ballot(a0_ >= tf[0]) | __ballot(a1_ >= tf[1]) | __ballot(a2_ >= tf[2]) | __ballot(a3_ >= tf[3]); } \
            if (pm != 0ull) { IXT_BEGIN(2); \
                unsigned pk[2][4], sl[2][4]; bool ps[2][4]; \
                _Pragma("unroll") for (int cbi = 0; cbi < 2; ++cbi) { const int kidx = (step) * 128 + cq * 32 + 16 * cbi + fr; const bool inr = kidx < nkeys; const unsigned low = (unsigned)(16383 - kidx); \
                    _Pragma("unroll") for (int r = 0; r < 4; ++r) { const unsigned u = __float_as_uint(sc[cbi][r]); const unsigned mono = u ^ ((unsigned)((int)u >> 31) | 0x80000000u); \
                        pk[cbi][r] = (mono & 0xFFFFC000u) | low; ps[cbi][r] = inr && (pk[cbi][r] > tq[r]); sl[cbi][r] = 0u; \
                        if (ps[cbi][r]) sl[cbi][r] = __hip_atomic_fetch_add(cntw + r, 1u, __ATOMIC_RELAXED, __HIP_MEMORY_SCOPE_WORKGROUP); } } \
                _Pragma("unroll") for (int cbi = 0; cbi < 2; ++cbi) _Pragma("unroll") for (int r = 0; r < 4; ++r) if (ps[cbi][r]) candw[r * IX_CAP + sl[cbi][r]] = pk[cbi][r]; \
            IXT_END(2); } } while (0)
#define IX_THRESH() do { _Pragma("unroll") for (int r = 0; r < 4; ++r) { tf[r] = tauf[rb * 16 + 4 * fq + r]; tq[r] = tau[rb * 16 + 4 * fq + r]; } } while (0)
#define IX_CHECK(cp, t) do { const unsigned E_ = misc[2 + ((t) & 1)]; \
            if ((cp) || E_ != 0u) { _Pragma("unroll 1") for (int rr = 0; rr < 4; ++rr) { const int row = wave * 4 + rr; const int n_ = (int)cnt[row]; \
                    if (n_ > ((cp) ? 256 : 512)) ix_select(cand + row * IX_CAP, hist, cnt + row, tau + row, tauf + row, n_, tau[row], false, lane); } \
                __syncthreads(); IX_THRESH(); } \
            if (wave == 0) { const unsigned cv = (lane < 32) ? cnt[lane] : 0u; const unsigned long long over = __ballot(cv > 640u); if (lane == 0) misc[2 + (((t) + 1) & 1)] = (over != 0ull) ? 1u : 0u; } } while (0)
        LAS unsigned* cntw = cnt + rb * 16 + 4 * fq; LAS unsigned* candw = cand + (rb * 16 + 4 * fq) * IX_CAP;
        float tf[4]; unsigned tq[4]; IX_THRESH();
        u32x4 RA[2], RB[2];
        IX_GLOAD(RA, 0); IX_GLOAD(RB, 1);
        IX_SWRITE(RA, 0); IX_GLOAD(RA, 2);
        __syncthreads();
#define IX_CP(done) (((done) == 4 || (done) == 8 || (done) == 16 || (done) == 32 || (done) == 64) && (done) < nsteps)
#pragma unroll 1
        for (int t0 = 0; t0 < nsteps; t0 += 2) {
            IX_SWRITE(RB, 1); IX_GLOAD(RB, t0 + 3);
            IX_COMPUTE(0, t0);
            __syncthreads();
            { IXT_BEGIN(1); const bool cp = IX_CP(t0 + 1); IX_CHECK(cp, t0); IXT_END(1); }
            IX_SWRITE(RA, 0); IX_GLOAD(RA, t0 + 4);
            if (t0 + 1 < nsteps) IX_COMPUTE(1, t0 + 1);
            __syncthreads();
            { IXT_BEGIN(1); const bool cp = IX_CP(t0 + 2); IX_CHECK(cp, t0 + 1); IXT_END(1); }
        }
        IXT_BEGIN(3);
#pragma unroll 1
        for (int rr = 0; rr < 4; ++rr) { const int row = wave * 4 + rr;
            int n = (int)cnt[row]; if (n > 256) { ix_select(cand + row * IX_CAP, hist, cnt + row, tau + row, tauf + row, n, tau[row], true, lane); n = (int)cnt[row]; if (n > 256) n = 256; }
            unsigned short* sp = SEL + (size_t)(qrow0 + row) * 256;
#pragma unroll
            for (int i = 0; i < 4; ++i) { const int k = lane + 64 * i; if (k < n) sp[k] = (unsigned short)(16383u - (cand[row * IX_CAP + k] & 16383u)); } }
        IXT_END(3);
        __syncthreads();
#undef IX_GLOAD
#undef IX_SWRITE
#undef IX_COMPUTE
#undef IX_THRESH
#undef IX_CP
#undef IX_CHECK
    }
#ifdef IXT
    if (VARIANT == 0 && tid == 0) *(LAS unsigned long long*)(lds + LDS_BYTES - 8) = ixt_acc;
#endif
}

constexpr int AT_BIAS_OFF = 131072;
constexpr int AT_T5_OFF = AT_BIAS_OFF + 2048;
constexpr int AT_SEL_OFF = AT_T5_OFF + 512 + 64;
static_assert(AT_SEL_OFF + 4096 <= LDS_BYTES, "attention LDS");
__device__ __forceinline__ void unpack8(const u32x4 w, float (&f)[8]) { f[0] = lo_f(w.x); f[1] = hi_f(w.x); f[2] = lo_f(w.y); f[3] = hi_f(w.y); f[4] = lo_f(w.z); f[5] = hi_f(w.z); f[6] = lo_f(w.w); f[7] = hi_f(w.w); }
__device__ __forceinline__ float oct_add(float x) {
    x += __builtin_bit_cast(float, __builtin_amdgcn_update_dpp(0, __builtin_bit_cast(int, x), 0xB1, 0xF, 0xF, true));
    x += __builtin_bit_cast(float, __builtin_amdgcn_update_dpp(0, __builtin_bit_cast(int, x), 0x4E, 0xF, 0xF, true));
    x += __builtin_bit_cast(float, __builtin_amdgcn_update_dpp(0, __builtin_bit_cast(int, x), 0x141, 0xF, 0xF, true));
    return x;
}
__device__ __forceinline__ void unpack8_fp8(const u32x2 w, float (&f)[8]) {
    const f32x2v a0 = __builtin_amdgcn_cvt_pk_f32_fp8((int)w.x, false), a1 = __builtin_amdgcn_cvt_pk_f32_fp8((int)w.x, true), b0 = __builtin_amdgcn_cvt_pk_f32_fp8((int)w.y, false), b1 = __builtin_amdgcn_cvt_pk_f32_fp8((int)w.y, true);
    f[0] = a0.x; f[1] = a0.y; f[2] = a1.x; f[3] = a1.y; f[4] = b0.x; f[5] = b0.y; f[6] = b1.x; f[7] = b1.y;
}
__device__ __forceinline__ unsigned xb_xcc_id();
__device__ __forceinline__ unsigned xb_ld(unsigned* p);
constexpr int AT_BK_OFF = AT_SEL_OFF + 4096;
static_assert(AT_BK_OFF + 2048 <= LDS_BYTES - 256, "attention LDS");
typedef long i64_t;
__device__ __forceinline__ void phase_attn(const Params& p, LAS unsigned char* lds, int tid, int wave, int lane) {
    unsigned char* ws = p.ws;
    bf16* QO = (bf16*)(ws + WS_Q); const unsigned char* KA = ws + WS_KALL; const unsigned char* VA = ws + WS_VALL;
    const unsigned short* SEL = (const unsigned short*)(ws + WS_SEL);
    LAS float* bias = (LAS float*)(lds + AT_BIAS_OFF); LAS int* t5 = (LAS int*)(lds + AT_T5_OFF);
    LAS float* L = (LAS float*)lds + wave * 4096; LAS unsigned short* S = (LAS unsigned short*)(lds + AT_SEL_OFF) + wave * 256;
    LAS unsigned char* BK = lds + AT_BK_OFF + wave * 256;
    bias[tid] = p.in[7][tid];
    if (tid < 128) { const int n = tid; int v; if (n < 8) v = n; else { int k2 = 0; while (k2 < 12 && n * n >= (64 << (k2 + 1))) ++k2; v = 8 + k2; if (v > 15) v = 15; } t5[n] = v; }
    __syncthreads();
    const int half = lane >> 5, l32 = lane & 31, j = l32 >> 3, sub = l32 & 7, d0 = 8 * sub;
    const int fr = lane & 15, fq = lane >> 4;
    const int G = gridDim.x;
    if (tid == 0) { unsigned* ctl = (unsigned*)(ws + WS_CTL); const unsigned x = xb_xcc_id(); bool even = (G == 256);
        for (int jx = 0; jx < 8; ++jx) even = even && (xb_ld(ctl + CW_BAR + 256 + 64 * jx) == 32u);
        const unsigned t = even ? __hip_atomic_fetch_add(ctl + CW_ATT + 64 * (x & 7u), 1u, __ATOMIC_RELAXED, __HIP_MEMORY_SCOPE_AGENT) : 0u;
        t5[128 + 0] = even ? 1 : 0; t5[128 + 1] = (int)(x & 7u); t5[128 + 2] = (int)t; }
    __syncthreads();
    const bool xcd_order = t5[128] != 0;
    const int xl = t5[129], lw = t5[130] * 8 + wave;
    const int niter = xcd_order ? 17 : (MT + G * 8 - 1) / (G * 8);
    auto qr_at = [&](int itq) -> int {
        if (xcd_order) { return itq < 8 ? 2048 * xl + itq * 256 + lw : itq < 16 ? SEQP + 2048 * (7 - xl) + (itq - 8) * 256 + lw : MP + xl * 128 + lw; }
        return itq * (G * 8) + blockIdx.x * 8 + wave; };
    int nq = niter;
    if (xcd_order) { if (lw >= 128) nq = 16; } else { while (nq > 0 && qr_at(nq - 1) >= MT) --nq; }
    u32x2 sw_n = {0u, 0u};
    const unsigned o_lo = (unsigned)(4 * j * 64 + d0) * 2u;
    const unsigned sel_lo = (unsigned)lane * 8u, q_lo = (unsigned)(fr * 64 + 16 * fq) * 2u;
    if (nq > 0) { const int q0_ = qr_at(0); sw_n = *(const u32x2*)((const unsigned char*)(SEL + (size_t)q0_ * 256) + sel_lo); }
#pragma unroll 1
    for (int itq = 0; itq < nq; ++itq) {
        const int qr = qr_at(itq);
        const u32x2 sw = sw_n;
        const unsigned char* qp_ = (const unsigned char*)(QO + (size_t)qr * 1024); const u32x4 w0 = *(const u32x4*)(qp_ + q_lo), w1 = *(const u32x4*)(qp_ + (q_lo + 16u));
        int krow0, pos, nsel;
        if (qr < MP) { const int b = qr >> 14, t = qr & 16383; krow0 = b * SEQP; pos = t; nsel = 64 * ((t >> 6) + 1); if (nsel > 256) nsel = 256; }
        else { const int rs = qr - MP, b = rs >> 5, t = rs & 31; krow0 = MP + b * SKEYS; pos = PAST + t; nsel = 256; }
        const int ntile = nsel >> 4;
        {
          int bw_ = 0; unsigned short id4[4];
#pragma unroll
          for (int i = 0; i < 4; ++i) { const int k = 4 * lane + i; const unsigned raw = ((i & 2) ? sw.y : sw.x) >> (16 * (i & 1)) & 0xffffu; const int idx = (k < nsel) ? (int)raw : 0; id4[i] = (unsigned short)idx;
              const int rel = idx - pos, n = rel < 0 ? -rel : rel; const int t5v = t5[n < 128 ? n : 127]; const int bk = (rel > 0 ? 16 : 0) + (n < 128 ? t5v : 15); bw_ |= bk << (8 * i); }
          u32x2 so; so.x = (unsigned)id4[0] | ((unsigned)id4[1] << 16); so.y = (unsigned)id4[2] | ((unsigned)id4[3] << 16);
          *(LAS u32x2*)(S + 4 * lane) = so; *(LAS int*)(BK + 4 * lane) = bw_; }
        i64_t bq[4][2];
        { float t0[8], t1[8]; unpack8(w0, t0); unpack8(w1, t1);
          const unsigned a0 = pk4_fp8(t0[0] * 0.125f, t0[1] * 0.125f, t0[2] * 0.125f, t0[3] * 0.125f), a1 = pk4_fp8(t0[4] * 0.125f, t0[5] * 0.125f, t0[6] * 0.125f, t0[7] * 0.125f);
          const unsigned c0 = pk4_fp8(t1[0] * 0.125f, t1[1] * 0.125f, t1[2] * 0.125f, t1[3] * 0.125f), c1 = pk4_fp8(t1[4] * 0.125f, t1[5] * 0.125f, t1[6] * 0.125f, t1[7] * 0.125f);
          const i64_t q0 = (i64_t)(((unsigned long long)a1 << 32) | a0), q1 = (i64_t)(((unsigned long long)c1 << 32) | c0);
#pragma unroll
          for (int m = 0; m < 4; ++m) { const bool mine = (fr >> 2) == m; bq[m][0] = mine ? q0 : (i64_t)0; bq[m][1] = mine ? q1 : (i64_t)0; } }
        WAVE_LDS_FENCE();
        const unsigned char* kbase = KA + (size_t)krow0 * 256; const unsigned char* vbase = VA + (size_t)krow0 * 256;
        u32x4 kA[2][4], kB[2][4];
#define AT_KISSUE(buf, tb) do { _Pragma("unroll") for (int u = 0; u < 2; ++u) { const unsigned idx = (unsigned)S[16 * (2 * (tb) + u) + fr]; \
            _Pragma("unroll") for (int m = 0; m < 4; ++m) buf[u][m] = *(const u32x4*)(kbase + (idx * 256u + (unsigned)(64 * m + 16 * fq))); } } while (0)
#define AT_KMMA(buf, tb) do { _Pragma("unroll") for (int u = 0; u < 2; ++u) { f32x4 acc = {0.f, 0.f, 0.f, 0.f}; \
            _Pragma("unroll") for (int m = 0; m < 4; ++m) { const i64_t lo_ = (i64_t)(((unsigned long long)buf[u][m].y << 32) | buf[u][m].x), hi_ = (i64_t)(((unsigned long long)buf[u][m].w << 32) | buf[u][m].z); \
                acc = __builtin_amdgcn_mfma_f32_16x16x32_fp8_fp8(lo_, bq[m][0], acc, 0, 0, 0); acc = __builtin_amdgcn_mfma_f32_16x16x32_fp8_fp8(hi_, bq[m][1], acc, 0, 0, 0); } \
            _Pragma("unroll") for (int r = 0; r < 4; ++r) L[(16 * (2 * (tb) + u) + 4 * fq + r) * 16 + fr] = acc[r]; } } while (0)
        const int ntb = ntile >> 1;
        AT_KISSUE(kA, 0);
#pragma unroll 1
        for (int tb = 0; tb < ntb; tb += 2) {
            AT_KISSUE(kB, tb + 1);
            AT_KMMA(kA, tb);
            { const int tx = (tb + 2 < ntb) ? tb + 2 : ntb - 1; AT_KISSUE(kA, tx); }
            AT_KMMA(kB, tb + 1);
        }
        u32x2 bA[16], bB[16];
#define AT_ISSUE(buf, bi, base) do { _Pragma("unroll") for (int u = 0; u < 16; ++u) { const unsigned idx = (unsigned)S[2 * (16 * (bi) + u) + half]; buf[u] = *(const u32x2*)((base) + (idx * 256u + (unsigned)l32 * 8u)); } } while (0)
        AT_ISSUE(bA, 0, vbase);
        { const int qn = qr_at(itq + 1 < nq ? itq + 1 : itq);
          sw_n = *(const u32x2*)((const unsigned char*)(SEL + (size_t)qn * 256) + sel_lo); }
        WAVE_LDS_FENCE();
        { const int h = lane & 15, kq = lane >> 4; LAS float* lp = L + (kq * 64) * 16 + h; LAS unsigned char* bp = BK + kq * 64;
          float v[64]; float mx = -INFINITY;
          const bool ok = kq * 64 < nsel;
          u32x4 bw[4];
#pragma unroll
          for (int i = 0; i < 4; ++i) bw[i] = *(const LAS u32x4*)(bp + 16 * i);
#pragma unroll
          for (int c = 0; c < 4; ++c) { float bb[16], ll[16]; __builtin_amdgcn_sched_barrier(0);
#pragma unroll
              for (int k = 0; k < 16; ++k) ll[k] = lp[(16 * c + k) * 16];
#pragma unroll
              for (int k = 0; k < 16; ++k) { const unsigned w_ = bw[c][k >> 2]; const unsigned bk_ = (w_ >> (8 * (k & 3))) & 0xffu; bb[k] = bias[bk_ * 16 + h]; }
#pragma unroll
              for (int k = 0; k < 16; ++k) { asm volatile("" : "+v"(ll[k]), "+v"(bb[k])); v[16 * c + k] = ok ? ll[k] + bb[k] : -INFINITY; mx = fmaxf(mx, v[16 * c + k]); } }
          mx = fmaxf(mx, __shfl_xor(mx, 16)); mx = fmaxf(mx, __shfl_xor(mx, 32));
          float sm = 0.f;
#pragma unroll
          for (int k = 0; k < 64; ++k) { v[k] = __expf(v[k] - mx); sm += v[k]; }
          sm += __shfl_xor(sm, 16); sm += __shfl_xor(sm, 32);
          const float inv = 1.0f / sm;
#pragma unroll
          for (int k = 0; k < 64; ++k) lp[k * 16] = v[k] * inv; }
        WAVE_LDS_FENCE();
        const int nbat = (nsel + 31) >> 5;
        float acc[4][8];
#pragma unroll
        for (int g = 0; g < 4; ++g)
#pragma unroll
            for (int e = 0; e < 8; ++e) acc[g][e] = 0.f;
#define AT_PV(buf, bi) do { _Pragma("unroll") for (int u = 0; u < 16; ++u) { const int ks = 2 * (16 * (bi) + u) + half; \
            const f32x4 pr = *(const LAS f32x4*)(L + ks * 16 + 4 * j); float vf[8]; unpack8_fp8(buf[u], vf); \
            _Pragma("unroll") for (int g = 0; g < 4; ++g) _Pragma("unroll") for (int e = 0; e < 8; ++e) acc[g][e] += pr[g] * vf[e]; } } while (0)
#pragma unroll 1
        for (int bi = 0; bi < nbat; bi += 2) {
            AT_ISSUE(bB, bi + 1, vbase);
            AT_PV(bA, bi);
            { const int bx = (bi + 2 < nbat) ? bi + 2 : nbat - 1; AT_ISSUE(bA, bx, vbase); }
            AT_PV(bB, bi + 1);
        }
#pragma unroll
        for (int g = 0; g < 4; ++g)
#pragma unroll
            for (int e = 0; e < 8; ++e) acc[g][e] += __shfl_xor(acc[g][e], 32);
        if (half == 0) {
#pragma unroll
            for (int g = 0; g < 4; ++g) { u32x4 o; o.x = pk2(acc[g][0], acc[g][1]); o.y = pk2(acc[g][2], acc[g][3]); o.z = pk2(acc[g][4], acc[g][5]); o.w = pk2(acc[g][6], acc[g][7]);
                *(u32x4*)((unsigned char*)(QO + (size_t)qr * 1024) + (o_lo + (unsigned)g * 128u)) = o; }
        }
        WAVE_LDS_FENCE();
    }
#undef AT_KISSUE
#undef AT_KMMA
#undef AT_ISSUE
#undef AT_PV
}

template <bool TO_BF16>
__device__ __forceinline__ void phase_ln(const bf16* src, void* dst, const float* gam, const float* bet, int wave, int lane, const float* slab, int nslab, const float* resx, const bf16* resh) {
    const int gw = blockIdx.x * 8 + wave, NGW = gridDim.x * 8;
    f32x4 gv[4], bv[4];
#pragma unroll
    for (int jj = 0; jj < 4; ++jj) { gv[jj] = *(const f32x4*)(gam + lane * 4 + 256 * jj); bv[jj] = *(const f32x4*)(bet + lane * 4 + 256 * jj); }
#define LN_LOAD(V, r_) do { const int rr_ = (r_); if (rr_ < MP) { const bf16* xr = src + (size_t)rr_ * 1024 + lane * 4; \
            _Pragma("unroll") for (int jj = 0; jj < 4; ++jj) { const u32x2 w = *(const u32x2*)(xr + 256 * jj); V[jj][0] = lo_f(w.x); V[jj][1] = hi_f(w.x); V[jj][2] = lo_f(w.y); V[jj][3] = hi_f(w.y); } } \
        else if (rr_ < MT) {     \
            _Pragma("unroll") for (int jj = 0; jj < 4; ++jj) { const size_t o = (size_t)(rr_ - MP) * 1024 + lane * 4 + 256 * jj; \
                if (resx) V[jj] = *(const f32x4*)(resx + o) * ALPHA; \
                else { const u32x2 hv = *(const u32x2*)(resh + (size_t)rr_ * 1024 + lane * 4 + 256 * jj); V[jj][0] = lo_f(hv.x) * ALPHA; V[jj][1] = hi_f(hv.x) * ALPHA; V[jj][2] = lo_f(hv.y) * ALPHA; V[jj][3] = hi_f(hv.y) * ALPHA; } \
                for (int k = 0; k < nslab; ++k) V[jj] += *(const f32x4*)(slab + (size_t)k * MS * 1024 + o); } } } while (0)
    f32x4 vn[4];
    LN_LOAD(vn, gw);
#pragma unroll 1
    for (int r = gw; r < MT; r += NGW) {
        f32x4 v[4]; float s = 0.f;
#pragma unroll
        for (int jj = 0; jj < 4; ++jj) v[jj] = vn[jj];
        LN_LOAD(vn, r + NGW);
#pragma unroll
        for (int jj = 0; jj < 4; ++jj) s += (v[jj][0] + v[jj][1]) + (v[jj][2] + v[jj][3]);
        const float mean = wave_sum(s) * (1.0f / 1024.0f); float s2 = 0.f;
#pragma unroll
        for (int jj = 0; jj < 4; ++jj) { v[jj] = v[jj] - mean; s2 += (v[jj][0] * v[jj][0] + v[jj][1] * v[jj][1]) + (v[jj][2] * v[jj][2] + v[jj][3] * v[jj][3]); }
        const float rstd = rsqrtf(wave_sum(s2) * (1.0f / 1024.0f) + LN_EPS);
#pragma unroll
        for (int jj = 0; jj < 4; ++jj) { const f32x4 o = v[jj] * rstd * gv[jj] + bv[jj];
            if (TO_BF16) { u32x2 w; w.x = pk2(o[0], o[1]); w.y = pk2(o[2], o[3]); *(u32x2*)((bf16*)dst + (size_t)r * 1024 + lane * 4 + 256 * jj) = w; }
            else *(f32x4*)((float*)dst + (size_t)r * 1024 + lane * 4 + 256 * jj) = o; }
    }
#undef LN_LOAD
}

#define XB_TMO      128
#define XB_XCNT(j)  (256  + 64 * (j))
#define XB_XSUB(j)  (1280 + 64 * (j))
#define XB_XGEN(j)  (2304 + 64 * (j))
#define XB_TOP      3328
#define XB_TOPGEN   3392
#define XCD_BAR_WORDS 3456
#define XB_SPIN_CAP (1u << 18)

__device__ __forceinline__ unsigned xb_ld(unsigned* p)              { return __hip_atomic_load(p, __ATOMIC_RELAXED, __HIP_MEMORY_SCOPE_AGENT); }
__device__ __forceinline__ unsigned xb_add(unsigned* p, unsigned v) { return __hip_atomic_fetch_add(p, v, __ATOMIC_RELAXED, __HIP_MEMORY_SCOPE_AGENT); }
__device__ __forceinline__ unsigned xb_xcc_id() { return (unsigned)__builtin_amdgcn_s_getreg((3 << 11) | 20) & 0xFu; }
#define XB_SPIN(cond, bar) do { unsigned _sp = 0; while (cond) { __builtin_amdgcn_s_sleep(1); \
    if ((++_sp & 255u) == 0u) { if (xb_ld(&(bar)[XB_TMO])) break; if (_sp > XB_SPIN_CAP) { atomicAdd(&(bar)[XB_TMO], 1u); break; } } } } while (0)

struct XcdBarrier {
    unsigned* bar; unsigned x;
    volatile LAS unsigned* st;
};

__device__ __forceinline__ XcdBarrier xcd_barrier_post(unsigned* bar, volatile LAS unsigned* st) {
    XcdBarrier b; b.bar = bar; b.x = xb_xcc_id(); b.st = st;
    if (threadIdx.x == 0) (void)xb_add(&bar[XB_XCNT(b.x)], 1u);
    return b;
}
__device__ __forceinline__ void xcd_barrier_complete(unsigned* bar, unsigned x, unsigned& nloc, unsigned& nx) {
    const unsigned G = gridDim.x * gridDim.y * gridDim.z;
    unsigned sum, cnt, mine, sp = 0u;
    for (;;) {
        sum = 0u; cnt = 0u; mine = 0u;
#pragma unroll
        for (unsigned j = 0; j < 16; ++j) { const unsigned c = xb_ld(&bar[XB_XCNT(j)]); sum += c; cnt += (c > 0u) ? 1u : 0u; mine = (j == x) ? c : mine; }
        if (sum == G) break;
        __builtin_amdgcn_s_sleep(1);
        if ((++sp & 255u) == 0u) { if (xb_ld(&bar[XB_TMO])) break; if (sp > XB_SPIN_CAP) { atomicAdd(&bar[XB_TMO], 1u); break; } }
    }
    nloc = mine > 0u ? mine : 1u; nx = cnt > 0u ? cnt : 1u;
}

__device__ __forceinline__ void xcd_barrier(const XcdBarrier& b) {
    asm volatile("s_waitcnt vmcnt(0)" ::: "memory");
    __syncthreads();
    if (threadIdx.x == 0) {
        unsigned* bar = b.bar;
        __builtin_amdgcn_s_waitcnt(0);
        unsigned nloc = b.st[0], nx = b.st[1];
        if (nloc == 0u) { xcd_barrier_complete(bar, b.x, nloc, nx); b.st[0] = nloc; b.st[1] = nx; }
        const unsigned old = xb_add(&bar[XB_XSUB(b.x)], 1u);
        const unsigned gen = old / nloc;
        if (old + 1u == (gen + 1u) * nloc) {
            __builtin_amdgcn_fence(__ATOMIC_RELEASE, "agent");
            asm volatile("s_waitcnt vmcnt(0)" ::: "memory");
            const unsigned og = xb_add(&bar[XB_TOP], 1u);
            const unsigned tg = og / nx;
            if (og + 1u == (tg + 1u) * nx) xb_add(&bar[XB_TOPGEN], 1u);
            else XB_SPIN(xb_ld(&bar[XB_TOPGEN]) == tg, bar);
            __builtin_amdgcn_fence(__ATOMIC_ACQUIRE, "agent");
            xb_add(&bar[XB_XGEN(b.x)], 1u);
            asm volatile("s_waitcnt vmcnt(0)" ::: "memory");
        } else {
            XB_SPIN(xb_ld(&bar[XB_XGEN(b.x)]) == gen, bar);
            __builtin_amdgcn_fence(__ATOMIC_ACQUIRE, "agent");
            asm volatile("s_waitcnt vmcnt(0)" ::: "memory");
        }
    }
    __syncthreads();
}

__global__ void __launch_bounds__(512, 2) hybrid_fwd(Params p) {
    extern __shared__ __attribute__((aligned(16))) unsigned char lds_raw[];
    LAS unsigned char* lds = (LAS unsigned char*)lds_raw;
    cg::grid_group grid = cg::this_grid();
    const int tid = threadIdx.x, lane = tid & 63, wave = __builtin_amdgcn_readfirstlane(tid >> 6);
    unsigned char* ws = p.ws;
    if (tid < 2) ((volatile LAS unsigned*)(lds + LDS_BYTES - 32))[tid] = 0u;
    __syncthreads();
    const XcdBarrier xbar = xcd_barrier_post((unsigned*)(ws + WS_CTL) + CW_BAR, (volatile LAS unsigned*)(lds + LDS_BYTES - 32));
#ifdef PROBE_A
    LAS unsigned long long* tsl = (LAS unsigned long long*)(lds + LDS_BYTES - 256);
    int tsn = 0;
#define STAMP() do { if (blockIdx.x == 0 && tid == 0) tsl[tsn] = __builtin_amdgcn_s_memrealtime(); ++tsn; } while (0)
#else
#define STAMP() do {} while (0)
#endif
    STAMP();
#ifndef PHASE_MASK
#define PHASE_MASK 0x7fff
#endif
#define IN(k) (((PHASE_MASK >> (k)) & 1) && p.ph_lo <= (k) && (k) < p.ph_hi)
    if (IN(0)) phase_prologue(p, lds, tid, wave, lane);
    grid.sync(); STAMP();
    if (IN(1)) {
        pg8::Gemm g{(const bf16*)(ws + WS_XB), (const bf16*)(ws + WS_WIN), MT, NIN, 1024}; pg8::StaticOrder S; S.init(MT, NIN, gridDim.x, blockIdx.x);
        pg8::EpiInProj E{(bf16*)(ws + WS_Z), (bf16*)(ws + WS_XBC), (bf16*)(ws + WS_Q), ws + WS_KALL, ws + WS_VALL, (bf16*)(ws + WS_QI), (bf16*)p.out, (bf16*)(ws + WS_KIALL),
                         (float*)(ws + WS_DT), (float*)(ws + WS_WI), p.out, p.in[11]};
        pg8::gemm_phase<pg8::EpiInProj, pg8::StaticOrder, true, true>(lds, g, S, E);
    }
    xcd_barrier(xbar); STAMP();
#ifdef IX_DUMMY
    if (IN(2)) phase_indexer<IX_DUMMY>(p, lds, tid, wave, lane);
    xcd_barrier(xbar);
#endif
    if (IN(2)) phase_indexer<0>(p, lds, tid, wave, lane);
    xcd_barrier(xbar); STAMP();
    if (IN(3)) phase_attn(p, lds, tid, wave, lane);
    xcd_barrier(xbar); STAMP();
    if (IN(4)) phase_conv(p, lds, tid);
    xcd_barrier(xbar); STAMP();
    if (IN(5)) phase_s1(p, wave, lane);
    xcd_barrier(xbar); STAMP();
    if (IN(6)) phase_s2(p, tid);
    xcd_barrier(xbar); STAMP();
    if (IN(7)) phase_s3(p, lds, wave, lane);
    xcd_barrier(xbar); STAMP();
    if (IN(8)) {
        pg8::Gemm g{(const bf16*)(ws + WS_Z), (const bf16*)(ws + WS_WSSD), MT, 1024, 2048}; pg8::SlicedOrder S; S.init(MP, MT, 1024, 2048, 256, gridDim.x, blockIdx.x);
        pg8::EpiMixA E{(const bf16*)p.out, (bf16*)(ws + WS_T), (float*)(ws + WS_R57)};
        pg8::gemm_phase<pg8::EpiMixA, pg8::SlicedOrder, true, true>(lds, g, S, E);
    }
    xcd_barrier(xbar); STAMP();
    if (IN(9)) {
        pg8::Gemm g{(const bf16*)(ws + WS_Q), (const bf16*)(ws + WS_WATT), MT, 1024, 1024}; pg8::SlicedOrder S; S.init(MP, MT, 1024, 1024, 256, gridDim.x, blockIdx.x);
        pg8::EpiMixB E{(const bf16*)p.out, (const bf16*)(ws + WS_T), (bf16*)(ws + WS_MIX), (float*)(ws + WS_R57) + (size_t)8 * MS * 1024};
        pg8::gemm_phase<pg8::EpiMixB, pg8::SlicedOrder, true, true>(lds, g, S, E);
    }
    xcd_barrier(xbar);
    if (IN(9)) {
        const float* SA = (const float*)(ws + WS_R57); const float* SB = SA + (size_t)8 * MS * 1024; const bf16* Gt = (const bf16*)p.out; bf16* MX = (bf16*)(ws + WS_MIX);
        for (int i = blockIdx.x * 512 + tid; i < MS * 256; i += gridDim.x * 512) { const int r = i >> 8, c = (i & 255) * 4; const size_t o = (size_t)r * 1024 + c;
            f32x4 a = *(const f32x4*)(SA + o), b = *(const f32x4*)(SB + o);
#pragma unroll
            for (int k = 1; k < 8; ++k) a += *(const f32x4*)(SA + (size_t)k * MS * 1024 + o);
#pragma unroll
            for (int k = 1; k < 4; ++k) b += *(const f32x4*)(SB + (size_t)k * MS * 1024 + o);
            const u32x2 g1 = *(const u32x2*)(Gt + (size_t)(MP + r) * 2048 + c), g2 = *(const u32x2*)(Gt + (size_t)(MP + r) * 2048 + 1024 + c);
            u32x2 w; w.x = pk2(a[0] * lo_f(g1.x) + b[0] * lo_f(g2.x), a[1] * hi_f(g1.x) + b[1] * hi_f(g2.x)); w.y = pk2(a[2] * lo_f(g1.y) + b[2] * lo_f(g2.y), a[3] * hi_f(g1.y) + b[3] * hi_f(g2.y));
            *(u32x2*)(MX + (size_t)(MP + r) * 1024 + c) = w; }
    }
    xcd_barrier(xbar); STAMP();
    if (IN(10)) {
        pg8::Gemm g{(const bf16*)(ws + WS_MIX), (const bf16*)(ws + WS_WOUT), MT, 1024, 1024}; pg8::SlicedOrder S; S.init(MP, MT, 1024, 1024, 256, gridDim.x, blockIdx.x);
        pg8::EpiResX E{p.in[0], p.in[1], (bf16*)(ws + WS_PRE1), (float*)(ws + WS_Z)};
        pg8::gemm_phase<pg8::EpiResX, pg8::SlicedOrder, true, true>(lds, g, S, E);
    }
    xcd_barrier(xbar); STAMP();
    if (IN(11)) phase_ln<true>((const bf16*)(ws + WS_PRE1), (void*)(ws + WS_H1), p.in[18], p.in[19], wave, lane, (const float*)(ws + WS_Z), 4, p.in[1], nullptr);
    xcd_barrier(xbar); STAMP();
    if (IN(12)) {
        pg8::Gemm g{(const bf16*)(ws + WS_H1), (const bf16*)(ws + WS_WUP), MT, 4096, 1024}; pg8::StaticOrder S; S.init(MT, 4096, gridDim.x, blockIdx.x);
        pg8::EpiSqRelu E{(bf16*)(ws + WS_HID)};
        pg8::gemm_phase<pg8::EpiSqRelu, pg8::StaticOrder, true, true>(lds, g, S, E);
    }
    xcd_barrier(xbar); STAMP();
    if (IN(13)) {
        pg8::Gemm g{(const bf16*)(ws + WS_HID), (const bf16*)(ws + WS_WDN), MT, 1024, 4096}; pg8::SlicedOrder S; S.init(MP, MT, 1024, 4096, 256, gridDim.x, blockIdx.x);
        pg8::EpiResH E{(const bf16*)(ws + WS_H1), (bf16*)(ws + WS_Q), (float*)(ws + WS_Z)};
        pg8::gemm_phase<pg8::EpiResH, pg8::SlicedOrder, true, true>(lds, g, S, E);
    }
    xcd_barrier(xbar); STAMP();
    if (IN(14)) phase_ln<false>((const bf16*)(ws + WS_Q), (void*)p.out, p.in[22], p.in[23], wave, lane, (const float*)(ws + WS_Z), 16, nullptr, (const bf16*)(ws + WS_H1));
    STAMP();
#ifdef IXT
    if (blockIdx.x == 0 && tid == 0) { const unsigned long long d = *(LAS unsigned long long*)(lds + LDS_BYTES - 8), t0 = __builtin_amdgcn_s_memrealtime();
        while (__builtin_amdgcn_s_memrealtime() - t0 < d) __builtin_amdgcn_s_sleep(8); }
#endif
#ifdef PROBE_A
    if (blockIdx.x == 0 && tid == 0) { const unsigned long long d = (tsl[PROBE_B] - tsl[PROBE_A]) * PROBE_MULT, t0 = __builtin_amdgcn_s_memrealtime();
        while (__builtin_amdgcn_s_memrealtime() - t0 < d) __builtin_amdgcn_s_sleep(8); }
#endif
#undef IN
}

extern "C" void kernel_launch(void* const* d_in, const int* in_sizes, int n_in, void* d_out, int out_size, void* d_ws, size_t ws_size, hipStream_t stream) {
    static int grid = 0;
    if (grid == 0) {
        int dev = 0, cus = 0, per_cu = 0;
        if (n_in != 24 || out_size != OUT_TOTAL || ws_size < WS_END) { fprintf(stderr, "kernel_launch: unexpected shapes (n_in %d out %d ws %zu, need %zu)\n", n_in, out_size, ws_size, (size_t)WS_END); grid = -1; return; }
        (void)hipGetDevice(&dev);
        (void)hipDeviceGetAttribute(&cus, hipDeviceAttributeMultiprocessorCount, dev);
        (void)hipFuncSetAttribute((const void*)hybrid_fwd, hipFuncAttributeMaxDynamicSharedMemorySize, LDS_BYTES);
        (void)hipOccupancyMaxActiveBlocksPerMultiprocessor(&per_cu, (const void*)hybrid_fwd, 512, LDS_BYTES);
        if (per_cu < 1) { fprintf(stderr, "kernel_launch: occupancy query says %d blocks per CU\n", per_cu); grid = -1; return; }
        grid = cus;
    }
    if (grid < 0) return;
    (void)hipMemsetAsync(d_ws, 0, 65536, stream);
    Params p{};
    for (int i = 0; i < 24; ++i) p.in[i] = (const float*)d_in[i];
    p.out = (float*)d_out; p.ws = (unsigned char*)d_ws; p.ph_lo = 0; p.ph_hi = 100;
    void* args[] = {&p};
    hipError_t e = hipLaunchCooperativeKernel((const void*)hybrid_fwd, dim3(grid), dim3(512), args, LDS_BYTES, stream);
    if (e != hipSuccess) fprintf(stderr, "cooperative launch failed: %s (grid %d)\n", hipGetErrorString(e), grid);
}
```

```cpp
#include <hip/hip_runtime.h>
#include <hip/hip_cooperative_groups.h>
#include <cstdint>
#include <cstdio>
#include <cmath>
namespace cg = cooperative_groups;

constexpr int MP = 32768, MS = 1024, MT = MP + MS;
constexpr int DM = 1024, NIN = 9472;
constexpr int SEQP = 16384, PAST = 4096, SKEYS = 4128;
constexpr int NQC = 544;
constexpr int KROWS = MP + 32 * SKEYS;
constexpr float ALPHA = 1.189207115002721f;
constexpr float LN_EPS = 1e-5f, RMS_EPS = 1e-5f;

constexpr int OUT_YP = 0, OUT_YS = 33554432, OUT_KP = 34603008, OUT_VP = 42991616, OUT_KIP = 51380224, OUT_SSMP = 53477376,
              OUT_CONVP = 54001664, OUT_KS = 54020096, OUT_VS = 54282240, OUT_KIS = 54544384, OUT_SSMS = 54609920, OUT_CONVS = 62998528,
              OUT_TOTAL = 63293440;

constexpr size_t WS_CTL = 0;
constexpr size_t WS_WIN = 1048576;
constexpr size_t WS_WSSD = WS_WIN + (size_t)NIN * 1024 * 2;
constexpr size_t WS_WATT = WS_WSSD + 4194304;
constexpr size_t WS_WOUT = WS_WATT + 2097152;
constexpr size_t WS_WUP = WS_WOUT + 2097152;
constexpr size_t WS_WDN = WS_WUP + 8388608;
constexpr size_t WS_Q = WS_WDN + 8388608;
constexpr size_t WS_Z = WS_Q + (size_t)MT * 2048;
constexpr size_t WS_DT = WS_Z + (size_t)MT * 4096;
constexpr size_t WS_WI = WS_DT + (size_t)MT * 128;
constexpr size_t WS_R46 = WS_WI + (size_t)MT * 32;
constexpr size_t SZ_R46 = 258998272;
constexpr size_t WS_R57 = WS_R46 + SZ_R46;
constexpr size_t SZ_R57 = 285212672;
constexpr size_t WS_END = WS_R57 + SZ_R57;
constexpr size_t WS_KALL = WS_R46;
constexpr size_t WS_VALL = WS_KALL + (size_t)KROWS * 256;
constexpr size_t WS_KIALL = WS_VALL + (size_t)KROWS * 256;
constexpr size_t WS_QI = WS_KIALL + (size_t)KROWS * 128;
constexpr size_t WS_SEL = WS_QI + (size_t)MT * 1024;
static_assert(WS_SEL + (size_t)MT * 512 <= WS_R46 + SZ_R46, "region A life 1");
constexpr size_t WS_XT = WS_R46;
constexpr size_t WS_BN = WS_XT + (size_t)NQC * 64 * 2048 * 2;
constexpr size_t WS_BT = WS_BN + (size_t)NQC * 64 * 512 * 2;
constexpr size_t WS_CN = WS_BT + (size_t)NQC * 64 * 512 * 2;
constexpr size_t WS_ACUM = WS_CN + (size_t)NQC * 64 * 512 * 2;
constexpr size_t WS_DTS = WS_ACUM + (size_t)NQC * 32 * 64 * 4;
static_assert(WS_DTS + (size_t)NQC * 32 * 64 * 4 <= WS_R46 + SZ_R46, "region A life 2");
constexpr size_t WS_T = WS_R46;
constexpr size_t WS_MIX = WS_T + (size_t)MT * 4096;
constexpr size_t WS_H1 = WS_R46;
static_assert(WS_MIX + (size_t)MT * 2048 <= WS_R46 + SZ_R46, "region A life 3");
constexpr size_t WS_XB = WS_R57;
constexpr size_t WS_XBC = WS_XB + (size_t)MT * 2048;
static_assert(WS_XBC + (size_t)MT * 6144 <= WS_R57 + SZ_R57, "region B life 1");
constexpr size_t WS_STATES = WS_R57;
static_assert((size_t)NQC * 32 * 64 * 128 * 2 <= SZ_R57, "region B life 2");
constexpr size_t WS_PRE1 = WS_R57;
constexpr size_t WS_HID = WS_R57;
static_assert((size_t)MT * 8192 <= SZ_R57, "region B life 3");
constexpr int CW_QUEUE = 64, CW_ATT = 1024, CW_BAR = 4096;

constexpr int LDS_BYTES = 159744;
#define LAS __attribute__((address_space(3)))

typedef unsigned short bf16;
typedef unsigned u32x4 __attribute__((ext_vector_type(4)));
typedef unsigned u32x2 __attribute__((ext_vector_type(2)));
typedef float f32x16 __attribute__((ext_vector_type(16)));
typedef float f32x2v __attribute__((ext_vector_type(2)));
typedef __bf16 bf16x2_t __attribute__((ext_vector_type(2)));

__device__ __forceinline__ float bf2f(unsigned h) { return __uint_as_float(h << 16); }
__device__ __forceinline__ unsigned pk2(float lo, float hi) { f32x2v v = {lo, hi}; bf16x2_t b = __builtin_convertvector(v, bf16x2_t); return __builtin_bit_cast(unsigned, b); }
__device__ __forceinline__ unsigned short f2bf(float f) { return (unsigned short)(pk2(f, 0.f) & 0xffffu); }
__device__ __forceinline__ float lo_f(unsigned w) { return __uint_as_float(w << 16); }
__device__ __forceinline__ float hi_f(unsigned w) { return __uint_as_float(w & 0xffff0000u); }
__device__ __forceinline__ unsigned pk4_fp8(float a, float b, float c, float d) { int w = 0; w = __builtin_amdgcn_cvt_pk_fp8_f32(a, b, w, false); w = __builtin_amdgcn_cvt_pk_fp8_f32(c, d, w, true); return (unsigned)w; }
__device__ __forceinline__ float sigmoidf_(float x) { return 1.0f / (1.0f + __expf(-x)); }
__device__ __forceinline__ float siluf_(float x) { return x / (1.0f + __expf(-x)); }
__device__ __forceinline__ float softplusf_(float x) { return x > 20.f ? x : log1pf(__expf(x)); }
namespace pg8 {
#define PG8_LAS __attribute__((address_space(3)))
typedef unsigned short bf16_t;
typedef short bf16x8 __attribute__((ext_vector_type(8)));
typedef float f32x4 __attribute__((ext_vector_type(4)));
typedef unsigned u32x4 __attribute__((ext_vector_type(4)));
constexpr int BM = 256, BK = 64, HALF = 128, HTB = HALF * BK * 2  , STAGE_BYTES = 8 * HTB, NXCD = 8, WGM = 8;

__host__ __device__ __forceinline__ int lds_byte(int r, int c) { const int st = (r >> 4) * 2 + (c >> 5), rr = r & 15, cc = c & 31, ob = rr * 64 + cc * 2; return st * 1024 + (ob ^ (((ob >> 9) & 1) << 5)); }
__host__ __device__ __forceinline__ void stage_rc(int b, int& R, int& C) { const int st = b / 1024, sb = b % 1024, swz = sb ^ (((sb >> 9) & 1) << 5); R = (st >> 1) * 16 + swz / 64; C = (st & 1) * 32 + (swz % 64) / 2; }
__host__ __device__ __forceinline__ int perm32(int rho) { const int n = rho >> 4, i = rho & 15; return 8 * (i >> 2) + 4 * n + (i & 3); }

struct Unit { int pm, pn, kofs, nt; };
struct Gemm { const bf16_t* A; const bf16_t* Bt; int M, N, K; };

struct StaticOrder {
    int nM, nN, nwg, G, c;
    __host__ __device__ void init(int M, int N, int G_, int c_) { nM = M / BM; nN = N / BM; nwg = nM * nN; G = G_; c = c_; }
    __host__ __device__ bool next(int i, Unit& u) const {
        const long L = (long)i * G + c; if (L >= nwg) return false;
        int wgid = (int)L; { const int q = nwg / NXCD, r = nwg % NXCD, xcd = wgid % NXCD, off = wgid / NXCD; wgid = (xcd < r ? xcd * (q + 1) : r * (q + 1) + (xcd - r) * q) + off; }
        const int nig = WGM * nN, gid = wgid / nig, fm = gid * WGM, gsz = (nM - fm) < WGM ? (nM - fm) : WGM;
        u.pm = fm + ((wgid % nig) % gsz); u.pn = (wgid % nig) / gsz; u.kofs = 0; u.nt = 0; return true;
    }
    __device__ __forceinline__ void a_ready(const Unit&) const {}
    __device__ __forceinline__ void done(const Unit&) const {}
};
struct SlicedOrder {
    StaticOrder so; int npt, pm0, nN, nsl, slnt, ntot;
    __host__ __device__ void init(int Mp, int Mall, int N, int K, int SLK, int G_, int c_) { so.init(Mp, N, G_, c_); npt = so.nwg; pm0 = Mp / BM; nN = N / BM; nsl = K / SLK; slnt = SLK / BK; ntot = npt + ((Mall - Mp) / BM) * nN * nsl; }
    __host__ __device__ bool next(int i, Unit& u) const {
        const long L = (long)i * so.G + so.c; if (L >= ntot) return false;
        if (L < npt) return so.next(i, u);
        const int s = (int)L - npt, tile = s / nsl, sl = s - tile * nsl; u.pm = pm0 + tile / nN; u.pn = tile % nN; u.kofs = sl * slnt * BK; u.nt = slnt; return true;
    }
    __device__ __forceinline__ void a_ready(const Unit&) const {}
    __device__ __forceinline__ void done(const Unit&) const {}
};

__device__ __forceinline__ unsigned cvt_pk_bf16(float lo, float hi) { unsigned r; asm volatile("v_cvt_pk_bf16_f32 %0, %1, %2" : "=v"(r) : "v"(lo), "v"(hi)); return r; }
__device__ __forceinline__ u32x4 pack8(const f32x4 a, const f32x4 b) { u32x4 w; w.x = ::pk2(a[0], a[1]); w.y = ::pk2(a[2], a[3]); w.z = ::pk2(b[0], b[1]); w.w = ::pk2(b[2], b[3]); return w; }
#define EPI_LOOP8(...) _Pragma("unroll") for (int ai = 0; ai < 2; ++ai) _Pragma("unroll") for (int m = 0; m < 4; ++m) _Pragma("unroll") for (int bj = 0; bj < 2; ++bj) { \
    const int r = row0 + ai * HALF + m * 16, cl = cl0 + bj * HALF; const f32x4 a = acc[ai][bj][m][0], b = acc[ai][bj][m][1]; __VA_ARGS__ }
#define EPI_LOOP4(...) _Pragma("unroll") for (int ai = 0; ai < 2; ++ai) _Pragma("unroll") for (int m = 0; m < 4; ++m) _Pragma("unroll") for (int bj = 0; bj < 2; ++bj) _Pragma("unroll") for (int n = 0; n < 2; ++n) { \
    const int r = row0 + ai * HALF + m * 16, c = col0 + bj * HALF + n * 16; const f32x4 a = acc[ai][bj][m][n]; __VA_ARGS__ }

#define EPI_HALF8(ai, ...) _Pragma("unroll") for (int m = 0; m < 4; ++m) _Pragma("unroll") for (int bj = 0; bj < 2; ++bj) { \
    const int ix = m * 2 + bj, r = row0 + (ai) * HALF + m * 16, cl = cl0 + bj * HALF; const f32x4 a = acc[ai][bj][m][0], b = acc[ai][bj][m][1]; (void)ix; (void)a; (void)b; __VA_ARGS__ }
#define EPI_HALF4(ai, ...) _Pragma("unroll") for (int m = 0; m < 4; ++m) _Pragma("unroll") for (int bj = 0; bj < 2; ++bj) _Pragma("unroll") for (int n = 0; n < 2; ++n) { \
    const int ix = (m * 2 + bj) * 2 + n, r = row0 + (ai) * HALF + m * 16, c = col0 + bj * HALF + n * 16; const f32x4 a = acc[ai][bj][m][n]; (void)ix; (void)a; __VA_ARGS__ }

struct EpiInProj {
    static constexpr bool PERM = true, AFTER_DRAIN = false;
    bf16_t *Z, *XBC, *Q; unsigned char *KALL, *VALL; bf16_t *QI, *G, *KIALL; float *DT, *WI, *out; const float* dt_bias;
    __device__ __forceinline__ void operator()(const f32x4 (&acc)[2][2][4][2], const Unit& u, int wr, int wc, int fr, int fq) const {
        const int pn = u.pn, row0 = u.pm * BM + wr * 64 + fr, cl0 = wc * 32 + 8 * fq;
        if (pn < 8) { EPI_LOOP8( *(u32x4*)(Z + (size_t)r * 2048 + pn * 256 + cl) = pack8(a, b); ) }
        else if (pn < 20) { EPI_LOOP8( const int c = (pn - 8) * 256 + cl; *(u32x4*)(XBC + (size_t)r * 3072 + c) = pack8(a, b);
            int slot = -1;
            if (r < MP) { const int t = r & 16383; if (t >= 16381) slot = OUT_CONVP + ((r >> 14) * 3 + (t - 16381)) * 3072; }
            else { const int rs = r - MP, t = rs & 31; if (t >= 29) slot = OUT_CONVS + ((rs >> 5) * 3 + (t - 29)) * 3072; }
            if (slot >= 0) { *(f32x4*)(out + slot + c) = a; *(f32x4*)(out + slot + c + 4) = b; } ) }
        else if (pn < 24) { EPI_LOOP8( *(u32x4*)(Q + (size_t)r * 1024 + (pn - 20) * 256 + cl) = pack8(a, b); ) }
        else if (pn < 26) { unsigned char* KV = (pn == 24) ? KALL : VALL; const int op = (pn == 24) ? OUT_KP : OUT_VP, os = (pn == 24) ? OUT_KS : OUT_VS;
            EPI_LOOP8( int kr, o; if (r < MP) { kr = r; o = op + r * 256; } else { const int rs = r - MP; kr = MP + (rs >> 5) * SKEYS + PAST + (rs & 31); o = os + rs * 256; }
                { ::u32x2 w8; w8.x = ::pk4_fp8(a[0], a[1], a[2], a[3]); w8.y = ::pk4_fp8(b[0], b[1], b[2], b[3]); *(::u32x2*)(KV + (size_t)kr * 256 + cl) = w8; } *(f32x4*)(out + o + cl) = a; *(f32x4*)(out + o + cl + 4) = b; ) }
        else if (pn < 28) { EPI_LOOP8( *(u32x4*)(QI + (size_t)r * 512 + (pn - 26) * 256 + cl) = pack8(a, b); ) }
        else if (pn < 36) { EPI_LOOP8( f32x4 sa, sb;
            _Pragma("unroll") for (int e = 0; e < 4; ++e) { sa[e] = ::sigmoidf_(a[e]); sb[e] = ::sigmoidf_(b[e]); }
            *(u32x4*)(G + (size_t)r * 2048 + (pn - 28) * 256 + cl) = pack8(sa, sb); ) }
        else { EPI_LOOP8(
            if (cl < 32) { f32x4 sa, sb; const f32x4 ba = *(const f32x4*)(dt_bias + cl), bb = *(const f32x4*)(dt_bias + cl + 4);
                _Pragma("unroll") for (int e = 0; e < 4; ++e) { sa[e] = ::softplusf_(a[e] + ba[e]); sb[e] = ::softplusf_(b[e] + bb[e]); }
                *(f32x4*)(DT + (size_t)r * 32 + cl) = sa; *(f32x4*)(DT + (size_t)r * 32 + cl + 4) = sb; }
            else if (cl < 96) { int kr, o; if (r < MP) { kr = r; o = OUT_KIP + r * 64; } else { const int rs = r - MP; kr = MP + (rs >> 5) * SKEYS + PAST + (rs & 31); o = OUT_KIS + rs * 64; }
                *(u32x4*)(KIALL + (size_t)kr * 64 + (cl - 32)) = pack8(a, b); *(f32x4*)(out + o + (cl - 32)) = a; *(f32x4*)(out + o + (cl - 32) + 4) = b; }
            else if (cl < 104) { const float s = 0.04419417382415922f;
                *(f32x4*)(WI + (size_t)r * 8) = a * s; *(f32x4*)(WI + (size_t)r * 8 + 4) = b * s; } ) }
    }
};
struct EpiMixA {
    static constexpr bool PERM = true, AFTER_DRAIN = false;
    const bf16_t* G; bf16_t* T; float* SLAB;
    __device__ __forceinline__ void operator()(const f32x4 (&acc)[2][2][4][2], const Unit& u, int wr, int wc, int fr, int fq) const {
        const int row0 = u.pm * BM + wr * 64 + fr, cl0 = u.pn * BM + wc * 32 + 8 * fq;
        if (u.nt != 0) { float* sl = SLAB + (size_t)(u.kofs / (u.nt * BK)) * MS * 1024; EPI_LOOP8( float* t = sl + (size_t)(r - MP) * 1024 + cl; *(f32x4*)t = a; *(f32x4*)(t + 4) = b; ) return; }
        _Pragma("unroll") for (int ai = 0; ai < 2; ++ai) { u32x4 gq[8];
          EPI_HALF8(ai, gq[ix] = *(const u32x4*)(G + (size_t)r * 2048 + cl); )
          EPI_HALF8(ai, const u32x4 g = gq[ix];
            f32x4 o0, o1; o0[0] = a[0] * ::lo_f(g.x); o0[1] = a[1] * ::hi_f(g.x); o0[2] = a[2] * ::lo_f(g.y); o0[3] = a[3] * ::hi_f(g.y);
            o1[0] = b[0] * ::lo_f(g.z); o1[1] = b[1] * ::hi_f(g.z); o1[2] = b[2] * ::lo_f(g.w); o1[3] = b[3] * ::hi_f(g.w);
            *(u32x4*)(T + (size_t)r * 1024 + cl) = pack8(o0, o1); ) }
    }
};
struct EpiMixB {
    static constexpr bool PERM = true, AFTER_DRAIN = false;
    const bf16_t* G; const bf16_t* T; bf16_t* MIX; float* SLAB;
    __device__ __forceinline__ void operator()(const f32x4 (&acc)[2][2][4][2], const Unit& u, int wr, int wc, int fr, int fq) const {
        const int row0 = u.pm * BM + wr * 64 + fr, cl0 = u.pn * BM + wc * 32 + 8 * fq;
        if (u.nt != 0) { float* sl = SLAB + (size_t)(u.kofs / (u.nt * BK)) * MS * 1024; EPI_LOOP8( float* t = sl + (size_t)(r - MP) * 1024 + cl; *(f32x4*)t = a; *(f32x4*)(t + 4) = b; ) return; }
        _Pragma("unroll") for (int ai = 0; ai < 2; ++ai) { u32x4 gq[8], tq[8];
          EPI_HALF8(ai, gq[ix] = *(const u32x4*)(G + (size_t)r * 2048 + 1024 + cl); tq[ix] = *(const u32x4*)(T + (size_t)r * 1024 + cl); )
          EPI_HALF8(ai, const u32x4 g = gq[ix], t = tq[ix];
            f32x4 o0, o1; o0[0] = ::lo_f(t.x) + a[0] * ::lo_f(g.x); o0[1] = ::hi_f(t.x) + a[1] * ::hi_f(g.x); o0[2] = ::lo_f(t.y) + a[2] * ::lo_f(g.y); o0[3] = ::hi_f(t.y) + a[3] * ::hi_f(g.y);
            o1[0] = ::lo_f(t.z) + b[0] * ::lo_f(g.z); o1[1] = ::hi_f(t.z) + b[1] * ::hi_f(g.z); o1[2] = ::lo_f(t.w) + b[2] * ::lo_f(g.w); o1[3] = ::hi_f(t.w) + b[3] * ::hi_f(g.w);
            *(u32x4*)(MIX + (size_t)r * 1024 + cl) = pack8(o0, o1); ) }
    }
};
struct EpiResX {
    static constexpr bool PERM = false, AFTER_DRAIN = false;
    const float *xp, *xs; bf16_t* PRE; float* SLAB;
    __device__ __forceinline__ void operator()(const f32x4 (&acc)[2][2][4][2], const Unit& u, int wr, int wc, int fr, int fq) const {
        const int row0 = u.pm * BM + wr * 64 + fr, col0 = u.pn * BM + wc * 32 + 4 * fq;
        if (u.nt != 0) { float* sl = SLAB + (size_t)(u.kofs / (u.nt * BK)) * MS * 1024; EPI_LOOP4( *(f32x4*)(sl + (size_t)(r - MP) * 1024 + c) = a; ) return; }
        _Pragma("unroll") for (int ai = 0; ai < 2; ++ai) { f32x4 xq[16];
          EPI_HALF4(ai, const float* xr = (r < MP) ? xp + (size_t)r * 1024 : xs + (size_t)(r - MP) * 1024; xq[ix] = *(const f32x4*)(xr + c); )
          EPI_HALF4(ai, const f32x4 o = xq[ix] * ALPHA + a; ::u32x2 w; w.x = ::pk2(o[0], o[1]); w.y = ::pk2(o[2], o[3]); *(::u32x2*)(PRE + (size_t)r * 1024 + c) = w; ) }
    }
};
struct EpiSqRelu {
    static constexpr bool PERM = true, AFTER_DRAIN = false;
    bf16_t* H;
    __device__ __forceinline__ void operator()(const f32x4 (&acc)[2][2][4][2], const Unit& u, int wr, int wc, int fr, int fq) const {
        const int row0 = u.pm * BM + wr * 64 + fr, cl0 = u.pn * BM + wc * 32 + 8 * fq;
        EPI_LOOP8( f32x4 sa, sb;
            _Pragma("unroll") for (int e = 0; e < 4; ++e) { const float x0 = fmaxf(a[e], 0.f), x1 = fmaxf(b[e], 0.f); sa[e] = x0 * x0; sb[e] = x1 * x1; }
            *(u32x4*)(H + (size_t)r * 4096 + cl) = pack8(sa, sb); )
    }
};
struct EpiResH {
    static constexpr bool PERM = false, AFTER_DRAIN = false;
    const bf16_t* H1; bf16_t* PRE; float* SLAB;
    __device__ __forceinline__ void operator()(const f32x4 (&acc)[2][2][4][2], const Unit& u, int wr, int wc, int fr, int fq) const {
        const int row0 = u.pm * BM + wr * 64 + fr, col0 = u.pn * BM + wc * 32 + 4 * fq;
        if (u.nt != 0) { float* sl = SLAB + (size_t)(u.kofs / (u.nt * BK)) * MS * 1024; EPI_LOOP4( *(f32x4*)(sl + (size_t)(r - MP) * 1024 + c) = a; ) return; }
        _Pragma("unroll") for (int ai = 0; ai < 2; ++ai) { ::u32x2 hq[16];
          EPI_HALF4(ai, hq[ix] = *(const ::u32x2*)(H1 + (size_t)r * 1024 + c); )
          EPI_HALF4(ai, const ::u32x2 hv = hq[ix];
            f32x4 o; o[0] = ::lo_f(hv.x) * ALPHA + a[0]; o[1] = ::hi_f(hv.x) * ALPHA + a[1]; o[2] = ::lo_f(hv.y) * ALPHA + a[2]; o[3] = ::hi_f(hv.y) * ALPHA + a[3];
            ::u32x2 w; w.x = ::pk2(o[0], o[1]); w.y = ::pk2(o[2], o[3]); *(::u32x2*)(PRE + (size_t)r * 1024 + c) = w; ) }
    }
};
template <class Epi, class Sched, bool ALIGN_EPI = false, bool SP2 = false>
__device__ __forceinline__ void gemm_phase(PG8_LAS unsigned char* lds, const Gemm g, const Sched& S, const Epi& E) {
    const int tid = threadIdx.x, wid = __builtin_amdgcn_readfirstlane(tid >> 6), lane = tid & 63, wr = wid >> 2, wc = wid & 3, fr = lane & 15, fq = lane >> 4;
    const int K = g.K, nt = K / BK;
    unsigned voffA[2], voffB[2];
#pragma unroll
    for (int i = 0; i < 2; ++i) { int R, C; stage_rc(tid * 16 + i * 8192, R, C); const int Rb = Epi::PERM ? ((R & ~31) + perm32(R & 31)) : R;
        voffA[i] = (unsigned)(R * K + C) * 2u; voffB[i] = (unsigned)(Rb * K + C) * 2u; }
    const size_t kstep = (size_t)(BK * 2);
    const size_t hstep = (size_t)HALF * K * 2;
    const size_t tstep = 2 * hstep;
    const unsigned ldsw = (unsigned)wid * 1024u;
    const int aoff = lds_byte(wr * 64 + fr, fq * 8), boff = lds_byte(wc * 32 + fr, fq * 8);
#define PG8_SA(b, h) (((b) * 2 + (h)) * HTB)
#define PG8_SB(b, h) ((4 + (b) * 2 + (h)) * HTB)
#define PG8_STAGE(bufoff, gbase, voff) do { _Pragma("unroll") for (int _i = 0; _i < 2; ++_i) \
        __builtin_amdgcn_global_load_lds((const unsigned*)((const char*)(gbase) + (voff)[_i]), (PG8_LAS unsigned*)(lds + (bufoff) + ldsw + _i * 8192), 16, 0, 0); } while (0)
#define PG8_LDA(dst, b, h) do { _Pragma("unroll") for (int m = 0; m < 4; ++m) _Pragma("unroll") for (int k = 0; k < 2; ++k) dst[m][k] = *(const PG8_LAS bf16x8*)(lds + PG8_SA(b, h) + aoff + m * 2048 + k * 1024); } while (0)
#define PG8_LDB(dst, b, h) do { _Pragma("unroll") for (int n = 0; n < 2; ++n) _Pragma("unroll") for (int k = 0; k < 2; ++k) dst[n][k] = *(const PG8_LAS bf16x8*)(lds + PG8_SB(b, h) + boff + n * 2048 + k * 1024); } while (0)
#define PG8_MMA(ai, bj, At, Bt) do { __builtin_amdgcn_s_setprio(1); _Pragma("unroll") for (int m = 0; m < 4; ++m) _Pragma("unroll") for (int n = 0; n < 2; ++n) _Pragma("unroll") for (int k = 0; k < 2; ++k) \
        acc[ai][bj][m][n] = __builtin_amdgcn_mfma_f32_16x16x32_bf16(Bt[n][k], At[m][k], acc[ai][bj][m][n], 0, 0, 0); __builtin_amdgcn_s_setprio(0); } while (0)
#define PG8_WAIT_V(n) asm volatile("s_waitcnt vmcnt(" #n ")" ::: "memory")
#define PG8_WAIT_L(n) asm volatile("s_waitcnt lgkmcnt(" #n ")" ::: "memory")
#define PG8_BAR __builtin_amdgcn_s_barrier()
#define PG8_SCHED __builtin_amdgcn_sched_barrier(0)
    Unit cur, nxt; int ui = 0;
    if (!S.next(0, cur)) return;
    f32x4 acc[2][2][4][2];
#pragma unroll
    for (int a = 0; a < 2; ++a)
#pragma unroll
        for (int b = 0; b < 2; ++b)
#pragma unroll
            for (int m = 0; m < 4; ++m)
#pragma unroll
                for (int n = 0; n < 2; ++n) acc[a][b][m][n] = (f32x4){0.f, 0.f, 0.f, 0.f};
    bf16x8 At[4][2], B0[2][2], B1[2][2];
    const char* cA = (const char*)g.A + (size_t)cur.pm * tstep + (size_t)cur.kofs * 2; const char* cB = (const char*)g.Bt + (size_t)cur.pn * tstep + (size_t)cur.kofs * 2;
    S.a_ready(cur);
    if constexpr (SP2) {
        PG8_STAGE(PG8_SB(0, 0), cB, voffB); PG8_STAGE(PG8_SB(0, 1), cB + hstep, voffB); PG8_STAGE(PG8_SA(0, 0), cA, voffA); PG8_STAGE(PG8_SA(0, 1), cA + hstep, voffA);
        if (wr == 1) PG8_BAR;
        PG8_WAIT_V(2); PG8_BAR;
        PG8_STAGE(PG8_SB(1, 0), cB + kstep, voffB); PG8_STAGE(PG8_SA(1, 0), cA + kstep, voffA); PG8_STAGE(PG8_SB(1, 1), cB + hstep + kstep, voffB);
        PG8_WAIT_V(6); PG8_BAR;
    } else {
        PG8_STAGE(PG8_SB(0, 0), cB, voffB); PG8_STAGE(PG8_SA(0, 0), cA, voffA); PG8_STAGE(PG8_SB(0, 1), cB + hstep, voffB); PG8_STAGE(PG8_SA(0, 1), cA + hstep, voffA);
        if (wr == 1) PG8_BAR;
        PG8_WAIT_V(4); PG8_BAR;
        PG8_STAGE(PG8_SB(1, 0), cB + kstep, voffB); PG8_STAGE(PG8_SA(1, 0), cA + kstep, voffA); PG8_STAGE(PG8_SB(1, 1), cB + hstep + kstep, voffB);
        PG8_WAIT_V(6); PG8_BAR;
    }
    for (;;) {
        const bool has_next = S.next(ui + 1, nxt);
        const char* nA = has_next ? (const char*)g.A + (size_t)nxt.pm * tstep + (size_t)nxt.kofs * 2 : cA; const char* nB = has_next ? (const char*)g.Bt + (size_t)nxt.pn * tstep + (size_t)nxt.kofs * 2 : cB;
        const int unt = cur.nt ? cur.nt : nt;
        for (int t = 0; t < unt; t += 2) {
            const bool last = (t == unt - 2);
            const char* a1 = cA + (size_t)(t + 1) * kstep;
            const char* a2 = last ? nA : cA + (size_t)(t + 2) * kstep; const char* b2 = last ? nB : cB + (size_t)(t + 2) * kstep;
            const char* a3 = a2 + kstep; const char* b3 = b2 + kstep;
            if (last && has_next) S.a_ready(nxt);
            if constexpr (SP2) {
            PG8_LDB(B0, 0, 0); PG8_LDB(B1, 0, 1); PG8_SCHED; PG8_LDA(At, 0, 0); PG8_STAGE(PG8_SA(1, 1), a1 + hstep, voffA);
            PG8_WAIT_V(8); PG8_WAIT_L(0); PG8_BAR; PG8_MMA(0, 0, At, B0); PG8_MMA(0, 1, At, B1); PG8_BAR; PG8_SCHED;
            PG8_LDA(At, 0, 1); PG8_STAGE(PG8_SB(0, 0), b2, voffB); PG8_STAGE(PG8_SB(0, 1), b2 + hstep, voffB); PG8_STAGE(PG8_SA(0, 0), a2, voffA);
            PG8_WAIT_V(8); PG8_WAIT_L(0); PG8_BAR; PG8_MMA(1, 0, At, B0); PG8_MMA(1, 1, At, B1); PG8_BAR; PG8_SCHED;
            PG8_LDB(B0, 1, 0); PG8_LDB(B1, 1, 1); PG8_SCHED; PG8_LDA(At, 1, 0); PG8_STAGE(PG8_SA(0, 1), a2 + hstep, voffA);
            PG8_WAIT_V(8); PG8_WAIT_L(0); PG8_BAR; PG8_MMA(0, 0, At, B0); PG8_MMA(0, 1, At, B1); PG8_BAR; PG8_SCHED;
            PG8_LDA(At, 1, 1); PG8_STAGE(PG8_SB(1, 0), b3, voffB); PG8_STAGE(PG8_SB(1, 1), b3 + hstep, voffB); PG8_STAGE(PG8_SA(1, 0), a3, voffA);
            PG8_WAIT_V(8); PG8_WAIT_L(0); PG8_BAR; PG8_MMA(1, 0, At, B0); PG8_MMA(1, 1, At, B1); PG8_BAR; PG8_SCHED;
            } else {
            PG8_LDB(B0, 0, 0); PG8_SCHED; PG8_LDA(At, 0, 0); PG8_STAGE(PG8_SA(1, 1), a1 + hstep, voffA);
            PG8_WAIT_L(8); PG8_BAR; PG8_WAIT_L(0); PG8_MMA(0, 0, At, B0); PG8_BAR; PG8_SCHED;
            PG8_LDB(B1, 0, 1); PG8_STAGE(PG8_SB(0, 0), b2, voffB);
            PG8_BAR; PG8_WAIT_L(0); PG8_MMA(0, 1, At, B1); PG8_BAR;
            PG8_LDA(At, 0, 1); PG8_STAGE(PG8_SA(0, 0), a2, voffA);
            PG8_BAR; PG8_WAIT_L(0); PG8_MMA(1, 0, At, B0); PG8_BAR; PG8_SCHED;
            PG8_STAGE(PG8_SB(0, 1), b2 + hstep, voffB);
            PG8_WAIT_V(6); PG8_BAR; PG8_MMA(1, 1, At, B1); PG8_BAR;
            PG8_LDB(B0, 1, 0); PG8_SCHED; PG8_LDA(At, 1, 0); PG8_STAGE(PG8_SA(0, 1), a2 + hstep, voffA);
            PG8_WAIT_L(8); PG8_BAR; PG8_WAIT_L(0); PG8_MMA(0, 0, At, B0); PG8_BAR; PG8_SCHED;
            PG8_LDB(B1, 1, 1); PG8_STAGE(PG8_SB(1, 0), b3, voffB);
            PG8_BAR; PG8_WAIT_L(0); PG8_MMA(0, 1, At, B1); PG8_BAR;
            PG8_LDA(At, 1, 1); PG8_STAGE(PG8_SA(1, 0), a3, voffA);
            PG8_BAR; PG8_WAIT_L(0); PG8_MMA(1, 0, At, B0); PG8_BAR; PG8_SCHED;
            PG8_STAGE(PG8_SB(1, 1), b3 + hstep, voffB);
            PG8_WAIT_V(6); PG8_BAR; PG8_MMA(1, 1, At, B1); PG8_BAR;
            }
        }
        if constexpr (ALIGN_EPI) { if (wr == 0) PG8_BAR; }
        if constexpr (!Epi::AFTER_DRAIN) { E(acc, cur, wr, wc, fr, fq); S.done(cur); }
        if (!has_next) break;
#pragma unroll
        for (int a = 0; a < 2; ++a)
#pragma unroll
            for (int b = 0; b < 2; ++b)
#pragma unroll
                for (int m = 0; m < 4; ++m)
#pragma unroll
                    for (int n = 0; n < 2; ++n) acc[a][b][m][n] = (f32x4){0.f, 0.f, 0.f, 0.f};
        cur = nxt; cA = nA; cB = nB; ++ui;
        if constexpr (ALIGN_EPI) { if (wr == 1) PG8_BAR; }
    }
    PG8_WAIT_V(0);
    if constexpr (!ALIGN_EPI) { if (wr == 0) PG8_BAR; }
    PG8_BAR;
    if constexpr (Epi::AFTER_DRAIN) { E.fused(acc, cur, wr, wc, fr, fq, lds, wid, lane); S.done(cur); }
#undef PG8_SA
#undef PG8_SB
#undef PG8_STAGE
#undef PG8_LDA
#undef PG8_LDB
#undef PG8_MMA
#undef PG8_WAIT_V
#undef PG8_WAIT_L
#undef PG8_BAR
#undef PG8_SCHED
}
}
using pg8::bf16x8;
using pg8::f32x4;
#define MFMA32(a, b, c) __builtin_amdgcn_mfma_f32_32x32x16_bf16((a), (b), (c), 0, 0, 0)
#define MFMA16(a, b, c) __builtin_amdgcn_mfma_f32_16x16x32_bf16((a), (b), (c), 0, 0, 0)
#define LDS_WAIT() asm volatile("s_waitcnt lgkmcnt(0)" ::: "memory")

struct Params {
    const float* in[24];
    float* out;
    unsigned char* ws;
    int ph_lo, ph_hi;
};

__device__ __forceinline__ bf16x8 ldg8(const bf16* p) { return *(const bf16x8*)p; }
__device__ __forceinline__ float wave_sum(float v) {
#pragma unroll
    for (int o = 1; o < 64; o <<= 1) v += __shfl_xor(v, o);
    return v;
}

__device__ __forceinline__ int win_src_col(int n) {
    if (n < 5120) return n;
    if (n < 7168) return n + 32;
    if (n < 9216) return n + 104;
    if (n < 9248) return n - 4096;
    if (n < 9320) return n - 2048;
    return -1;
}
template <bool REMAP>
__device__ __forceinline__ void transpose_item(const float* W, int K, int Nsrc, bf16* WT, LAS float* scr, int kb, int nb, int lane) {
    const int k0 = 64 * kb, n0 = 32 * nb;
    int sc = n0 + (lane & 31); if (REMAP) sc = win_src_col(sc);
#pragma unroll 8
    for (int i = 0; i < 32; ++i) { const int kk = 2 * i + (lane >> 5); scr[kk * 33 + (lane & 31)] = (sc >= 0) ? W[(size_t)(k0 + kk) * Nsrc + sc] : 0.f; }
    LDS_WAIT(); asm volatile("" ::: "memory");
    const int c = lane & 7;
#pragma unroll
    for (int j = 0; j < 4; ++j) { const int n = (lane >> 3) + 8 * j; const LAS float* s = scr + (8 * c) * 33 + n;
        u32x4 o; o.x = pk2(s[0 * 33], s[1 * 33]); o.y = pk2(s[2 * 33], s[3 * 33]); o.z = pk2(s[4 * 33], s[5 * 33]); o.w = pk2(s[6 * 33], s[7 * 33]);
        *(u32x4*)(WT + (size_t)(n0 + n) * K + k0 + 8 * c) = o; }
    LDS_WAIT(); asm volatile("" ::: "memory");
}
__device__ __forceinline__ void cvt8(const float* src, bf16* dst) {
    const f32x4 a = *(const f32x4*)src, b = *(const f32x4*)(src + 4);
    u32x4 o; o.x = pk2(a[0], a[1]); o.y = pk2(a[2], a[3]); o.z = pk2(b[0], b[1]); o.w = pk2(b[2], b[3]);
    *(u32x4*)dst = o;
}
__device__ __forceinline__ void phase_prologue(const Params& p, LAS unsigned char* lds, int tid, int wave, int lane) {
    unsigned char* ws = p.ws;
    LAS float* scr = (LAS float*)(lds + wave * 16384);
    const int gw = blockIdx.x * 8 + wave, NGW = gridDim.x * 8;
    constexpr int I_IN = 16 * 296, I_SSD = 32 * 32, I_ATT = 16 * 32, I_OUT = 16 * 32, I_UP = 16 * 128, I_DN = 64 * 32;
    constexpr int NITEMS = I_IN + I_SSD + I_ATT + I_OUT + I_UP + I_DN;
    for (int it = gw; it < NITEMS; it += NGW) {
        int r = it;
        if (r < I_IN) { transpose_item<true>(p.in[8], 1024, 9320, (bf16*)(ws + WS_WIN), scr, r / 296, r % 296, lane); continue; } r -= I_IN;
        if (r < I_SSD) { transpose_item<false>(p.in[15], 2048, 1024, (bf16*)(ws + WS_WSSD), scr, r / 32, r % 32, lane); continue; } r -= I_SSD;
        if (r < I_ATT) { transpose_item<false>(p.in[16], 1024, 1024, (bf16*)(ws + WS_WATT), scr, r / 32, r % 32, lane); continue; } r -= I_ATT;
        if (r < I_OUT) { transpose_item<false>(p.in[17], 1024, 1024, (bf16*)(ws + WS_WOUT), scr, r / 32, r % 32, lane); continue; } r -= I_OUT;
        if (r < I_UP) { transpose_item<false>(p.in[20], 1024, 4096, (bf16*)(ws + WS_WUP), scr, r / 128, r % 128, lane); continue; } r -= I_UP;
        transpose_item<false>(p.in[21], 4096, 1024, (bf16*)(ws + WS_WDN), scr, r / 32, r % 32, lane);
    }
    const size_t gt = (size_t)blockIdx.x * 512 + tid, NT = (size_t)gridDim.x * 512;
    { bf16* XB = (bf16*)(ws + WS_XB);
      for (size_t i = gt; i < (size_t)MT * 128; i += NT) { const size_t e = i * 8; const float* s = (e < (size_t)MP * 1024) ? p.in[0] + e : p.in[1] + (e - (size_t)MP * 1024); cvt8(s, XB + e); } }
    { unsigned char* KA = ws + WS_KALL; unsigned char* VA = ws + WS_VALL; bf16* KI = (bf16*)(ws + WS_KIALL);
      for (size_t i = gt; i < (size_t)32 * PAST * 16; i += NT) { const size_t row = i >> 4, c16 = (i & 15) * 16; const size_t b = row >> 12, pos = row & 4095;
          const size_t dr = (size_t)MP + b * SKEYS + pos;
          { const float* s = p.in[2] + row * 256 + c16; const f32x4 a = *(const f32x4*)s, b4 = *(const f32x4*)(s + 4), c = *(const f32x4*)(s + 8), d = *(const f32x4*)(s + 12);
            u32x4 o; o.x = pk4_fp8(a[0], a[1], a[2], a[3]); o.y = pk4_fp8(b4[0], b4[1], b4[2], b4[3]); o.z = pk4_fp8(c[0], c[1], c[2], c[3]); o.w = pk4_fp8(d[0], d[1], d[2], d[3]); *(u32x4*)(KA + dr * 256 + c16) = o; }
          { const float* s = p.in[3] + row * 256 + c16; const f32x4 a = *(const f32x4*)s, b4 = *(const f32x4*)(s + 4), c = *(const f32x4*)(s + 8), d = *(const f32x4*)(s + 12);
            u32x4 o; o.x = pk4_fp8(a[0], a[1], a[2], a[3]); o.y = pk4_fp8(b4[0], b4[1], b4[2], b4[3]); o.z = pk4_fp8(c[0], c[1], c[2], c[3]); o.w = pk4_fp8(d[0], d[1], d[2], d[3]); *(u32x4*)(VA + dr * 256 + c16) = o; } }
      for (size_t i = gt; i < (size_t)32 * PAST * 8; i += NT) { const size_t row = i >> 3, c8 = (i & 7) * 8; const size_t b = row >> 12, pos = row & 4095;
          const size_t dr = (size_t)MP + b * SKEYS + pos; cvt8(p.in[4] + row * 64 + c8, KI + dr * 64 + c8); } }
}

constexpr int CV_ROW = 2064;
static_assert(64 * CV_ROW <= LDS_BYTES - 256, "conv LDS");
__device__ __forceinline__ void phase_conv(const Params& p, LAS unsigned char* lds, int tid) {
    unsigned char* ws = p.ws;
    const bf16* XBC = (const bf16*)(ws + WS_XBC); const float* DT = (const float*)(ws + WS_DT);
    bf16* XT = (bf16*)(ws + WS_XT); bf16* BN = (bf16*)(ws + WS_BN); bf16* BT = (bf16*)(ws + WS_BT); bf16* CN = (bf16*)(ws + WS_CN);
    float* ACUM = (float*)(ws + WS_ACUM); float* DTS = (float*)(ws + WS_DTS);
    const float* conv_w = p.in[9]; const float* conv_b = p.in[10]; const float* a_log = p.in[12]; const float* state_conv = p.in[6];
    for (int it = blockIdx.x; it < NQC * 3; it += gridDim.x) {
        const int q = it / 3, j = it - 3 * q;
        const bool samp = q >= 512; const int b = samp ? q - 512 : (q >> 8), c = samp ? 0 : (q & 255);
        const int row0 = samp ? MP + b * 32 : q * 64, nvalid = samp ? 32 : 64;
        if (j == 0) {
            const int ln_ = tid & 63, wv_ = tid >> 6; const int rr_ = (ln_ < nvalid) ? ln_ : 0;
            float dvv[4];
#pragma unroll
            for (int k = 0; k < 4; ++k) dvv[k] = DT[(size_t)(row0 + rr_) * 32 + wv_ * 4 + k];
#pragma unroll
            for (int k = 0; k < 4; ++k) { const int h = wv_ * 4 + k; const float A = -__expf(a_log[h]); const float dv = (ln_ < nvalid) ? dvv[k] : 0.f;
                float x = dv * A;
                x += __builtin_bit_cast(float, __builtin_amdgcn_update_dpp(0, __builtin_bit_cast(int, x), 0x111, 0xF, 0xF, true));
                x += __builtin_bit_cast(float, __builtin_amdgcn_update_dpp(0, __builtin_bit_cast(int, x), 0x112, 0xF, 0xF, true));
                x += __builtin_bit_cast(float, __builtin_amdgcn_update_dpp(0, __builtin_bit_cast(int, x), 0x114, 0xF, 0xF, true));
                x += __builtin_bit_cast(float, __builtin_amdgcn_update_dpp(0, __builtin_bit_cast(int, x), 0x118, 0xF, 0xF, true));
                const float T0 = __builtin_bit_cast(float, __builtin_amdgcn_readlane(__builtin_bit_cast(int, x), 15)), T1 = __builtin_bit_cast(float, __builtin_amdgcn_readlane(__builtin_bit_cast(int, x), 31)),
                            T2 = __builtin_bit_cast(float, __builtin_amdgcn_readlane(__builtin_bit_cast(int, x), 47));
                const int row_ = ln_ >> 4; x += (row_ == 1 ? T0 : row_ == 2 ? T0 + T1 : row_ == 3 ? (T0 + T1) + T2 : 0.f);
                ACUM[(q * 32 + h) * 64 + ln_] = x; DTS[(q * 32 + h) * 64 + ln_] = dv; } }
        {
            const int ch = 2 * (tid + 512 * j);
            float w0[4], w1[4];
#pragma unroll
            for (int i = 0; i < 4; ++i) { w0[i] = conv_w[i * 3072 + ch]; w1[i] = conv_w[i * 3072 + ch + 1]; }
            const float bias0 = conv_b[ch], bias1 = conv_b[ch + 1];
            float h0[3], h1[3];
            if (samp) {
#pragma unroll
                for (int k = 0; k < 3; ++k) { h0[k] = state_conv[(size_t)(b * 3 + k) * 3072 + ch]; h1[k] = state_conv[(size_t)(b * 3 + k) * 3072 + ch + 1]; }
            } else if (c == 0) {
#pragma unroll
                for (int k = 0; k < 3; ++k) { h0[k] = 0.f; h1[k] = 0.f; }
            } else {
#pragma unroll
                for (int k = 0; k < 3; ++k) { const unsigned w = *(const unsigned*)(XBC + (size_t)(row0 - 3 + k) * 3072 + ch); h0[k] = lo_f(w); h1[k] = hi_f(w); }
            }
            unsigned rawall[64];
#pragma unroll
            for (int i = 0; i < 64; ++i) rawall[i] = (i < nvalid) ? *(const unsigned*)(XBC + (size_t)(row0 + i) * 3072 + ch) : 0u;
#pragma unroll
            for (int s0 = 0; s0 < 64; s0 += 8) {
                unsigned raw[8];
#pragma unroll
                for (int i = 0; i < 8; ++i) raw[i] = rawall[s0 + i];
                float o0[8], o1[8];
#pragma unroll
                for (int i = 0; i < 8; ++i) {
                    const float c0 = lo_f(raw[i]), c1 = hi_f(raw[i]);
                    const float v0 = bias0 + w0[0] * h0[0] + w0[1] * h0[1] + w0[2] * h0[2] + w0[3] * c0;
                    const float v1 = bias1 + w1[0] * h1[0] + w1[1] * h1[1] + w1[2] * h1[2] + w1[3] * c1;
                    const bool ok = (s0 + i) < nvalid;
                    o0[i] = ok ? siluf_(v0) : 0.f; o1[i] = ok ? siluf_(v1) : 0.f;
                    h0[0] = h0[1]; h0[1] = h0[2]; h0[2] = c0; h1[0] = h1[1]; h1[1] = h1[2]; h1[2] = c1;
                }
                u32x4 t0, t1;
                t0.x = pk2(o0[0], o0[1]); t0.y = pk2(o0[2], o0[3]); t0.z = pk2(o0[4], o0[5]); t0.w = pk2(o0[6], o0[7]);
                t1.x = pk2(o1[0], o1[1]); t1.y = pk2(o1[2], o1[3]); t1.z = pk2(o1[4], o1[5]); t1.w = pk2(o1[6], o1[7]);
                if (ch < 2048) {
                    const int h = ch >> 6, pp = ch & 63;
                    bf16* xp_ = XT + (size_t)(q * 32 + h) * 4096 + ((s0 >> 3) * 64 + pp) * 8; *(u32x4*)xp_ = t0; *(u32x4*)(xp_ + 8) = t1;
                } else if (ch < 2560) {
                    const int g = (ch - 2048) >> 7, n = (ch - 2048) & 127;
                    bf16* bp_ = BT + (size_t)(q * 4 + g) * 8192 + ((s0 >> 3) * 128 + n) * 8; *(u32x4*)bp_ = t0; *(u32x4*)(bp_ + 8) = t1;
#pragma unroll
                    for (int i = 0; i < 8; ++i) *(LAS unsigned*)(lds + (s0 + i) * CV_ROW + (ch - 2048) * 2) = pk2(o0[i], o1[i]);
                } else {
                    const int g = (ch - 2560) >> 7, n = (ch - 2560) & 127;
#pragma unroll
                    for (int i = 0; i < 8; ++i) *(LAS unsigned*)(lds + (s0 + i) * CV_ROW + (ch - 2048) * 2) = pk2(o0[i], o1[i]);
                }
            }
        }
        if (j == 2) {
            __syncthreads();
            const int wv_ = tid >> 6, ln_ = tid & 63;
#pragma unroll 4
            for (int oc = 0; oc < 16; ++oc) { const int octet = wv_ * 16 + oc; const u32x4 v = *(const LAS u32x4*)(lds + ln_ * CV_ROW + octet * 16);
                bf16* dst = ((octet < 64) ? BN : CN) + (size_t)(q * 4 + ((octet & 63) >> 4)) * 8192 + ((octet & 15) * 64 + ln_) * 8; *(u32x4*)dst = v; }
            __syncthreads();
        }
    }
}

__device__ __forceinline__ bf16x8 scale8(bf16x8 v, const float (&w)[8]) {
    const u32x4 u = __builtin_bit_cast(u32x4, v); u32x4 o;
    o.x = pk2(lo_f(u.x) * w[0], hi_f(u.x) * w[1]); o.y = pk2(lo_f(u.y) * w[2], hi_f(u.y) * w[3]);
    o.z = pk2(lo_f(u.z) * w[4], hi_f(u.z) * w[5]); o.w = pk2(lo_f(u.w) * w[6], hi_f(u.w) * w[7]);
    return __builtin_bit_cast(bf16x8, o);
}
__device__ __forceinline__ void phase_s1(const Params& p, int wave, int lane) {
    unsigned char* ws = p.ws;
    const bf16* XT = (const bf16*)(ws + WS_XT); const bf16* BT = (const bf16*)(ws + WS_BT);
    const float* ACUM = (const float*)(ws + WS_ACUM); const float* DTS = (const float*)(ws + WS_DTS);
    bf16* ST = (bf16*)(ws + WS_STATES);
    const int gw = blockIdx.x * 8 + wave, NGW = gridDim.x * 8, l32 = lane & 31, hh = lane >> 5;
#pragma unroll 1
    for (int it = gw; it < NQC * 32; it += NGW) {
        const int q = it >> 5, h = it & 31, g = h >> 3;
        const float* ac = ACUM + (q * 32 + h) * 64 + 8 * hh; const float* dts = DTS + (q * 32 + h) * 64 + 8 * hh;
        f32x4 av[4][2], dv[4][2]; bf16x8 af[2][4], bfr[4][4];
#pragma unroll
        for (int kk = 0; kk < 4; ++kk) { av[kk][0] = *(const f32x4*)(ac + 16 * kk); av[kk][1] = *(const f32x4*)(ac + 16 * kk + 4); dv[kk][0] = *(const f32x4*)(dts + 16 * kk); dv[kk][1] = *(const f32x4*)(dts + 16 * kk + 4); }
        const float alast = ACUM[(q * 32 + h) * 64 + 63];
#pragma unroll
        for (int pb = 0; pb < 2; ++pb)
#pragma unroll
            for (int kk = 0; kk < 4; ++kk) af[pb][kk] = ldg8(XT + (size_t)(q * 32 + h) * 4096 + ((2 * kk + hh) * 64 + pb * 32 + l32) * 8);
        float w[4][8];
#pragma unroll
        for (int kk = 0; kk < 4; ++kk)
#pragma unroll
            for (int e = 0; e < 4; ++e) { w[kk][e] = __expf(alast - av[kk][0][e]) * dv[kk][0][e]; w[kk][4 + e] = __expf(alast - av[kk][1][e]) * dv[kk][1][e]; }
        asm volatile("" ::: "memory");
#pragma unroll
        for (int nb = 0; nb < 4; ++nb)
#pragma unroll
            for (int kk = 0; kk < 4; ++kk) bfr[nb][kk] = ldg8(BT + (size_t)(q * 4 + g) * 8192 + ((2 * kk + hh) * 128 + nb * 32 + l32) * 8);
#pragma unroll
        for (int pb = 0; pb < 2; ++pb) {
            f32x16 acc[4];
#pragma unroll
            for (int n = 0; n < 4; ++n)
#pragma unroll
                for (int e = 0; e < 16; ++e) acc[n][e] = 0.f;
#pragma unroll
            for (int kk = 0; kk < 4; ++kk) { const bf16x8 a = scale8(af[pb][kk], w[kk]);
#pragma unroll
                for (int nb = 0; nb < 4; ++nb) acc[nb] = MFMA32(bfr[nb][kk], a, acc[nb]); }
            bf16* sp = ST + (size_t)(q * 32 + h) * 8192 + (pb * 32 + l32) * 8 + 4 * hh;
#pragma unroll
            for (int nb = 0; nb < 4; ++nb)
#pragma unroll
                for (int e4 = 0; e4 < 4; ++e4) { u32x2 o; o.x = pk2(acc[nb][4 * e4], acc[nb][4 * e4 + 1]); o.y = pk2(acc[nb][4 * e4 + 2], acc[nb][4 * e4 + 3]); *(u32x2*)(sp + (nb * 4 + e4) * 512) = o; }
        }
    }
}

__device__ __forceinline__ void phase_s2(const Params& p, int tid) {
    unsigned char* ws = p.ws;
    bf16* ST = (bf16*)(ws + WS_STATES); const float* ACUM = (const float*)(ws + WS_ACUM);
    const size_t gt = (size_t)blockIdx.x * 512 + tid, NT = (size_t)gridDim.x * 512;
    for (size_t u = gt; u < 131072; u += NT) {
        const int b = (int)(u >> 16), e = (int)(u & 65535) * 4, h = e >> 13;
        f32x4 st = {0.f, 0.f, 0.f, 0.f};
#pragma unroll 1
        for (int c0 = 0; c0 < 256; c0 += 16) {
            u32x2 raw[16]; float dec[16];
#pragma unroll
            for (int i = 0; i < 16; ++i) { const int q = b * 256 + c0 + i; raw[i] = *(const u32x2*)(ST + (size_t)q * 262144 + e); dec[i] = ACUM[(q * 32 + h) * 64 + 63]; }
#pragma unroll
            for (int i = 0; i < 16; ++i) { const int q = b * 256 + c0 + i; u32x2 o; o.x = pk2(st[0], st[1]); o.y = pk2(st[2], st[3]); *(u32x2*)(ST + (size_t)q * 262144 + e) = o;
                const float d = __expf(dec[i]); st[0] = st[0] * d + lo_f(raw[i].x); st[1] = st[1] * d + hi_f(raw[i].x); st[2] = st[2] * d + lo_f(raw[i].y); st[3] = st[3] * d + hi_f(raw[i].y); }
        }
        { const int eh = e & 8191; *(f32x4*)(p.out + OUT_SSMP + (size_t)b * 262144 + (e - eh) + ((eh >> 3) & 63) * 128 + (eh >> 9) * 8 + (eh & 7)) = st; }
    }
    for (size_t u = gt; u < (size_t)32 * 65536; u += NT) {
        const int b = (int)(u >> 16), e = (int)(u & 65535) * 4, h = e >> 13, q = 512 + b;
        const int eh = e & 8191; const size_t nat = (size_t)b * 262144 + (e - eh) + ((eh >> 3) & 63) * 128 + (eh >> 9) * 8 + (eh & 7);
        const f32x4 h0 = *(const f32x4*)(p.in[5] + nat);
        const u32x2 raw = *(const u32x2*)(ST + (size_t)q * 262144 + e);
        const float d = __expf(ACUM[(q * 32 + h) * 64 + 63]);
        u32x2 o; o.x = pk2(h0[0], h0[1]); o.y = pk2(h0[2], h0[3]); *(u32x2*)(ST + (size_t)q * 262144 + e) = o;
        f32x4 r; r[0] = h0[0] * d + lo_f(raw.x); r[1] = h0[1] * d + hi_f(raw.x); r[2] = h0[2] * d + lo_f(raw.y); r[3] = h0[3] * d + hi_f(raw.y);
        *(f32x4*)(p.out + OUT_SSMS + nat) = r;
    }
}

constexpr int S3_MROW = 144;
constexpr int S3_YROW = 272;
constexpr int S3_WBYTES = 64 * S3_YROW;
constexpr int S3_SSQ_OFF = 8 * S3_WBYTES;
constexpr int S3_AC_OFF = S3_SSQ_OFF + 2048;
static_assert(S3_AC_OFF + 4096 <= LDS_BYTES - 256, "S3 LDS");
__device__ __forceinline__ void phase_s3(const Params& p, LAS unsigned char* lds, int wave, int lane) {
    unsigned char* ws = p.ws;
    const bf16* XT = (const bf16*)(ws + WS_XT); const bf16* BN = (const bf16*)(ws + WS_BN); const bf16* CN = (const bf16*)(ws + WS_CN);
    const float* ACUM = (const float*)(ws + WS_ACUM); const float* DTS = (const float*)(ws + WS_DTS); const bf16* ST = (const bf16*)(ws + WS_STATES);
    bf16* ZY = (bf16*)(ws + WS_Z);
    const float* d_skip = p.in[13]; const float* norm_w = p.in[14];
    const int l32 = lane & 31, hh = lane >> 5;
    LAS unsigned char* Mw = lds + wave * S3_WBYTES;
    LAS float* SSQ = (LAS float*)(lds + S3_SSQ_OFF);
    LAS float* acl = (LAS float*)(lds + S3_AC_OFF) + wave * 128; LAS float* dtl = acl + 64;
#pragma unroll 1
    for (int it = blockIdx.x; it < NQC * 4; it += gridDim.x) {
        const int q = it >> 2, g = it & 3, h = g * 8 + wave;
        const bool samp = q >= 512; const int row0 = samp ? MP + (q - 512) * 32 : q * 64, nvalid = samp ? 32 : 64;
        const float* ac = ACUM + (q * 32 + h) * 64; const float* dts = DTS + (q * 32 + h) * 64;
        acl[lane] = ac[lane]; dtl[lane] = dts[lane];
        const bf16* Cb = CN + (size_t)(q * 4 + g) * 8192; const bf16* Bb = BN + (size_t)(q * 4 + g) * 8192;
        const bf16* Xb = XT + (size_t)(q * 32 + h) * 4096; const bf16* Hb = ST + (size_t)(q * 32 + h) * 8192;
        bf16x8 cf[2][8];
#pragma unroll
        for (int tb = 0; tb < 2; ++tb)
#pragma unroll
            for (int kk = 0; kk < 8; ++kk) cf[tb][kk] = ldg8(Cb + ((2 * kk + hh) * 64 + tb * 32 + l32) * 8);
        {
            f32x16 cb00, cb10, cb11;
#pragma unroll
            for (int e = 0; e < 16; ++e) { cb00[e] = 0.f; cb10[e] = 0.f; cb11[e] = 0.f; }
            { bf16x8 bq_[2][8];
#pragma unroll
              for (int kk = 0; kk < 8; ++kk) { bq_[0][kk] = ldg8(Bb + ((2 * kk + hh) * 64 + l32) * 8); bq_[1][kk] = ldg8(Bb + ((2 * kk + hh) * 64 + 32 + l32) * 8); }
#pragma unroll
              for (int kk = 0; kk < 8; ++kk) { cb00 = MFMA32(cf[0][kk], bq_[0][kk], cb00); cb10 = MFMA32(cf[1][kk], bq_[0][kk], cb10); cb11 = MFMA32(cf[1][kk], bq_[1][kk], cb11); } }
            asm volatile("s_waitcnt lgkmcnt(0)" ::: "memory"); __builtin_amdgcn_wave_barrier();
            const float as0 = acl[l32], as1 = acl[32 + l32], ds0 = dtl[l32], ds1 = dtl[32 + l32]; const float Dh = d_skip[h];
#pragma unroll
            for (int e = 0; e < 16; ++e) { const int tl = (e & 3) + 8 * (e >> 2) + 4 * hh; const float at0 = acl[tl], at1 = acl[32 + tl];
                { const int t = tl, s_ = l32; float m = (s_ <= t) ? cb00[e] * __expf(fminf(at0 - as0, 0.f)) * ds0 : 0.f; if (s_ == t) m += Dh; *(LAS unsigned short*)(Mw + t * S3_MROW + s_ * 2) = f2bf(m); }
                { const int t = tl; *(LAS unsigned short*)(Mw + t * S3_MROW + (32 + l32) * 2) = 0; }
                { const int t = 32 + tl, s_ = l32; const float m = cb10[e] * __expf(fminf(at1 - as0, 0.f)) * ds0; *(LAS unsigned short*)(Mw + t * S3_MROW + s_ * 2) = f2bf(m); }
                { const int t = 32 + tl, s_ = 32 + l32; float m = (s_ <= t) ? cb11[e] * __expf(fminf(at1 - as1, 0.f)) * ds1 : 0.f; if (s_ == t) m += Dh; *(LAS unsigned short*)(Mw + t * S3_MROW + s_ * 2) = f2bf(m); } }
        }
        f32x16 y[2][2];
#pragma unroll
        for (int a = 0; a < 2; ++a)
#pragma unroll
            for (int b = 0; b < 2; ++b)
#pragma unroll
                for (int e = 0; e < 16; ++e) y[a][b][e] = 0.f;
        bf16x8 hq_[2][5];
#pragma unroll
        for (int kk = 0; kk < 5; ++kk) { hq_[0][kk] = ldg8(Hb + ((2 * kk + hh) * 64 + l32) * 8); hq_[1][kk] = ldg8(Hb + ((2 * kk + hh) * 64 + 32 + l32) * 8); }
#pragma unroll
        for (int kk = 0; kk < 8; ++kk) {
            const int sl = kk < 5 ? kk : kk - 5;
            const bf16x8 h0 = hq_[0][sl], h1 = hq_[1][sl];
            y[0][0] = MFMA32(cf[0][kk], h0, y[0][0]); y[0][1] = MFMA32(cf[0][kk], h1, y[0][1]);
            y[1][0] = MFMA32(cf[1][kk], h0, y[1][0]); y[1][1] = MFMA32(cf[1][kk], h1, y[1][1]);
            if (kk < 3) { hq_[0][kk] = ldg8(Hb + ((2 * (kk + 5) + hh) * 64 + l32) * 8); hq_[1][kk] = ldg8(Hb + ((2 * (kk + 5) + hh) * 64 + 32 + l32) * 8); }
        }
        __builtin_amdgcn_sched_barrier(0);
        bf16x8 xq[2][4];
#pragma unroll
        for (int kk = 0; kk < 4; ++kk) { xq[0][kk] = ldg8(Xb + ((2 * kk + hh) * 64 + l32) * 8); xq[1][kk] = ldg8(Xb + ((2 * kk + hh) * 64 + 32 + l32) * 8); }
        const int r8 = lane >> 3, c8 = lane & 7;
        u32x4 zq[8];
#pragma unroll
        for (int it8 = 0; it8 < 8; ++it8) { const int t = it8 * 8 + r8; const int tr = (t < nvalid) ? t : 0; zq[it8] = *(const u32x4*)(ZY + (size_t)(row0 + tr) * 2048 + h * 64 + c8 * 8); }
#pragma unroll
        for (int tb = 0; tb < 2; ++tb)
#pragma unroll
            for (int e = 0; e < 16; ++e) { const float sc = __expf(acl[tb * 32 + (e & 3) + 8 * (e >> 2) + 4 * hh]); y[tb][0][e] *= sc; y[tb][1][e] *= sc; }
        __syncthreads();
#pragma unroll
        for (int kk = 0; kk < 4; ++kk) {
            const bf16x8 x0 = xq[0][kk], x1 = xq[1][kk];
            const bf16x8 m0 = *(const LAS bf16x8*)(Mw + (l32) * S3_MROW + (16 * kk + 8 * hh) * 2), m1 = *(const LAS bf16x8*)(Mw + (32 + l32) * S3_MROW + (16 * kk + 8 * hh) * 2);
            y[0][0] = MFMA32(m0, x0, y[0][0]); y[0][1] = MFMA32(m0, x1, y[0][1]);
            y[1][0] = MFMA32(m1, x0, y[1][0]); y[1][1] = MFMA32(m1, x1, y[1][1]);
        }
        asm volatile("s_waitcnt lgkmcnt(0)" ::: "memory"); __builtin_amdgcn_wave_barrier();
#pragma unroll
        for (int tb = 0; tb < 2; ++tb)
#pragma unroll
            for (int pb = 0; pb < 2; ++pb)
#pragma unroll
                for (int e = 0; e < 16; ++e) *(LAS float*)(Mw + (tb * 32 + (e & 3) + 8 * (e >> 2) + 4 * hh) * S3_YROW + (pb * 32 + l32) * 4) = y[tb][pb][e];
        asm volatile("s_waitcnt lgkmcnt(0)" ::: "memory"); __builtin_amdgcn_wave_barrier();
        float hv[8][8];
#pragma unroll
        for (int it = 0; it < 8; ++it) { const int t = it * 8 + r8; const int tr = (t < nvalid) ? t : 0;
            const f32x4 y0 = *(const LAS f32x4*)(Mw + t * S3_YROW + c8 * 32), y1 = *(const LAS f32x4*)(Mw + t * S3_YROW + c8 * 32 + 16);
            const u32x4 zw = zq[it]; (void)tr;
            float zf[8]; zf[0] = lo_f(zw.x); zf[1] = hi_f(zw.x); zf[2] = lo_f(zw.y); zf[3] = hi_f(zw.y); zf[4] = lo_f(zw.z); zf[5] = hi_f(zw.z); zf[6] = lo_f(zw.w); zf[7] = hi_f(zw.w);
            float sq = 0.f;
#pragma unroll
            for (int k = 0; k < 4; ++k) { hv[it][k] = y0[k] * siluf_(zf[k]); hv[it][4 + k] = y1[k] * siluf_(zf[4 + k]); sq += hv[it][k] * hv[it][k] + hv[it][4 + k] * hv[it][4 + k]; }
            sq += __shfl_xor(sq, 1); sq += __shfl_xor(sq, 2); sq += __shfl_xor(sq, 4);
            if (c8 == 0) SSQ[wave * 64 + t] = sq; }
        __syncthreads();
        float nw[8];
        { const f32x4 n0 = *(const f32x4*)(norm_w + h * 64 + c8 * 8), n1 = *(const f32x4*)(norm_w + h * 64 + c8 * 8 + 4);
#pragma unroll
          for (int k = 0; k < 4; ++k) { nw[k] = n0[k]; nw[4 + k] = n1[k]; } }
#pragma unroll
        for (int it = 0; it < 8; ++it) { const int t = it * 8 + r8;
            float sm = 0.f;
#pragma unroll
            for (int w = 0; w < 8; ++w) sm += SSQ[w * 64 + t];
            const float rs = rsqrtf(sm * (1.0f / 512.0f) + RMS_EPS);
            if (t < nvalid) { u32x4 o; o.x = pk2(hv[it][0] * rs * nw[0], hv[it][1] * rs * nw[1]); o.y = pk2(hv[it][2] * rs * nw[2], hv[it][3] * rs * nw[3]);
                o.z = pk2(hv[it][4] * rs * nw[4], hv[it][5] * rs * nw[5]); o.w = pk2(hv[it][6] * rs * nw[6], hv[it][7] * rs * nw[7]);
                *(u32x4*)(ZY + (size_t)(row0 + t) * 2048 + h * 64 + c8 * 8) = o; } }
    }
}

constexpr int IX_CAP = 896, IX_THR = 768, IX_KEEP = 320;
constexpr int IX_RING_OFF = 32 * IX_CAP * 4;
constexpr int IX_HIST_OFF = IX_RING_OFF + 32768;
constexpr int IX_CNT_OFF = IX_HIST_OFF + 8192;
constexpr int IX_TAU_OFF = IX_CNT_OFF + 128;
constexpr int IX_TAUF_OFF = IX_TAU_OFF + 128;
constexpr int IX_MISC_OFF = IX_TAUF_OFF + 128;
constexpr int IX_NITEMS = 1056;
static_assert(IX_MISC_OFF + 16 <= LDS_BYTES - 256, "indexer LDS");
#define WAVE_LDS_FENCE() do { asm volatile("s_waitcnt lgkmcnt(0)" ::: "memory"); __builtin_amdgcn_wave_barrier(); } while (0)

__device__ __forceinline__ float ix_tau_float(unsigned tau) {
    const unsigned m = tau & 0xFFFFC000u;
    const unsigned u = (m & 0x80000000u) ? (m ^ 0x80000000u) : ~m;
    return tau == 0u ? -INFINITY : __uint_as_float(u);
}
__device__ __forceinline__ unsigned wave_max_u32(unsigned x) {
    unsigned t;
    t = (unsigned)__builtin_amdgcn_update_dpp(0, (int)x, 0xB1, 0xF, 0xF, true); x = x > t ? x : t;
    t = (unsigned)__builtin_amdgcn_update_dpp(0, (int)x, 0x4E, 0xF, 0xF, true); x = x > t ? x : t;
    t = (unsigned)__builtin_amdgcn_update_dpp(0, (int)x, 0x141, 0xF, 0xF, true); x = x > t ? x : t;
    t = (unsigned)__builtin_amdgcn_update_dpp(0, (int)x, 0x140, 0xF, 0xF, true); x = x > t ? x : t;
    { const auto r = __builtin_amdgcn_permlane16_swap(x, x, false, false); x = r[0] > r[1] ? r[0] : r[1]; }
    { const auto r = __builtin_amdgcn_permlane32_swap(x, x, false, false); x = r[0] > r[1] ? r[0] : r[1]; }
    return x;
}
__device__ __forceinline__ unsigned wave_suffix_sum_u32(unsigned s, int lane) {
    s += (unsigned)__builtin_amdgcn_update_dpp(0, (int)s, 0x101, 0xF, 0xF, true);
    s += (unsigned)__builtin_amdgcn_update_dpp(0, (int)s, 0x102, 0xF, 0xF, true);
    s += (unsigned)__builtin_amdgcn_update_dpp(0, (int)s, 0x104, 0xF, 0xF, true);
    s += (unsigned)__builtin_amdgcn_update_dpp(0, (int)s, 0x108, 0xF, 0xF, true);
    const unsigned T1 = (unsigned)__builtin_amdgcn_readlane((int)s, 16), T2 = (unsigned)__builtin_amdgcn_readlane((int)s, 32), T3 = (unsigned)__builtin_amdgcn_readlane((int)s, 48);
    const int row = lane >> 4;
    return s + (row == 0 ? T1 + T2 + T3 : row == 1 ? T2 + T3 : row == 2 ? T3 : 0u);
}
__device__ __forceinline__ void ix_select(LAS unsigned* cr, LAS unsigned* hist, LAS unsigned* cntp, LAS unsigned* taup, LAS float* taufp, int n, unsigned tau_old, bool exact, int lane) {
    unsigned v[14]; unsigned mx = 0u;
#pragma unroll
    for (int i = 0; i < 14; ++i) { const int idx = lane + 64 * i; v[i] = (idx < n) ? cr[idx] : 0u; mx = v[i] > mx ? v[i] : mx; }
    mx = wave_max_u32(mx);
    unsigned lo = tau_old, hi = mx, kth = 256u, above_total = 0u;
#pragma unroll 1
    for (int round = 0; round < 6; ++round) {
        const unsigned span = hi - lo - 1u;
        const int shift = (span >> 8) ? (32 - __clz(span) - 8) : 0;
#pragma unroll
        for (int j = 0; j < 4; ++j) hist[lane * 4 + j] = 0u;
        WAVE_LDS_FENCE();
#pragma unroll
        for (int i = 0; i < 14; ++i) if (v[i] > lo && v[i] <= hi) __hip_atomic_fetch_add(&hist[(v[i] - lo - 1u) >> shift], 1u, __ATOMIC_RELAXED, __HIP_MEMORY_SCOPE_WORKGROUP);
        WAVE_LDS_FENCE();
        const unsigned h0 = hist[lane * 4 + 0], h1 = hist[lane * 4 + 1], h2 = hist[lane * 4 + 2], h3 = hist[lane * 4 + 3];
        const unsigned lsum = h0 + h1 + h2 + h3;
        const unsigned s = wave_suffix_sum_u32(lsum, lane);
        const unsigned a3 = s - lsum, a2 = a3 + h3, a1 = a2 + h2, a0 = a1 + h1;
        int found = -1; unsigned abv = 0u, inb = 0u;
        if (a3 < kth && kth <= a3 + h3) { found = 3; abv = a3; inb = h3; }
        else if (a2 < kth && kth <= a2 + h2) { found = 2; abv = a2; inb = h2; }
        else if (a1 < kth && kth <= a1 + h1) { found = 1; abv = a1; inb = h1; }
        else if (a0 < kth && kth <= a0 + h0) { found = 0; abv = a0; inb = h0; }
        const unsigned long long bal = __ballot(found >= 0);
        const int src = (bal != 0ull) ? (__ffsll((long long)bal) - 1) : 0;
        const unsigned bin = (unsigned)__builtin_amdgcn_readlane(lane * 4 + (found < 0 ? 0 : found), src); const unsigned ab = (unsigned)__builtin_amdgcn_readlane((int)abv, src), ib = (unsigned)__builtin_amdgcn_readlane((int)inb, src);
        WAVE_LDS_FENCE();
        kth -= ab; above_total += ab;
        const unsigned nlo = lo + (bin << shift);
        hi = (shift == 0) ? nlo + 1u : lo + ((bin + 1u) << shift); if (hi > mx) hi = mx;
        lo = nlo;
        if (shift == 0) break;
        if (!exact && above_total + ib <= (unsigned)IX_KEEP) break;
        if (exact && ib <= 64u) {
            unsigned base_ = 0u;
#pragma unroll
            for (int i = 0; i < 14; ++i) { const bool in_ = v[i] > lo && v[i] <= hi; const unsigned long long bal_ = __ballot(in_);
                const unsigned pos_ = base_ + (unsigned)__popcll(bal_ & ((1ull << lane) - 1ull)); if (in_) hist[pos_] = v[i]; base_ += (unsigned)__popcll(bal_); }
            WAVE_LDS_FENCE();
            const unsigned x_ = ((unsigned)lane < ib) ? hist[lane] : 0u; unsigned rank_ = 0u;
            for (unsigned m_ = 0; m_ < ib; ++m_) rank_ += (hist[m_] > x_) ? 1u : 0u;
            const unsigned long long hit_ = __ballot((unsigned)lane < ib && rank_ == kth - 1u);
            const int src_ = (hit_ != 0ull) ? (__ffsll((long long)hit_) - 1) : 0;
            lo = (unsigned)__builtin_amdgcn_readlane((int)x_, src_) - 1u;
            WAVE_LDS_FENCE();
            break;
        }
    }
    unsigned base = 0u;
#pragma unroll
    for (int i = 0; i < 14; ++i) { const bool keep = v[i] > lo; const unsigned long long bal = __ballot(keep);
        const unsigned pos = base + (unsigned)__popcll(bal & ((1ull << lane) - 1ull)); if (keep) cr[pos] = v[i]; base += (unsigned)__popcll(bal); }
    if (lane == 0) { *cntp = base; *taup = lo; *taufp = ix_tau_float(lo); }
    WAVE_LDS_FENCE();
}

#ifdef IXT
#define IXT_BEGIN(k) unsigned long long _t##k = (IXT == k) ? __builtin_amdgcn_s_memrealtime() : 0ull
#define IXT_END(k) do { if (IXT == k) ixt_acc += __builtin_amdgcn_s_memrealtime() - _t##k; } while (0)
#else
#define IXT_BEGIN(k) do {} while (0)
#define IXT_END(k) do {} while (0)
#endif
template <int VARIANT>
__device__ __forceinline__ void phase_indexer(const Params& p, LAS unsigned char* lds, int tid, int wave, int lane) {
    unsigned char* ws = p.ws;
    const bf16* QI = (const bf16*)(ws + WS_QI); const bf16* KI = (const bf16*)(ws + WS_KIALL); const float* WI = (const float*)(ws + WS_WI);
    unsigned short* SEL = (unsigned short*)(ws + WS_SEL);
    unsigned* queue = (unsigned*)(ws + WS_CTL) + CW_QUEUE + 64 * VARIANT;
    LAS unsigned* cand = (LAS unsigned*)lds; LAS unsigned* hist = (LAS unsigned*)(lds + IX_HIST_OFF) + wave * 256;
    LAS unsigned* cnt = (LAS unsigned*)(lds + IX_CNT_OFF); LAS unsigned* tau = (LAS unsigned*)(lds + IX_TAU_OFF); LAS float* tauf = (LAS float*)(lds + IX_TAUF_OFF);
    LAS unsigned* misc = (LAS unsigned*)(lds + IX_MISC_OFF);
    const int fr = lane & 15, fq = lane >> 4, rb = wave >> 2, cq = wave & 3;
    unsigned long long ixt_acc = 0ull; (void)ixt_acc;
#pragma unroll 1
    for (;;) {
        if (tid == 0) misc[0] = __hip_atomic_fetch_add(queue, 1u, __ATOMIC_RELAXED, __HIP_MEMORY_SCOPE_AGENT);
        __syncthreads();
        const int item = (int)misc[0];
        __syncthreads();
        if (item >= IX_NITEMS) break;
        bool samp = false; int b, c = 0, hf = 0;
        if (item < 764) { b = item & 1; hf = (item >> 1) & 1; c = 255 - (item >> 2); }
        else if (item < 796) { samp = true; b = item - 764; }
        else { const int j = item - 32; b = j & 1; hf = (j >> 1) & 1; c = 255 - (j >> 2); }
        const int qrow0 = samp ? MP + b * 32 : b * SEQP + c * 64 + hf * 32;
        const int krow0 = samp ? MP + b * SKEYS : b * SEQP, nkeys = samp ? SKEYS : 64 * (c + 1), nsteps = (nkeys + 127) >> 7;
        if (tid < 32) { cnt[tid] = 0u; tau[tid] = (VARIANT >= 1) ? 0xFFFFFFFFu : 0u; tauf[tid] = (VARIANT >= 1) ? __uint_as_float(0x7FFFC000u) : -INFINITY; }
        if (tid >= 32 && tid < 34) misc[tid - 30] = 0u;
        bf16x8 af[8][2], qt[2]; float wh[8][4];
        { const bf16* qp = QI + (size_t)(qrow0 + rb * 16 + fr) * 512 + 8 * fq;
#pragma unroll
          for (int h = 0; h < 8; ++h) { af[h][0] = ldg8(qp + h * 64); af[h][1] = ldg8(qp + h * 64 + 32); }
#pragma unroll
          for (int r = 0; r < 4; ++r) { const float* wp = WI + (size_t)(qrow0 + rb * 16 + 4 * fq + r) * 8;
              const f32x4 w0 = *(const f32x4*)wp, w1 = *(const f32x4*)(wp + 4);
#pragma unroll
              for (int e = 0; e < 4; ++e) { wh[e][r] = 0.5f * w0[e]; wh[4 + e][r] = 0.5f * w1[e]; } }
          const float* wp = WI + (size_t)(qrow0 + rb * 16 + fr) * 8; const f32x4 w0 = *(const f32x4*)wp, w1 = *(const f32x4*)(wp + 4);
          float wr_[8]; wr_[0] = w0[0]; wr_[1] = w0[1]; wr_[2] = w0[2]; wr_[3] = w0[3]; wr_[4] = w1[0]; wr_[5] = w1[1]; wr_[6] = w1[2]; wr_[7] = w1[3];
#pragma unroll
          for (int ks = 0; ks < 2; ++ks) { float a8[8];
#pragma unroll
              for (int e = 0; e < 8; ++e) a8[e] = 0.f;
#pragma unroll
              for (int h = 0; h < 8; ++h) { const u32x4 u = __builtin_bit_cast(u32x4, af[h][ks]); const float s_ = 0.5f * wr_[h];
                  a8[0] += s_ * lo_f(u.x); a8[1] += s_ * hi_f(u.x); a8[2] += s_ * lo_f(u.y); a8[3] += s_ * hi_f(u.y);
                  a8[4] += s_ * lo_f(u.z); a8[5] += s_ * hi_f(u.z); a8[6] += s_ * lo_f(u.w); a8[7] += s_ * hi_f(u.w); }
              u32x4 o; o.x = pk2(a8[0], a8[1]); o.y = pk2(a8[2], a8[3]); o.z = pk2(a8[4], a8[5]); o.w = pk2(a8[6], a8[7]); qt[ks] = __builtin_bit_cast(bf16x8, o); } }
        __syncthreads();
        const char* kib = (const char*)(KI + (size_t)krow0 * 64);
        const int srow = tid >> 3, sch = tid & 7;
#define IX_GLOAD(R, step) do { _Pragma("unroll") for (int i = 0; i < 2; ++i) { int key = (step) * 128 + srow + 64 * i; if (key > nkeys - 1) key = nkeys - 1; \
            R[i] = *(const u32x4*)(kib + ((unsigned)key * 128u + (unsigned)sch * 16u)); } } while (0)
#define IX_SWRITE(R, slot) do { _Pragma("unroll") for (int i = 0; i < 2; ++i) { const int k = srow + 64 * i; \
            *(LAS u32x4*)(lds + IX_RING_OFF + (slot) * 16384 + k * 128 + ((sch ^ (k & 7)) << 4)) = R[i]; } } while (0)
#define IX_COMPUTE(slot, step) do { \
            float sc[2][4]; unsigned long long pm = 0ull; \
            _Pragma("unroll") for (int cbi = 0; cbi < 2; ++cbi) { const int kl = cq * 32 + 16 * cbi + fr; \
                const bf16x8 b0 = *(const LAS bf16x8*)(lds + IX_RING_OFF + (slot) * 16384 + kl * 128 + ((fq ^ (kl & 7)) << 4)); \
                const bf16x8 b1 = *(const LAS bf16x8*)(lds + IX_RING_OFF + (slot) * 16384 + kl * 128 + (((4 + fq) ^ (kl & 7)) << 4)); \
                f32x4 acc = {0.f, 0.f, 0.f, 0.f}; acc = MFMA16(qt[0], b0, acc); acc = MFMA16(qt[1], b1, acc); \
                f32x4 dq = {0.f, 0.f, 0.f, 0.f}; dq = MFMA16(af[0][0], b0, dq); dq = MFMA16(af[0][1], b1, dq); \
                float a0_ = acc[0], a1_ = acc[1], a2_ = acc[2], a3_ = acc[3]; \
                  \
                _Pragma("unroll") for (int h = 0; h < (VARIANT == 2 ? 4 : 8); ++h) { f32x4 dn = {0.f, 0.f, 0.f, 0.f}; \
                    if (h + 1 < (VARIANT == 2 ? 4 : 8)) { dn = MFMA16(af[(h + 1) & 7][0], b0, dn); dn = MFMA16(af[(h + 1) & 7][1], b1, dn); } \
                    __builtin_amdgcn_sched_barrier(0); \
                    a0_ = __builtin_fmaf(wh[h][0], __builtin_fabsf(dq[0]), a0_); asm("" : "+v"(a0_)); a1_ = __builtin_fmaf(wh[h][1], __builtin_fabsf(dq[1]), a1_); asm("" : "+v"(a1_)); \
                    a2_ = __builtin_fmaf(wh[h][2], __builtin_fabsf(dq[2]), a2_); asm("" : "+v"(a2_)); a3_ = __builtin_fmaf(wh[h][3], __builtin_fabsf(dq[3]), a3_); asm("" : "+v"(a3_)); \
                    __builtin_amdgcn_sched_barrier(0); \
                    dq = dn; } \
                sc[cbi][0] = a0_; sc[cbi][1] = a1_; sc[cbi][2] = a2_; sc[cbi][3] = a3_; \
                pm |= __ballot(a0_ >= tf[0]) | __ballot(a1_ >= tf[1]) | __ballot(a2_ >= tf[2]) | __ballot(a3_ >= tf[3]); } \
            if (pm != 0ull) { IXT_BEGIN(2); \
                unsigned pk[2][4], sl[2][4]; bool ps[2][4]; \
                _Pragma("unroll") for (int cbi = 0; cbi < 2; ++cbi) { const int kidx = (step) * 128 + cq * 32 + 16 * cbi + fr; const bool inr = kidx < nkeys; const unsigned low = (unsigned)(16383 - kidx); \
                    _Pragma("unroll") for (int r = 0; r < 4; ++r) { const unsigned u = __float_as_uint(sc[cbi][r]); const unsigned mono = u ^ ((unsigned)((int)u >> 31) | 0x80000000u); \
                        pk[cbi][r] = (mono & 0xFFFFC000u) | low; ps[cbi][r] = inr && (pk[cbi][r] > tq[r]); sl[cbi][r] = 0u; \
                        if (ps[cbi][r]) sl[cbi][r] = __hip_atomic_fetch_add(cntw + r, 1u, __ATOMIC_RELAXED, __HIP_MEMORY_SCOPE_WORKGROUP); } } \
                _Pragma("unroll") for (int cbi = 0; cbi < 2; ++cbi) _Pragma("unroll") for (int r = 0; r < 4; ++r) if (ps[cbi][r]) candw[r * IX_CAP + sl[cbi][r]] = pk[cbi][r]; \
            IXT_END(2); } } while (0)
#define IX_THRESH() do { _Pragma("unroll") for (int r = 0; r < 4; ++r) { tf[r] = tauf[rb * 16 + 4 * fq + r]; tq[r] = tau[rb * 16 + 4 * fq + r]; } } while (0)
#define IX_CHECK(cp, t) do { const unsigned E_ = misc[2 + ((t) & 1)]; \
            if ((cp) || E_ != 0u) { _Pragma("unroll 1") for (int rr = 0; rr < 4; ++rr) { const int row = wave * 4 + rr; const int n_ = (int)cnt[row]; \
                    if (n_ > ((cp) ? 256 : 512)) ix_select(cand + row * IX_CAP, hist, cnt + row, tau + row, tauf + row, n_, tau[row], false, lane); } \
                __syncthreads(); IX_THRESH(); } \
            if (wave == 0) { const unsigned cv = (lane < 32) ? cnt[lane] : 0u; const unsigned long long over = __ballot(cv > 640u); if (lane == 0) misc[2 + (((t) + 1) & 1)] = (over != 0ull) ? 1u : 0u; } } while (0)
        LAS unsigned* cntw = cnt + rb * 16 + 4 * fq; LAS unsigned* candw = cand + (rb * 16 + 4 * fq) * IX_CAP;
        float tf[4]; unsigned tq[4]; IX_THRESH();
        u32x4 RA[2], RB[2];
        IX_GLOAD(RA, 0); IX_GLOAD(RB, 1);
        IX_SWRITE(RA, 0); IX_GLOAD(RA, 2);
        __syncthreads();
#define IX_CP(done) (((done) == 4 || (done) == 8 || (done) == 16 || (done) == 32 || (done) == 64) && (done) < nsteps)
#pragma unroll 1
        for (int t0 = 0; t0 < nsteps; t0 += 2) {
            IX_SWRITE(RB, 1); IX_GLOAD(RB, t0 + 3);
            IX_COMPUTE(0, t0);
            __syncthreads();
            { IXT_BEGIN(1); const bool cp = IX_CP(t0 + 1); IX_CHECK(cp, t0); IXT_END(1); }
            IX_SWRITE(RA, 0); IX_GLOAD(RA, t0 + 4);
            if (t0 + 1 < nsteps) IX_COMPUTE(1, t0 + 1);
            __syncthreads();
            { IXT_BEGIN(1); const bool cp = IX_CP(t0 + 2); IX_CHECK(cp, t0 + 1); IXT_END(1); }
        }
        IXT_BEGIN(3);
#pragma unroll 1
        for (int rr = 0; rr < 4; ++rr) { const int row = wave * 4 + rr;
            int n = (int)cnt[row]; if (n > 256) { ix_select(cand + row * IX_CAP, hist, cnt + row, tau + row, tauf + row, n, tau[row], true, lane); n = (int)cnt[row]; if (n > 256) n = 256; }
            unsigned short* sp = SEL + (size_t)(qrow0 + row) * 256;
#pragma unroll
            for (int i = 0; i < 4; ++i) { const int k = lane + 64 * i; if (k < n) sp[k] = (unsigned short)(16383u - (cand[row * IX_CAP + k] & 16383u)); } }
        IXT_END(3);
        __syncthreads();
#undef IX_GLOAD
#undef IX_SWRITE
#undef IX_COMPUTE
#undef IX_THRESH
#undef IX_CP
#undef IX_CHECK
    }
#ifdef IXT
    if (VARIANT == 0 && tid == 0) *(LAS unsigned long long*)(lds + LDS_BYTES - 8) = ixt_acc;
#endif
}

constexpr int AT_BIAS_OFF = 131072;
constexpr int AT_T5_OFF = AT_BIAS_OFF + 2048;
constexpr int AT_SEL_OFF = AT_T5_OFF + 512 + 64;
static_assert(AT_SEL_OFF + 4096 <= LDS_BYTES, "attention LDS");
__device__ __forceinline__ void unpack8(const u32x4 w, float (&f)[8]) { f[0] = lo_f(w.x); f[1] = hi_f(w.x); f[2] = lo_f(w.y); f[3] = hi_f(w.y); f[4] = lo_f(w.z); f[5] = hi_f(w.z); f[6] = lo_f(w.w); f[7] = hi_f(w.w); }
__device__ __forceinline__ float oct_add(float x) {
    x += __builtin_bit_cast(float, __builtin_amdgcn_update_dpp(0, __builtin_bit_cast(int, x), 0xB1, 0xF, 0xF, true));
    x += __builtin_bit_cast(float, __builtin_amdgcn_update_dpp(0, __builtin_bit_cast(int, x), 0x4E, 0xF, 0xF, true));
    x += __builtin_bit_cast(float, __builtin_amdgcn_update_dpp(0, __builtin_bit_cast(int, x), 0x141, 0xF, 0xF, true));
    return x;
}
__device__ __forceinline__ void unpack8_fp8(const u32x2 w, float (&f)[8]) {
    const f32x2v a0 = __builtin_amdgcn_cvt_pk_f32_fp8((int)w.x, false), a1 = __builtin_amdgcn_cvt_pk_f32_fp8((int)w.x, true), b0 = __builtin_amdgcn_cvt_pk_f32_fp8((int)w.y, false), b1 = __builtin_amdgcn_cvt_pk_f32_fp8((int)w.y, true);
    f[0] = a0.x; f[1] = a0.y; f[2] = a1.x; f[3] = a1.y; f[4] = b0.x; f[5] = b0.y; f[6] = b1.x; f[7] = b1.y;
}
__device__ __forceinline__ unsigned xb_xcc_id();
__device__ __forceinline__ unsigned xb_ld(unsigned* p);
constexpr int AT_BK_OFF = AT_SEL_OFF + 4096;
constexpr int AT_PIMG = 32 * 272;
static_assert(AT_PIMG + 16 * 272 <= 16384, "attention images");
static_assert(AT_BK_OFF + 2048 <= LDS_BYTES - 256, "attention LDS");
typedef long i64_t;
__device__ __forceinline__ void phase_attn(const Params& p, LAS unsigned char* lds, int tid, int wave, int lane) {
    unsigned char* ws = p.ws;
    bf16* QO = (bf16*)(ws + WS_Q); const unsigned char* KA = ws + WS_KALL; const unsigned char* VA = ws + WS_VALL;
    const unsigned short* SEL = (const unsigned short*)(ws + WS_SEL);
    LAS float* bias = (LAS float*)(lds + AT_BIAS_OFF); LAS int* t5 = (LAS int*)(lds + AT_T5_OFF);
    LAS float* L = (LAS float*)lds + wave * 4096; LAS unsigned short* S = (LAS unsigned short*)(lds + AT_SEL_OFF) + wave * 256;
    LAS unsigned char* BK = lds + AT_BK_OFF + wave * 256;
    bias[tid] = p.in[7][tid];
    if (tid < 128) { const int n = tid; int v; if (n < 8) v = n; else { int k2 = 0; while (k2 < 12 && n * n >= (64 << (k2 + 1))) ++k2; v = 8 + k2; if (v > 15) v = 15; } t5[n] = v; }
    __syncthreads();
    const int half = lane >> 5, l32 = lane & 31, j = l32 >> 3, sub = l32 & 7, d0 = 8 * sub;
    const int fr = lane & 15, fq = lane >> 4;
    const int G = gridDim.x;
    if (tid == 0) { unsigned* ctl = (unsigned*)(ws + WS_CTL); const unsigned x = xb_xcc_id(); bool even = (G == 256);
        for (int jx = 0; jx < 8; ++jx) even = even && (xb_ld(ctl + CW_BAR + 256 + 64 * jx) == 32u);
        const unsigned t = even ? __hip_atomic_fetch_add(ctl + CW_ATT + 64 * (x & 7u), 1u, __ATOMIC_RELAXED, __HIP_MEMORY_SCOPE_AGENT) : 0u;
        t5[128 + 0] = even ? 1 : 0; t5[128 + 1] = (int)(x & 7u); t5[128 + 2] = (int)t; }
    __syncthreads();
    const bool xcd_order = t5[128] != 0;
    const int xl = t5[129], lw = t5[130] * 8 + wave;
    const int niter = xcd_order ? 17 : (MT + G * 8 - 1) / (G * 8);
    auto qr_at = [&](int itq) -> int {
        if (xcd_order) { return itq < 8 ? 2048 * xl + itq * 256 + lw : itq < 16 ? SEQP + 2048 * (7 - xl) + (itq - 8) * 256 + lw : MP + xl * 128 + lw; }
        return itq * (G * 8) + blockIdx.x * 8 + wave; };
    int nq = niter;
    if (xcd_order) { if (lw >= 128) nq = 16; } else { while (nq > 0 && qr_at(nq - 1) >= MT) --nq; }
    u32x2 sw_n = {0u, 0u};
    const unsigned o_lo = (unsigned)(4 * j * 64 + d0) * 2u;
    const unsigned sel_lo = (unsigned)lane * 8u, q_lo = (unsigned)(fr * 64 + 16 * fq) * 2u;
    if (nq > 0) { const int q0_ = qr_at(0); sw_n = *(const u32x2*)((const unsigned char*)(SEL + (size_t)q0_ * 256) + sel_lo); }
#pragma unroll 1
    for (int itq = 0; itq < nq; ++itq) {
        const int qr = qr_at(itq);
        const u32x2 sw = sw_n;
        const unsigned char* qp_ = (const unsigned char*)(QO + (size_t)qr * 1024); const u32x4 w0 = *(const u32x4*)(qp_ + q_lo), w1 = *(const u32x4*)(qp_ + (q_lo + 16u));
        int krow0, pos, nsel;
        if (qr < MP) { const int b = qr >> 14, t = qr & 16383; krow0 = b * SEQP; pos = t; nsel = 64 * ((t >> 6) + 1); if (nsel > 256) nsel = 256; }
        else { const int rs = qr - MP, b = rs >> 5, t = rs & 31; krow0 = MP + b * SKEYS; pos = PAST + t; nsel = 256; }
        const int ntile = nsel >> 4;
        {
          int bw_ = 0; unsigned short id4[4];
#pragma unroll
          for (int i = 0; i < 4; ++i) { const int k = 4 * lane + i; const unsigned raw = ((i & 2) ? sw.y : sw.x) >> (16 * (i & 1)) & 0xffffu; const int idx = (k < nsel) ? (int)raw : 0; id4[i] = (unsigned short)idx;
              const int rel = idx - pos, n = rel < 0 ? -rel : rel; const int t5v = t5[n < 128 ? n : 127]; const int bk = (rel > 0 ? 16 : 0) + (n < 128 ? t5v : 15); bw_ |= bk << (8 * i); }
          u32x2 so; so.x = (unsigned)id4[0] | ((unsigned)id4[1] << 16); so.y = (unsigned)id4[2] | ((unsigned)id4[3] << 16);
          *(LAS u32x2*)(S + 4 * lane) = so; *(LAS int*)(BK + 4 * lane) = bw_; }
        i64_t bq[4][2];
        { float t0[8], t1[8]; unpack8(w0, t0); unpack8(w1, t1);
          const unsigned a0 = pk4_fp8(t0[0] * 0.125f, t0[1] * 0.125f, t0[2] * 0.125f, t0[3] * 0.125f), a1 = pk4_fp8(t0[4] * 0.125f, t0[5] * 0.125f, t0[6] * 0.125f, t0[7] * 0.125f);
          const unsigned c0 = pk4_fp8(t1[0] * 0.125f, t1[1] * 0.125f, t1[2] * 0.125f, t1[3] * 0.125f), c1 = pk4_fp8(t1[4] * 0.125f, t1[5] * 0.125f, t1[6] * 0.125f, t1[7] * 0.125f);
          const i64_t q0 = (i64_t)(((unsigned long long)a1 << 32) | a0), q1 = (i64_t)(((unsigned long long)c1 << 32) | c0);
#pragma unroll
          for (int m = 0; m < 4; ++m) { const bool mine = (fr >> 2) == m; bq[m][0] = mine ? q0 : (i64_t)0; bq[m][1] = mine ? q1 : (i64_t)0; } }
        WAVE_LDS_FENCE();
        const unsigned char* kbase = KA + (size_t)krow0 * 256; const unsigned char* vbase = VA + (size_t)krow0 * 256;
        u32x4 kA[2][4], kB[2][4];
#define AT_KISSUE(buf, tb) do { _Pragma("unroll") for (int u = 0; u < 2; ++u) { const unsigned idx = (unsigned)S[16 * (2 * (tb) + u) + fr]; \
            _Pragma("unroll") for (int m = 0; m < 4; ++m) buf[u][m] = *(const u32x4*)(kbase + (idx * 256u + (unsigned)(64 * m + 16 * fq))); } } while (0)
#define AT_KMMA(buf, tb) do { _Pragma("unroll") for (int u = 0; u < 2; ++u) { f32x4 acc = {0.f, 0.f, 0.f, 0.f}; \
            _Pragma("unroll") for (int m = 0; m < 4; ++m) { const i64_t lo_ = (i64_t)(((unsigned long long)buf[u][m].y << 32) | buf[u][m].x), hi_ = (i64_t)(((unsigned long long)buf[u][m].w << 32) | buf[u][m].z); \
                acc = __builtin_amdgcn_mfma_f32_16x16x32_fp8_fp8(lo_, bq[m][0], acc, 0, 0, 0); acc = __builtin_amdgcn_mfma_f32_16x16x32_fp8_fp8(hi_, bq[m][1], acc, 0, 0, 0); } \
            _Pragma("unroll") for (int r = 0; r < 4; ++r) L[(16 * (2 * (tb) + u) + 4 * fq + r) * 16 + fr] = acc[r]; } } while (0)
        const int ntb = ntile >> 1;
        AT_KISSUE(kA, 0);
#pragma unroll 1
        for (int tb = 0; tb < ntb; tb += 2) {
            AT_KISSUE(kB, tb + 1);
            AT_KMMA(kA, tb);
            { const int tx = (tb + 2 < ntb) ? tb + 2 : ntb - 1; AT_KISSUE(kA, tx); }
            AT_KMMA(kB, tb + 1);
        }
        u32x2 bA[16], bB[16];
#define AT_ISSUE(buf, bi, base) do { _Pragma("unroll") for (int u = 0; u < 16; ++u) { const unsigned idx = (unsigned)S[2 * (16 * (bi) + u) + half]; buf[u] = *(const u32x2*)((base) + (idx * 256u + (unsigned)l32 * 8u)); } } while (0)
        AT_ISSUE(bA, 0, vbase);
        { const int qn = qr_at(itq + 1 < nq ? itq + 1 : itq);
          sw_n = *(const u32x2*)((const unsigned char*)(SEL + (size_t)qn * 256) + sel_lo); }
        WAVE_LDS_FENCE();
        { const int h = lane & 15, kq = lane >> 4; LAS float* lp = L + (kq * 64) * 16 + h; LAS unsigned char* bp = BK + kq * 64;
          float v[64]; float mx = -INFINITY;
          const bool ok = kq * 64 < nsel;
          u32x4 bw[4];
#pragma unroll
          for (int i = 0; i < 4; ++i) bw[i] = *(const LAS u32x4*)(bp + 16 * i);
#pragma unroll
          for (int c = 0; c < 4; ++c) { float bb[16], ll[16]; __builtin_amdgcn_sched_barrier(0);
#pragma unroll
              for (int k = 0; k < 16; ++k) ll[k] = lp[(16 * c + k) * 16];
#pragma unroll
              for (int k = 0; k < 16; ++k) { const unsigned w_ = bw[c][k >> 2]; const unsigned bk_ = (w_ >> (8 * (k & 3))) & 0xffu; bb[k] = bias[bk_ * 16 + h]; }
#pragma unroll
              for (int k = 0; k < 16; ++k) { asm volatile("" : "+v"(ll[k]), "+v"(bb[k])); v[16 * c + k] = ok ? ll[k] + bb[k] : -INFINITY; mx = fmaxf(mx, v[16 * c + k]); } }
          mx = fmaxf(mx, __shfl_xor(mx, 16)); mx = fmaxf(mx, __shfl_xor(mx, 32));
          float sm = 0.f;
#pragma unroll
          for (int k = 0; k < 64; ++k) { v[k] = __expf(v[k] - mx); sm += v[k]; }
          sm += __shfl_xor(sm, 16); sm += __shfl_xor(sm, 32);
          const float inv = 1.0f / sm;
          { const float sc_ = inv * 256.f; LAS unsigned char* pw = (LAS unsigned char*)L + AT_PIMG + h * 272 + kq * 64;
#pragma unroll
            for (int i = 0; i < 4; ++i) { u32x4 w_; w_.x = pk4_fp8(v[16 * i + 0] * sc_, v[16 * i + 1] * sc_, v[16 * i + 2] * sc_, v[16 * i + 3] * sc_); w_.y = pk4_fp8(v[16 * i + 4] * sc_, v[16 * i + 5] * sc_, v[16 * i + 6] * sc_, v[16 * i + 7] * sc_);
                w_.z = pk4_fp8(v[16 * i + 8] * sc_, v[16 * i + 9] * sc_, v[16 * i + 10] * sc_, v[16 * i + 11] * sc_); w_.w = pk4_fp8(v[16 * i + 12] * sc_, v[16 * i + 13] * sc_, v[16 * i + 14] * sc_, v[16 * i + 15] * sc_);
                *(LAS u32x4*)(pw + 16 * i) = w_; } } }
        WAVE_LDS_FENCE();
        const int nbat = (nsel + 31) >> 5;
        f32x4 oc[16];
#pragma unroll
        for (int c = 0; c < 16; ++c) oc[c] = f32x4{0.f, 0.f, 0.f, 0.f};
        LAS unsigned char* Vimg = (LAS unsigned char*)L;
        const unsigned vw_addr = (unsigned)(size_t)(Vimg + half * 272 + l32 * 8);
        const unsigned tr_addr = (unsigned)(size_t)(Vimg + (8 * fq + ((lane & 15) >> 1)) * 272 + 8 * (lane & 1));
        const unsigned pa_addr = (unsigned)(size_t)(Vimg + AT_PIMG + fr * 272 + 8 * fq);
#define AT_PV(buf, bi) do { _Pragma("unroll") for (int u = 0; u < 16; ++u) *(LAS u32x2*)(size_t)(vw_addr + (unsigned)(2 * u * 272)) = buf[u]; \
            const u32x2 pa2 = *(const LAS u32x2*)(size_t)(pa_addr + (unsigned)(32 * (bi))); const i64_t pa = (i64_t)(((unsigned long long)pa2.y << 32) | pa2.x); \
            u32x2 tt[16];     \
            asm volatile("ds_read_b64_tr_b8 %0, %16\n\tds_read_b64_tr_b8 %1, %16 offset:16\n\tds_read_b64_tr_b8 %2, %16 offset:32\n\tds_read_b64_tr_b8 %3, %16 offset:48\n\t" \
                         "ds_read_b64_tr_b8 %4, %16 offset:64\n\tds_read_b64_tr_b8 %5, %16 offset:80\n\tds_read_b64_tr_b8 %6, %16 offset:96\n\tds_read_b64_tr_b8 %7, %16 offset:112\n\t" \
                         "ds_read_b64_tr_b8 %8, %16 offset:128\n\tds_read_b64_tr_b8 %9, %16 offset:144\n\tds_read_b64_tr_b8 %10, %16 offset:160\n\tds_read_b64_tr_b8 %11, %16 offset:176\n\t" \
                         "ds_read_b64_tr_b8 %12, %16 offset:192\n\tds_read_b64_tr_b8 %13, %16 offset:208\n\tds_read_b64_tr_b8 %14, %16 offset:224\n\tds_read_b64_tr_b8 %15, %16 offset:240\n\ts_waitcnt lgkmcnt(0)" \
                : "=&v"(tt[0]), "=&v"(tt[1]), "=&v"(tt[2]), "=&v"(tt[3]), "=&v"(tt[4]), "=&v"(tt[5]), "=&v"(tt[6]), "=&v"(tt[7]), \
                  "=&v"(tt[8]), "=&v"(tt[9]), "=&v"(tt[10]), "=&v"(tt[11]), "=&v"(tt[12]), "=&v"(tt[13]), "=&v"(tt[14]), "=&v"(tt[15]) : "v"(tr_addr) : "memory"); \
            _Pragma("unroll") for (int c = 0; c < 16; ++c) oc[c] = __builtin_amdgcn_mfma_f32_16x16x32_fp8_fp8(pa, (i64_t)(((unsigned long long)tt[c].y << 32) | tt[c].x), oc[c], 0, 0, 0); } while (0)
#pragma unroll 1
        for (int bi = 0; bi < nbat; bi += 2) {
            AT_ISSUE(bB, bi + 1, vbase);
            AT_PV(bA, bi);
            { const int bx = (bi + 2 < nbat) ? bi + 2 : nbat - 1; AT_ISSUE(bA, bx, vbase); }
            AT_PV(bB, bi + 1);
        }
        { unsigned short* orow = (unsigned short*)((unsigned char*)(QO + (size_t)qr * 1024)) ;
#pragma unroll
          for (int cc = 0; cc < 4; ++cc) { const f32x4 sel_ = (fq == 0) ? oc[cc] : (fq == 1) ? oc[4 + cc] : (fq == 2) ? oc[8 + cc] : oc[12 + cc];
#pragma unroll
              for (int r = 0; r < 4; ++r) orow[(unsigned)((4 * fq + r) * 64 + 16 * cc + fr)] = f2bf(sel_[r] * 0.00390625f); } }
        WAVE_LDS_FENCE();
    }
#undef AT_KISSUE
#undef AT_KMMA
#undef AT_ISSUE
#undef AT_PV
}

template <bool TO_BF16>
__device__ __forceinline__ void phase_ln(const bf16* src, void* dst, const float* gam, const float* bet, int wave, int lane, const float* slab, int nslab, const float* resx, const bf16* resh) {
    const int gw = blockIdx.x * 8 + wave, NGW = gridDim.x * 8;
    f32x4 gv[4], bv[4];
#pragma unroll
    for (int jj = 0; jj < 4; ++jj) { gv[jj] = *(const f32x4*)(gam + lane * 4 + 256 * jj); bv[jj] = *(const f32x4*)(bet + lane * 4 + 256 * jj); }
#define LN_LOAD(V, r_) do { const int rr_ = (r_); if (rr_ < MP) { const bf16* xr = src + (size_t)rr_ * 1024 + lane * 4; \
            _Pragma("unroll") for (int jj = 0; jj < 4; ++jj) { const u32x2 w = *(const u32x2*)(xr + 256 * jj); V[jj][0] = lo_f(w.x); V[jj][1] = hi_f(w.x); V[jj][2] = lo_f(w.y); V[jj][3] = hi_f(w.y); } } \
        else if (rr_ < MT) {     \
            _Pragma("unroll") for (int jj = 0; jj < 4; ++jj) { const size_t o = (size_t)(rr_ - MP) * 1024 + lane * 4 + 256 * jj; \
                if (resx) V[jj] = *(const f32x4*)(resx + o) * ALPHA; \
                else { const u32x2 hv = *(const u32x2*)(resh + (size_t)rr_ * 1024 + lane * 4 + 256 * jj); V[jj][0] = lo_f(hv.x) * ALPHA; V[jj][1] = hi_f(hv.x) * ALPHA; V[jj][2] = lo_f(hv.y) * ALPHA; V[jj][3] = hi_f(hv.y) * ALPHA; } \
                for (int k = 0; k < nslab; ++k) V[jj] += *(const f32x4*)(slab + (size_t)k * MS * 1024 + o); } } } while (0)
    f32x4 vn[4];
    LN_LOAD(vn, gw);
#pragma unroll 1
    for (int r = gw; r < MT; r += NGW) {
        f32x4 v[4]; float s = 0.f;
#pragma unroll
        for (int jj = 0; jj < 4; ++jj) v[jj] = vn[jj];
        LN_LOAD(vn, r + NGW);
#pragma unroll
        for (int jj = 0; jj < 4; ++jj) s += (v[jj][0] + v[jj][1]) + (v[jj][2] + v[jj][3]);
        const float mean = wave_sum(s) * (1.0f / 1024.0f); float s2 = 0.f;
#pragma unroll
        for (int jj = 0; jj < 4; ++jj) { v[jj] = v[jj] - mean; s2 += (v[jj][0] * v[jj][0] + v[jj][1] * v[jj][1]) + (v[jj][2] * v[jj][2] + v[jj][3] * v[jj][3]); }
        const float rstd = rsqrtf(wave_sum(s2) * (1.0f / 1024.0f) + LN_EPS);
#pragma unroll
        for (int jj = 0; jj < 4; ++jj) { const f32x4 o = v[jj] * rstd * gv[jj] + bv[jj];
            if (TO_BF16) { u32x2 w; w.x = pk2(o[0], o[1]); w.y = pk2(o[2], o[3]); *(u32x2*)((bf16*)dst + (size_t)r * 1024 + lane * 4 + 256 * jj) = w; }
            else *(f32x4*)((float*)dst + (size_t)r * 1024 + lane * 4 + 256 * jj) = o; }
    }
#undef LN_LOAD
}

#define XB_TMO      128
#define XB_XCNT(j)  (256  + 64 * (j))
#define XB_XSUB(j)  (1280 + 64 * (j))
#define XB_XGEN(j)  (2304 + 64 * (j))
#define XB_TOP      3328
#define XB_TOPGEN   3392
#define XCD_BAR_WORDS 3456
#define XB_SPIN_CAP (1u << 18)

__device__ __forceinline__ unsigned xb_ld(unsigned* p)              { return __hip_atomic_load(p, __ATOMIC_RELAXED, __HIP_MEMORY_SCOPE_AGENT); }
__device__ __forceinline__ unsigned xb_add(unsigned* p, unsigned v) { return __hip_atomic_fetch_add(p, v, __ATOMIC_RELAXED, __HIP_MEMORY_SCOPE_AGENT); }
__device__ __forceinline__ unsigned xb_xcc_id() { return (unsigned)__builtin_amdgcn_s_getreg((3 << 11) | 20) & 0xFu; }
#define XB_SPIN(cond, bar) do { unsigned _sp = 0; while (cond) { __builtin_amdgcn_s_sleep(1); \
    if ((++_sp & 255u) == 0u) { if (xb_ld(&(bar)[XB_TMO])) break; if (_sp > XB_SPIN_CAP) { atomicAdd(&(bar)[XB_TMO], 1u); break; } } } } while (0)

struct XcdBarrier {
    unsigned* bar; unsigned x;
    volatile LAS unsigned* st;
};

__device__ __forceinline__ XcdBarrier xcd_barrier_post(unsigned* bar, volatile LAS unsigned* st) {
    XcdBarrier b; b.bar = bar; b.x = xb_xcc_id(); b.st = st;
    if (threadIdx.x == 0) (void)xb_add(&bar[XB_XCNT(b.x)], 1u);
    return b;
}
__device__ __forceinline__ void xcd_barrier_complete(unsigned* bar, unsigned x, unsigned& nloc, unsigned& nx) {
    const unsigned G = gridDim.x * gridDim.y * gridDim.z;
    unsigned sum, cnt, mine, sp = 0u;
    for (;;) {
        sum = 0u; cnt = 0u; mine = 0u;
#pragma unroll
        for (unsigned j = 0; j < 16; ++j) { const unsigned c = xb_ld(&bar[XB_XCNT(j)]); sum += c; cnt += (c > 0u) ? 1u : 0u; mine = (j == x) ? c : mine; }
        if (sum == G) break;
        __builtin_amdgcn_s_sleep(1);
        if ((++sp & 255u) == 0u) { if (xb_ld(&bar[XB_TMO])) break; if (sp > XB_SPIN_CAP) { atomicAdd(&bar[XB_TMO], 1u); break; } }
    }
    nloc = mine > 0u ? mine : 1u; nx = cnt > 0u ? cnt : 1u;
}

__device__ __forceinline__ void xcd_barrier(const XcdBarrier& b) {
    asm volatile("s_waitcnt vmcnt(0)" ::: "memory");
    __syncthreads();
    if (threadIdx.x == 0) {
        unsigned* bar = b.bar;
        __builtin_amdgcn_s_waitcnt(0);
        unsigned nloc = b.st[0], nx = b.st[1];
        if (nloc == 0u) { xcd_barrier_complete(bar, b.x, nloc, nx); b.st[0] = nloc; b.st[1] = nx; }
        const unsigned old = xb_add(&bar[XB_XSUB(b.x)], 1u);
        const unsigned gen = old / nloc;
        if (old + 1u == (gen + 1u) * nloc) {
            __builtin_amdgcn_fence(__ATOMIC_RELEASE, "agent");
            asm volatile("s_waitcnt vmcnt(0)" ::: "memory");
            const unsigned og = xb_add(&bar[XB_TOP], 1u);
            const unsigned tg = og / nx;
            if (og + 1u == (tg + 1u) * nx) xb_add(&bar[XB_TOPGEN], 1u);
            else XB_SPIN(xb_ld(&bar[XB_TOPGEN]) == tg, bar);
            __builtin_amdgcn_fence(__ATOMIC_ACQUIRE, "agent");
            xb_add(&bar[XB_XGEN(b.x)], 1u);
            asm volatile("s_waitcnt vmcnt(0)" ::: "memory");
        } else {
            XB_SPIN(xb_ld(&bar[XB_XGEN(b.x)]) == gen, bar);
            __builtin_amdgcn_fence(__ATOMIC_ACQUIRE, "agent");
            asm volatile("s_waitcnt vmcnt(0)" ::: "memory");
        }
    }
    __syncthreads();
}

__global__ void __launch_bounds__(512, 2) hybrid_fwd(Params p) {
    extern __shared__ __attribute__((aligned(16))) unsigned char lds_raw[];
    LAS unsigned char* lds = (LAS unsigned char*)lds_raw;
    cg::grid_group grid = cg::this_grid();
    const int tid = threadIdx.x, lane = tid & 63, wave = __builtin_amdgcn_readfirstlane(tid >> 6);
    unsigned char* ws = p.ws;
    if (tid < 2) ((volatile LAS unsigned*)(lds + LDS_BYTES - 32))[tid] = 0u;
    __syncthreads();
    const XcdBarrier xbar = xcd_barrier_post((unsigned*)(ws + WS_CTL) + CW_BAR, (volatile LAS unsigned*)(lds + LDS_BYTES - 32));
#ifdef PROBE_A
    LAS unsigned long long* tsl = (LAS unsigned long long*)(lds + LDS_BYTES - 256);
    int tsn = 0;
#define STAMP() do { if (blockIdx.x == 0 && tid == 0) tsl[tsn] = __builtin_amdgcn_s_memrealtime(); ++tsn; } while (0)
#else
#define STAMP() do {} while (0)
#endif
    STAMP();
#ifndef PHASE_MASK
#define PHASE_MASK 0x7fff
#endif
#define IN(k) (((PHASE_MASK >> (k)) & 1) && p.ph_lo <= (k) && (k) < p.ph_hi)
    if (IN(0)) phase_prologue(p, lds, tid, wave, lane);
    grid.sync(); STAMP();
    if (IN(1)) {
        pg8::Gemm g{(const bf16*)(ws + WS_XB), (const bf16*)(ws + WS_WIN), MT, NIN, 1024}; pg8::StaticOrder S; S.init(MT, NIN, gridDim.x, blockIdx.x);
        pg8::EpiInProj E{(bf16*)(ws + WS_Z), (bf16*)(ws + WS_XBC), (bf16*)(ws + WS_Q), ws + WS_KALL, ws + WS_VALL, (bf16*)(ws + WS_QI), (bf16*)p.out, (bf16*)(ws + WS_KIALL),
                         (float*)(ws + WS_DT), (float*)(ws + WS_WI), p.out, p.in[11]};
        pg8::gemm_phase<pg8::EpiInProj, pg8::StaticOrder, true, true>(lds, g, S, E);
    }
    xcd_barrier(xbar); STAMP();
#ifdef IX_DUMMY
    if (IN(2)) phase_indexer<IX_DUMMY>(p, lds, tid, wave, lane);
    xcd_barrier(xbar);
#endif
    if (IN(2)) phase_indexer<0>(p, lds, tid, wave, lane);
    xcd_barrier(xbar); STAMP();
    if (IN(3)) phase_attn(p, lds, tid, wave, lane);
    xcd_barrier(xbar); STAMP();
    if (IN(4)) phase_conv(p, lds, tid);
    xcd_barrier(xbar); STAMP();
    if (IN(5)) phase_s1(p, wave, lane);
    xcd_barrier(xbar); STAMP();
    if (IN(6)) phase_s2(p, tid);
    xcd_barrier(xbar); STAMP();
    if (IN(7)) phase_s3(p, lds, wave, lane);
    xcd_barrier(xbar); STAMP();
    if (IN(8)) {
        pg8::Gemm g{(const bf16*)(ws + WS_Z), (const bf16*)(ws + WS_WSSD), MT, 1024, 2048}; pg8::SlicedOrder S; S.init(MP, MT, 1024, 2048, 256, gridDim.x, blockIdx.x);
        pg8::EpiMixA E{(const bf16*)p.out, (bf16*)(ws + WS_T), (float*)(ws + WS_R57)};
        pg8::gemm_phase<pg8::EpiMixA, pg8::SlicedOrder, true, true>(lds, g, S, E);
    }
    xcd_barrier(xbar); STAMP();
    if (IN(9)) {
        pg8::Gemm g{(const bf16*)(ws + WS_Q), (const bf16*)(ws + WS_WATT), MT, 1024, 1024}; pg8::SlicedOrder S; S.init(MP, MT, 1024, 1024, 256, gridDim.x, blockIdx.x);
        pg8::EpiMixB E{(const bf16*)p.out, (const bf16*)(ws + WS_T), (bf16*)(ws + WS_MIX), (float*)(ws + WS_R57) + (size_t)8 * MS * 1024};
        pg8::gemm_phase<pg8::EpiMixB, pg8::SlicedOrder, true, true>(lds, g, S, E);
    }
    xcd_barrier(xbar);
    if (IN(9)) {
        const float* SA = (const float*)(ws + WS_R57); const float* SB = SA + (size_t)8 * MS * 1024; const bf16* Gt = (const bf16*)p.out; bf16* MX = (bf16*)(ws + WS_MIX);
        for (int i = blockIdx.x * 512 + tid; i < MS * 256; i += gridDim.x * 512) { const int r = i >> 8, c = (i & 255) * 4; const size_t o = (size_t)r * 1024 + c;
            f32x4 a = *(const f32x4*)(SA + o), b = *(const f32x4*)(SB + o);
#pragma unroll
            for (int k = 1; k < 8; ++k) a += *(const f32x4*)(SA + (size_t)k * MS * 1024 + o);
#pragma unroll
            for (int k = 1; k < 4; ++k) b += *(const f32x4*)(SB + (size_t)k * MS * 1024 + o);
            const u32x2 g1 = *(const u32x2*)(Gt + (size_t)(MP + r) * 2048 + c), g2 = *(const u32x2*)(Gt + (size_t)(MP + r) * 2048 + 1024 + c);
            u32x2 w; w.x = pk2(a[0] * lo_f(g1.x) + b[0] * lo_f(g2.x), a[1] * hi_f(g1.x) + b[1] * hi_f(g2.x)); w.y = pk2(a[2] * lo_f(g1.y) + b[2] * lo_f(g2.y), a[3] * hi_f(g1.y) + b[3] * hi_f(g2.y));
            *(u32x2*)(MX + (size_t)(MP + r) * 1024 + c) = w; }
    }
    xcd_barrier(xbar); STAMP();
    if (IN(10)) {
        pg8::Gemm g{(const bf16*)(ws + WS_MIX), (const bf16*)(ws + WS_WOUT), MT, 1024, 1024}; pg8::SlicedOrder S; S.init(MP, MT, 1024, 1024, 256, gridDim.x, blockIdx.x);
        pg8::EpiResX E{p.in[0], p.in[1], (bf16*)(ws + WS_PRE1), (float*)(ws + WS_Z)};
        pg8::gemm_phase<pg8::EpiResX, pg8::SlicedOrder, true, true>(lds, g, S, E);
    }
    xcd_barrier(xbar); STAMP();
    if (IN(11)) phase_ln<true>((const bf16*)(ws + WS_PRE1), (void*)(ws + WS_H1), p.in[18], p.in[19], wave, lane, (const float*)(ws + WS_Z), 4, p.in[1], nullptr);
    xcd_barrier(xbar); STAMP();
    if (IN(12)) {
        pg8::Gemm g{(const bf16*)(ws + WS_H1), (const bf16*)(ws + WS_WUP), MT, 4096, 1024}; pg8::StaticOrder S; S.init(MT, 4096, gridDim.x, blockIdx.x);
        pg8::EpiSqRelu E{(bf16*)(ws + WS_HID)};
        pg8::gemm_phase<pg8::EpiSqRelu, pg8::StaticOrder, true, true>(lds, g, S, E);
    }
    xcd_barrier(xbar); STAMP();
    if (IN(13)) {
        pg8::Gemm g{(const bf16*)(ws + WS_HID), (const bf16*)(ws + WS_WDN), MT, 1024, 4096}; pg8::SlicedOrder S; S.init(MP, MT, 1024, 4096, 256, gridDim.x, blockIdx.x);
        pg8::EpiResH E{(const bf16*)(ws + WS_H1), (bf16*)(ws + WS_Q), (float*)(ws + WS_Z)};
        pg8::gemm_phase<pg8::EpiResH, pg8::SlicedOrder, true, true>(lds, g, S, E);
    }
    xcd_barrier(xbar); STAMP();
    if (IN(14)) phase_ln<false>((const bf16*)(ws + WS_Q), (void*)p.out, p.in[22], p.in[23], wave, lane, (const float*)(ws + WS_Z), 16, nullptr, (const bf16*)(ws + WS_H1));
    STAMP();
#ifdef IXT
    if (blockIdx.x == 0 && tid == 0) { const unsigned long long d = *(LAS unsigned long long*)(lds + LDS_BYTES - 8), t0 = __builtin_amdgcn_s_memrealtime();
        while (__builtin_amdgcn_s_memrealtime() - t0 < d) __builtin_amdgcn_s_sleep(8); }
#endif
#ifdef PROBE_A
    if (blockIdx.x == 0 && tid == 0) { const unsigned long long d = (tsl[PROBE_B] - tsl[PROBE_A]) * PROBE_MULT, t0 = __builtin_amdgcn_s_memrealtime();
        while (__builtin_amdgcn_s_memrealtime() - t0 < d) __builtin_amdgcn_s_sleep(8); }
#endif
#undef IN
}

extern "C" void kernel_launch(void* const* d_in, const int* in_sizes, int n_in, void* d_out, int out_size, void* d_ws, size_t ws_size, hipStream_t stream) {
    static int grid = 0;
    if (grid == 0) {
        int dev = 0, cus = 0, per_cu = 0;
        if (n_in != 24 || out_size != OUT_TOTAL || ws_size < WS_END) { fprintf(stderr, "kernel_launch: unexpected shapes (n_in %d out %d ws %zu, need %zu)\n", n_in, out_size, ws_size, (size_t)WS_END); grid = -1; return; }
        (void)hipGetDevice(&dev);
        (void)hipDeviceGetAttribute(&cus, hipDeviceAttributeMultiprocessorCount, dev);
        (void)hipFuncSetAttribute((const void*)hybrid_fwd, hipFuncAttributeMaxDynamicSharedMemorySize, LDS_BYTES);
        (void)hipOccupancyMaxActiveBlocksPerMultiprocessor(&per_cu, (const void*)hybrid_fwd, 512, LDS_BYTES);
        if (per_cu < 1) { fprintf(stderr, "kernel_launch: occupancy query says %d blocks per CU\n", per_cu); grid = -1; return; }
        grid = cus;
    }
    if (grid < 0) return;
    (void)hipMemsetAsync(d_ws, 0, 65536, stream);
    Params p{};
    for (int i = 0; i < 24; ++i) p.in[i] = (const float*)d_in[i];
    p.out = (float*)d_out; p.ws = (unsigned char*)d_ws; p.ph_lo = 0; p.ph_hi = 100;
    void* args[] = {&p};
    hipError_t e = hipLaunchCooperativeKernel((const void*)hybrid_fwd, dim3(grid), dim3(512), args, LDS_BYTES, stream);
    if (e != hipSuccess) fprintf(stderr, "cooperative launch failed: %s (grid %d)\n", hipGetErrorString(e), grid);
}
```

```cpp
#include <hip/hip_runtime.h>
#include <hip/hip_cooperative_groups.h>
#include <cstdint>
#include <cstdio>
#include <cmath>
namespace cg = cooperative_groups;

constexpr int MP = 32768, MS = 1024, MT = MP + MS;
constexpr int DM = 1024, NIN = 9472;
constexpr int SEQP = 16384, PAST = 4096, SKEYS = 4128;
constexpr int NQC = 544;
constexpr int KROWS = MP + 32 * SKEYS;
constexpr float ALPHA = 1.189207115002721f;
constexpr float LN_EPS = 1e-5f, RMS_EPS = 1e-5f;

constexpr int OUT_YP = 0, OUT_YS = 33554432, OUT_KP = 34603008, OUT_VP = 42991616, OUT_KIP = 51380224, OUT_SSMP = 53477376,
              OUT_CONVP = 54001664, OUT_KS = 54020096, OUT_VS = 54282240, OUT_KIS = 54544384, OUT_SSMS = 54609920, OUT_CONVS = 62998528,
              OUT_TOTAL = 63293440;

constexpr size_t WS_CTL = 0;
constexpr size_t WS_WIN = 1048576;
constexpr size_t WS_WSSD = WS_WIN + (size_t)NIN * 1024 * 2;
constexpr size_t WS_WATT = WS_WSSD + 4194304;
constexpr size_t WS_WOUT = WS_WATT + 2097152;
constexpr size_t WS_WUP = WS_WOUT + 2097152;
constexpr size_t WS_WDN = WS_WUP + 8388608;
constexpr size_t WS_Q = WS_WDN + 8388608;
constexpr size_t WS_Z = WS_Q + (size_t)MT * 2048;
constexpr size_t WS_DT = WS_Z + (size_t)MT * 4096;
constexpr size_t WS_WI = WS_DT + (size_t)MT * 128;
constexpr size_t WS_R46 = WS_WI + (size_t)MT * 32;
constexpr size_t SZ_R46 = 258998272;
constexpr size_t WS_R57 = WS_R46 + SZ_R46;
constexpr size_t SZ_R57 = 285212672;
constexpr size_t WS_END = WS_R57 + SZ_R57;
constexpr size_t WS_KALL = WS_R46;
constexpr size_t WS_VALL = WS_KALL + (size_t)KROWS * 256;
constexpr size_t WS_KIALL = WS_VALL + (size_t)KROWS * 256;
constexpr size_t WS_QI = WS_KIALL + (size_t)KROWS * 128;
constexpr size_t WS_SEL = WS_QI + (size_t)MT * 1024;
static_assert(WS_SEL + (size_t)MT * 512 <= WS_R46 + SZ_R46, "region A life 1");
constexpr size_t WS_XT = WS_R46;
constexpr size_t WS_BN = WS_XT + (size_t)NQC * 64 * 2048 * 2;
constexpr size_t WS_BT = WS_BN + (size_t)NQC * 64 * 512 * 2;
constexpr size_t WS_CN = WS_BT + (size_t)NQC * 64 * 512 * 2;
constexpr size_t WS_ACUM = WS_CN + (size_t)NQC * 64 * 512 * 2;
constexpr size_t WS_DTS = WS_ACUM + (size_t)NQC * 32 * 64 * 4;
static_assert(WS_DTS + (size_t)NQC * 32 * 64 * 4 <= WS_R46 + SZ_R46, "region A life 2");
constexpr size_t WS_T = WS_R46;
constexpr size_t WS_MIX = WS_T + (size_t)MT * 4096;
constexpr size_t WS_H1 = WS_R46;
static_assert(WS_MIX + (size_t)MT * 2048 <= WS_R46 + SZ_R46, "region A life 3");
constexpr size_t WS_XB = WS_R57;
constexpr size_t WS_XBC = WS_XB + (size_t)MT * 2048;
static_assert(WS_XBC + (size_t)MT * 6144 <= WS_R57 + SZ_R57, "region B life 1");
constexpr size_t WS_STATES = WS_R57;
static_assert((size_t)NQC * 32 * 64 * 128 * 2 <= SZ_R57, "region B life 2");
constexpr size_t WS_PRE1 = WS_R57;
constexpr size_t WS_HID = WS_R57;
static_assert((size_t)MT * 8192 <= SZ_R57, "region B life 3");
constexpr int CW_QUEUE = 64, CW_ATT = 1024, CW_BAR = 4096;

constexpr int LDS_BYTES = 159744;
#define LAS __attribute__((address_space(3)))

typedef unsigned short bf16;
typedef unsigned u32x4 __attribute__((ext_vector_type(4)));
typedef unsigned u32x2 __attribute__((ext_vector_type(2)));
typedef float f32x16 __attribute__((ext_vector_type(16)));
typedef float f32x2v __attribute__((ext_vector_type(2)));
typedef __bf16 bf16x2_t __attribute__((ext_vector_type(2)));

__device__ __forceinline__ float bf2f(unsigned h) { return __uint_as_float(h << 16); }
__device__ __forceinline__ unsigned pk2(float lo, float hi) { f32x2v v = {lo, hi}; bf16x2_t b = __builtin_convertvector(v, bf16x2_t); return __builtin_bit_cast(unsigned, b); }
__device__ __forceinline__ unsigned short f2bf(float f) { return (unsigned short)(pk2(f, 0.f) & 0xffffu); }
__device__ __forceinline__ float lo_f(unsigned w) { return __uint_as_float(w << 16); }
__device__ __forceinline__ float hi_f(unsigned w) { return __uint_as_float(w & 0xffff0000u); }
__device__ __forceinline__ unsigned pk4_fp8(float a, float b, float c, float d) { int w = 0; w = __builtin_amdgcn_cvt_pk_fp8_f32(a, b, w, false); w = __builtin_amdgcn_cvt_pk_fp8_f32(c, d, w, true); return (unsigned)w; }
__device__ __forceinline__ float sigmoidf_(float x) { return 1.0f / (1.0f + __expf(-x)); }
__device__ __forceinline__ float siluf_(float x) { return x / (1.0f + __expf(-x)); }
__device__ __forceinline__ float softplusf_(float x) { return x > 20.f ? x : log1pf(__expf(x)); }
namespace pg8 {
#define PG8_LAS __attribute__((address_space(3)))
typedef unsigned short bf16_t;
typedef short bf16x8 __attribute__((ext_vector_type(8)));
typedef float f32x4 __attribute__((ext_vector_type(4)));
typedef unsigned u32x4 __attribute__((ext_vector_type(4)));
constexpr int BM = 256, BK = 64, HALF = 128, HTB = HALF * BK * 2  , STAGE_BYTES = 8 * HTB, NXCD = 8, WGM = 8;

__host__ __device__ __forceinline__ int lds_byte(int r, int c) { const int st = (r >> 4) * 2 + (c >> 5), rr = r & 15, cc = c & 31, ob = rr * 64 + cc * 2; return st * 1024 + (ob ^ (((ob >> 9) & 1) << 5)); }
__host__ __device__ __forceinline__ void stage_rc(int b, int& R, int& C) { const int st = b / 1024, sb = b % 1024, swz = sb ^ (((sb >> 9) & 1) << 5); R = (st >> 1) * 16 + swz / 64; C = (st & 1) * 32 + (swz % 64) / 2; }
__host__ __device__ __forceinline__ int perm32(int rho) { const int n = rho >> 4, i = rho & 15; return 8 * (i >> 2) + 4 * n + (i & 3); }

struct Unit { int pm, pn, kofs, nt; };
struct Gemm { const bf16_t* A; const bf16_t* Bt; int M, N, K; };

struct StaticOrder {
    int nM, nN, nwg, G, c;
    __host__ __device__ void init(int M, int N, int G_, int c_) { nM = M / BM; nN = N / BM; nwg = nM * nN; G = G_; c = c_; }
    __host__ __device__ bool next(int i, Unit& u) const {
        const long L = (long)i * G + c; if (L >= nwg) return false;
        int wgid = (int)L; { const int q = nwg / NXCD, r = nwg % NXCD, xcd = wgid % NXCD, off = wgid / NXCD; wgid = (xcd < r ? xcd * (q + 1) : r * (q + 1) + (xcd - r) * q) + off; }
        const int nig = WGM * nN, gid = wgid / nig, fm = gid * WGM, gsz = (nM - fm) < WGM ? (nM - fm) : WGM;
        u.pm = fm + ((wgid % nig) % gsz); u.pn = (wgid % nig) / gsz; u.kofs = 0; u.nt = 0; return true;
    }
    __device__ __forceinline__ void a_ready(const Unit&) const {}
    __device__ __forceinline__ void done(const Unit&) const {}
};
struct SlicedOrder {
    StaticOrder so; int npt, pm0, nN, nsl, slnt, ntot;
    __host__ __device__ void init(int Mp, int Mall, int N, int K, int SLK, int G_, int c_) { so.init(Mp, N, G_, c_); npt = so.nwg; pm0 = Mp / BM; nN = N / BM; nsl = K / SLK; slnt = SLK / BK; ntot = npt + ((Mall - Mp) / BM) * nN * nsl; }
    __host__ __device__ bool next(int i, Unit& u) const {
        const long L = (long)i * so.G + so.c; if (L >= ntot) return false;
        if (L < npt) return so.next(i, u);
        const int s = (int)L - npt, tile = s / nsl, sl = s - tile * nsl; u.pm = pm0 + tile / nN; u.pn = tile % nN; u.kofs = sl * slnt * BK; u.nt = slnt; return true;
    }
    __device__ __forceinline__ void a_ready(const Unit&) const {}
    __device__ __forceinline__ void done(const Unit&) const {}
};

__device__ __forceinline__ unsigned cvt_pk_bf16(float lo, float hi) { unsigned r; asm volatile("v_cvt_pk_bf16_f32 %0, %1, %2" : "=v"(r) : "v"(lo), "v"(hi)); return r; }
__device__ __forceinline__ u32x4 pack8(const f32x4 a, const f32x4 b) { u32x4 w; w.x = ::pk2(a[0], a[1]); w.y = ::pk2(a[2], a[3]); w.z = ::pk2(b[0], b[1]); w.w = ::pk2(b[2], b[3]); return w; }
#define EPI_LOOP8(...) _Pragma("unroll") for (int ai = 0; ai < 2; ++ai) _Pragma("unroll") for (int m = 0; m < 4; ++m) _Pragma("unroll") for (int bj = 0; bj < 2; ++bj) { \
    const int r = row0 + ai * HALF + m * 16, cl = cl0 + bj * HALF; const f32x4 a = acc[ai][bj][m][0], b = acc[ai][bj][m][1]; __VA_ARGS__ }
#define EPI_LOOP4(...) _Pragma("unroll") for (int ai = 0; ai < 2; ++ai) _Pragma("unroll") for (int m = 0; m < 4; ++m) _Pragma("unroll") for (int bj = 0; bj < 2; ++bj) _Pragma("unroll") for (int n = 0; n < 2; ++n) { \
    const int r = row0 + ai * HALF + m * 16, c = col0 + bj * HALF + n * 16; const f32x4 a = acc[ai][bj][m][n]; __VA_ARGS__ }

#define EPI_HALF8(ai, ...) _Pragma("unroll") for (int m = 0; m < 4; ++m) _Pragma("unroll") for (int bj = 0; bj < 2; ++bj) { \
    const int ix = m * 2 + bj, r = row0 + (ai) * HALF + m * 16, cl = cl0 + bj * HALF; const f32x4 a = acc[ai][bj][m][0], b = acc[ai][bj][m][1]; (void)ix; (void)a; (void)b; __VA_ARGS__ }
#define EPI_HALF4(ai, ...) _Pragma("unroll") for (int m = 0; m < 4; ++m) _Pragma("unroll") for (int bj = 0; bj < 2; ++bj) _Pragma("unroll") for (int n = 0; n < 2; ++n) { \
    const int ix = (m * 2 + bj) * 2 + n, r = row0 + (ai) * HALF + m * 16, c = col0 + bj * HALF + n * 16; const f32x4 a = acc[ai][bj][m][n]; (void)ix; (void)a; __VA_ARGS__ }

struct EpiInProj {
    static constexpr bool PERM = true, AFTER_DRAIN = false;
    bf16_t *Z, *XBC, *Q; unsigned char *KALL, *VALL; bf16_t *QI, *G, *KIALL; float *DT, *WI, *out; const float* dt_bias;
    __device__ __forceinline__ void operator()(const f32x4 (&acc)[2][2][4][2], const Unit& u, int wr, int wc, int fr, int fq) const {
        const int pn = u.pn, row0 = u.pm * BM + wr * 64 + fr, cl0 = wc * 32 + 8 * fq;
        if (pn < 8) { EPI_LOOP8( *(u32x4*)(Z + (size_t)r * 2048 + pn * 256 + cl) = pack8(a, b); ) }
        else if (pn < 20) { EPI_LOOP8( const int c = (pn - 8) * 256 + cl; *(u32x4*)(XBC + (size_t)r * 3072 + c) = pack8(a, b);
            int slot = -1;
            if (r < MP) { const int t = r & 16383; if (t >= 16381) slot = OUT_CONVP + ((r >> 14) * 3 + (t - 16381)) * 3072; }
            else { const int rs = r - MP, t = rs & 31; if (t >= 29) slot = OUT_CONVS + ((rs >> 5) * 3 + (t - 29)) * 3072; }
            if (slot >= 0) { *(f32x4*)(out + slot + c) = a; *(f32x4*)(out + slot + c + 4) = b; } ) }
        else if (pn < 24) { EPI_LOOP8( *(u32x4*)(Q + (size_t)r * 1024 + (pn - 20) * 256 + cl) = pack8(a, b); ) }
        else if (pn < 26) { unsigned char* KV = (pn == 24) ? KALL : VALL; const int op = (pn == 24) ? OUT_KP : OUT_VP, os = (pn == 24) ? OUT_KS : OUT_VS;
            EPI_LOOP8( int kr, o; if (r < MP) { kr = r; o = op + r * 256; } else { const int rs = r - MP; kr = MP + (rs >> 5) * SKEYS + PAST + (rs & 31); o = os + rs * 256; }
                { ::u32x2 w8; w8.x = ::pk4_fp8(a[0], a[1], a[2], a[3]); w8.y = ::pk4_fp8(b[0], b[1], b[2], b[3]); *(::u32x2*)(KV + (size_t)kr * 256 + cl) = w8; } *(f32x4*)(out + o + cl) = a; *(f32x4*)(out + o + cl + 4) = b; ) }
        else if (pn < 28) { EPI_LOOP8( *(u32x4*)(QI + (size_t)r * 512 + (pn - 26) * 256 + cl) = pack8(a, b); ) }
        else if (pn < 36) { EPI_LOOP8( f32x4 sa, sb;
            _Pragma("unroll") for (int e = 0; e < 4; ++e) { sa[e] = ::sigmoidf_(a[e]); sb[e] = ::sigmoidf_(b[e]); }
            *(u32x4*)(G + (size_t)r * 2048 + (pn - 28) * 256 + cl) = pack8(sa, sb); ) }
        else { EPI_LOOP8(
            if (cl < 32) { f32x4 sa, sb; const f32x4 ba = *(const f32x4*)(dt_bias + cl), bb = *(const f32x4*)(dt_bias + cl + 4);
                _Pragma("unroll") for (int e = 0; e < 4; ++e) { sa[e] = ::softplusf_(a[e] + ba[e]); sb[e] = ::softplusf_(b[e] + bb[e]); }
                *(f32x4*)(DT + (size_t)r * 32 + cl) = sa; *(f32x4*)(DT + (size_t)r * 32 + cl + 4) = sb; }
            else if (cl < 96) { int kr, o; if (r < MP) { kr = r; o = OUT_KIP + r * 64; } else { const int rs = r - MP; kr = MP + (rs >> 5) * SKEYS + PAST + (rs & 31); o = OUT_KIS + rs * 64; }
                *(u32x4*)(KIALL + (size_t)kr * 64 + (cl - 32)) = pack8(a, b); *(f32x4*)(out + o + (cl - 32)) = a; *(f32x4*)(out + o + (cl - 32) + 4) = b; }
            else if (cl < 104) { const float s = 0.04419417382415922f;
                *(f32x4*)(WI + (size_t)r * 8) = a * s; *(f32x4*)(WI + (size_t)r * 8 + 4) = b * s; } ) }
    }
};
struct EpiMixA {
    static constexpr bool PERM = true, AFTER_DRAIN = false;
    const bf16_t* G; bf16_t* T; float* SLAB;
    __device__ __forceinline__ void operator()(const f32x4 (&acc)[2][2][4][2], const Unit& u, int wr, int wc, int fr, int fq) const {
        const int row0 = u.pm * BM + wr * 64 + fr, cl0 = u.pn * BM + wc * 32 + 8 * fq;
        if (u.nt != 0) { float* sl = SLAB + (size_t)(u.kofs / (u.nt * BK)) * MS * 1024; EPI_LOOP8( float* t = sl + (size_t)(r - MP) * 1024 + cl; *(f32x4*)t = a; *(f32x4*)(t + 4) = b; ) return; }
        _Pragma("unroll") for (int ai = 0; ai < 2; ++ai) { u32x4 gq[8];
          EPI_HALF8(ai, gq[ix] = *(const u32x4*)(G + (size_t)r * 2048 + cl); )
          EPI_HALF8(ai, const u32x4 g = gq[ix];
            f32x4 o0, o1; o0[0] = a[0] * ::lo_f(g.x); o0[1] = a[1] * ::hi_f(g.x); o0[2] = a[2] * ::lo_f(g.y); o0[3] = a[3] * ::hi_f(g.y);
            o1[0] = b[0] * ::lo_f(g.z); o1[1] = b[1] * ::hi_f(g.z); o1[2] = b[2] * ::lo_f(g.w); o1[3] = b[3] * ::hi_f(g.w);
            *(u32x4*)(T + (size_t)r * 1024 + cl) = pack8(o0, o1); ) }
    }
};
struct EpiMixB {
    static constexpr bool PERM = true, AFTER_DRAIN = false;
    const bf16_t* G; const bf16_t* T; bf16_t* MIX; float* SLAB;
    __device__ __forceinline__ void operator()(const f32x4 (&acc)[2][2][4][2], const Unit& u, int wr, int wc, int fr, int fq) const {
        const int row0 = u.pm * BM + wr * 64 + fr, cl0 = u.pn * BM + wc * 32 + 8 * fq;
        if (u.nt != 0) { float* sl = SLAB + (size_t)(u.kofs / (u.nt * BK)) * MS * 1024; EPI_LOOP8( float* t = sl + (size_t)(r - MP) * 1024 + cl; *(f32x4*)t = a; *(f32x4*)(t + 4) = b; ) return; }
        _Pragma("unroll") for (int ai = 0; ai < 2; ++ai) { u32x4 gq[8], tq[8];
          EPI_HALF8(ai, gq[ix] = *(const u32x4*)(G + (size_t)r * 2048 + 1024 + cl); tq[ix] = *(const u32x4*)(T + (size_t)r * 1024 + cl); )
          EPI_HALF8(ai, const u32x4 g = gq[ix], t = tq[ix];
            f32x4 o0, o1; o0[0] = ::lo_f(t.x) + a[0] * ::lo_f(g.x); o0[1] = ::hi_f(t.x) + a[1] * ::hi_f(g.x); o0[2] = ::lo_f(t.y) + a[2] * ::lo_f(g.y); o0[3] = ::hi_f(t.y) + a[3] * ::hi_f(g.y);
            o1[0] = ::lo_f(t.z) + b[0] * ::lo_f(g.z); o1[1] = ::hi_f(t.z) + b[1] * ::hi_f(g.z); o1[2] = ::lo_f(t.w) + b[2] * ::lo_f(g.w); o1[3] = ::hi_f(t.w) + b[3] * ::hi_f(g.w);
            *(u32x4*)(MIX + (size_t)r * 1024 + cl) = pack8(o0, o1); ) }
    }
};
struct EpiResX {
    static constexpr bool PERM = false, AFTER_DRAIN = false;
    const float *xp, *xs; bf16_t* PRE; float* SLAB;
    __device__ __forceinline__ void operator()(const f32x4 (&acc)[2][2][4][2], const Unit& u, int wr, int wc, int fr, int fq) const {
        const int row0 = u.pm * BM + wr * 64 + fr, col0 = u.pn * BM + wc * 32 + 4 * fq;
        if (u.nt != 0) { float* sl = SLAB + (size_t)(u.kofs / (u.nt * BK)) * MS * 1024; EPI_LOOP4( *(f32x4*)(sl + (size_t)(r - MP) * 1024 + c) = a; ) return; }
        _Pragma("unroll") for (int ai = 0; ai < 2; ++ai) { f32x4 xq[16];
          EPI_HALF4(ai, const float* xr = (r < MP) ? xp + (size_t)r * 1024 : xs + (size_t)(r - MP) * 1024; xq[ix] = *(const f32x4*)(xr + c); )
          EPI_HALF4(ai, const f32x4 o = xq[ix] * ALPHA + a; ::u32x2 w; w.x = ::pk2(o[0], o[1]); w.y = ::pk2(o[2], o[3]); *(::u32x2*)(PRE + (size_t)r * 1024 + c) = w; ) }
    }
};
struct EpiSqRelu {
    static constexpr bool PERM = true, AFTER_DRAIN = false;
    bf16_t* H;
    __device__ __forceinline__ void operator()(const f32x4 (&acc)[2][2][4][2], const Unit& u, int wr, int wc, int fr, int fq) const {
        const int row0 = u.pm * BM + wr * 64 + fr, cl0 = u.pn * BM + wc * 32 + 8 * fq;
        EPI_LOOP8( f32x4 sa, sb;
            _Pragma("unroll") for (int e = 0; e < 4; ++e) { const float x0 = fmaxf(a[e], 0.f), x1 = fmaxf(b[e], 0.f); sa[e] = x0 * x0; sb[e] = x1 * x1; }
            *(u32x4*)(H + (size_t)r * 4096 + cl) = pack8(sa, sb); )
    }
};
struct EpiResH {
    static constexpr bool PERM = false, AFTER_DRAIN = false;
    const bf16_t* H1; bf16_t* PRE; float* SLAB;
    __device__ __forceinline__ void operator()(const f32x4 (&acc)[2][2][4][2], const Unit& u, int wr, int wc, int fr, int fq) const {
        const int row0 = u.pm * BM + wr * 64 + fr, col0 = u.pn * BM + wc * 32 + 4 * fq;
        if (u.nt != 0) { float* sl = SLAB + (size_t)(u.kofs / (u.nt * BK)) * MS * 1024; EPI_LOOP4( *(f32x4*)(sl + (size_t)(r - MP) * 1024 + c) = a; ) return; }
        _Pragma("unroll") for (int ai = 0; ai < 2; ++ai) { ::u32x2 hq[16];
          EPI_HALF4(ai, hq[ix] = *(const ::u32x2*)(H1 + (size_t)r * 1024 + c); )
          EPI_HALF4(ai, const ::u32x2 hv = hq[ix];
            f32x4 o; o[0] = ::lo_f(hv.x) * ALPHA + a[0]; o[1] = ::hi_f(hv.x) * ALPHA + a[1]; o[2] = ::lo_f(hv.y) * ALPHA + a[2]; o[3] = ::hi_f(hv.y) * ALPHA + a[3];
            ::u32x2 w; w.x = ::pk2(o[0], o[1]); w.y = ::pk2(o[2], o[3]); *(::u32x2*)(PRE + (size_t)r * 1024 + c) = w; ) }
    }
};
template <class Epi, class Sched, bool ALIGN_EPI = false, bool SP2 = false>
__device__ __forceinline__ void gemm_phase(PG8_LAS unsigned char* lds, const Gemm g, const Sched& S, const Epi& E) {
    const int tid = threadIdx.x, wid = __builtin_amdgcn_readfirstlane(tid >> 6), lane = tid & 63, wr = wid >> 2, wc = wid & 3, fr = lane & 15, fq = lane >> 4;
    const int K = g.K, nt = K / BK;
    unsigned voffA[2], voffB[2];
#pragma unroll
    for (int i = 0; i < 2; ++i) { int R, C; stage_rc(tid * 16 + i * 8192, R, C); const int Rb = Epi::PERM ? ((R & ~31) + perm32(R & 31)) : R;
        voffA[i] = (unsigned)(R * K + C) * 2u; voffB[i] = (unsigned)(Rb * K + C) * 2u; }
    const size_t kstep = (size_t)(BK * 2);
    const size_t hstep = (size_t)HALF * K * 2;
    const size_t tstep = 2 * hstep;
    const unsigned ldsw = (unsigned)wid * 1024u;
    const int aoff = lds_byte(wr * 64 + fr, fq * 8), boff = lds_byte(wc * 32 + fr, fq * 8);
#define PG8_SA(b, h) (((b) * 2 + (h)) * HTB)
#define PG8_SB(b, h) ((4 + (b) * 2 + (h)) * HTB)
#define PG8_STAGE(bufoff, gbase, voff) do { _Pragma("unroll") for (int _i = 0; _i < 2; ++_i) \
        __builtin_amdgcn_global_load_lds((const unsigned*)((const char*)(gbase) + (voff)[_i]), (PG8_LAS unsigned*)(lds + (bufoff) + ldsw + _i * 8192), 16, 0, 0); } while (0)
#define PG8_LDA(dst, b, h) do { _Pragma("unroll") for (int m = 0; m < 4; ++m) _Pragma("unroll") for (int k = 0; k < 2; ++k) dst[m][k] = *(const PG8_LAS bf16x8*)(lds + PG8_SA(b, h) + aoff + m * 2048 + k * 1024); } while (0)
#define PG8_LDB(dst, b, h) do { _Pragma("unroll") for (int n = 0; n < 2; ++n) _Pragma("unroll") for (int k = 0; k < 2; ++k) dst[n][k] = *(const PG8_LAS bf16x8*)(lds + PG8_SB(b, h) + boff + n * 2048 + k * 1024); } while (0)
#define PG8_MMA(ai, bj, At, Bt) do { __builtin_amdgcn_s_setprio(1); _Pragma("unroll") for (int m = 0; m < 4; ++m) _Pragma("unroll") for (int n = 0; n < 2; ++n) _Pragma("unroll") for (int k = 0; k < 2; ++k) \
        acc[ai][bj][m][n] = __builtin_amdgcn_mfma_f32_16x16x32_bf16(Bt[n][k], At[m][k], acc[ai][bj][m][n], 0, 0, 0); __builtin_amdgcn_s_setprio(0); } while (0)
#define PG8_WAIT_V(n) asm volatile("s_waitcnt vmcnt(" #n ")" ::: "memory")
#define PG8_WAIT_L(n) asm volatile("s_waitcnt lgkmcnt(" #n ")" ::: "memory")
#define PG8_BAR __builtin_amdgcn_s_barrier()
#define PG8_SCHED __builtin_amdgcn_sched_barrier(0)
    Unit cur, nxt; int ui = 0;
    if (!S.next(0, cur)) return;
    f32x4 acc[2][2][4][2];
#pragma unroll
    for (int a = 0; a < 2; ++a)
#pragma unroll
        for (int b = 0; b < 2; ++b)
#pragma unroll
            for (int m = 0; m < 4; ++m)
#pragma unroll
                for (int n = 0; n < 2; ++n) acc[a][b][m][n] = (f32x4){0.f, 0.f, 0.f, 0.f};
    bf16x8 At[4][2], B0[2][2], B1[2][2];
    const char* cA = (const char*)g.A + (size_t)cur.pm * tstep + (size_t)cur.kofs * 2; const char* cB = (const char*)g.Bt + (size_t)cur.pn * tstep + (size_t)cur.kofs * 2;
    S.a_ready(cur);
    if constexpr (SP2) {
        PG8_STAGE(PG8_SB(0, 0), cB, voffB); PG8_STAGE(PG8_SB(0, 1), cB + hstep, voffB); PG8_STAGE(PG8_SA(0, 0), cA, voffA); PG8_STAGE(PG8_SA(0, 1), cA + hstep, voffA);
        if (wr == 1) PG8_BAR;
        PG8_WAIT_V(2); PG8_BAR;
        PG8_STAGE(PG8_SB(1, 0), cB + kstep, voffB); PG8_STAGE(PG8_SA(1, 0), cA + kstep, voffA); PG8_STAGE(PG8_SB(1, 1), cB + hstep + kstep, voffB);
        PG8_WAIT_V(6); PG8_BAR;
    } else {
        PG8_STAGE(PG8_SB(0, 0), cB, voffB); PG8_STAGE(PG8_SA(0, 0), cA, voffA); PG8_STAGE(PG8_SB(0, 1), cB + hstep, voffB); PG8_STAGE(PG8_SA(0, 1), cA + hstep, voffA);
        if (wr == 1) PG8_BAR;
        PG8_WAIT_V(4); PG8_BAR;
        PG8_STAGE(PG8_SB(1, 0), cB + kstep, voffB); PG8_STAGE(PG8_SA(1, 0), cA + kstep, voffA); PG8_STAGE(PG8_SB(1, 1), cB + hstep + kstep, voffB);
        PG8_WAIT_V(6); PG8_BAR;
    }
    for (;;) {
        const bool has_next = S.next(ui + 1, nxt);
        const char* nA = has_next ? (const char*)g.A + (size_t)nxt.pm * tstep + (size_t)nxt.kofs * 2 : cA; const char* nB = has_next ? (const char*)g.Bt + (size_t)nxt.pn * tstep + (size_t)nxt.kofs * 2 : cB;
        const int unt = cur.nt ? cur.nt : nt;
        for (int t = 0; t < unt; t += 2) {
            const bool last = (t == unt - 2);
            const char* a1 = cA + (size_t)(t + 1) * kstep;
            const char* a2 = last ? nA : cA + (size_t)(t + 2) * kstep; const char* b2 = last ? nB : cB + (size_t)(t + 2) * kstep;
            const char* a3 = a2 + kstep; const char* b3 = b2 + kstep;
            if (last && has_next) S.a_ready(nxt);
            if constexpr (SP2) {
            PG8_LDB(B0, 0, 0); PG8_LDB(B1, 0, 1); PG8_SCHED; PG8_LDA(At, 0, 0); PG8_STAGE(PG8_SA(1, 1), a1 + hstep, voffA);
            PG8_WAIT_V(8); PG8_WAIT_L(0); PG8_BAR; PG8_MMA(0, 0, At, B0); PG8_MMA(0, 1, At, B1); PG8_BAR; PG8_SCHED;
            PG8_LDA(At, 0, 1); PG8_STAGE(PG8_SB(0, 0), b2, voffB); PG8_STAGE(PG8_SB(0, 1), b2 + hstep, voffB); PG8_STAGE(PG8_SA(0, 0), a2, voffA);
            PG8_WAIT_V(8); PG8_WAIT_L(0); PG8_BAR; PG8_MMA(1, 0, At, B0); PG8_MMA(1, 1, At, B1); PG8_BAR; PG8_SCHED;
            PG8_LDB(B0, 1, 0); PG8_LDB(B1, 1, 1); PG8_SCHED; PG8_LDA(At, 1, 0); PG8_STAGE(PG8_SA(0, 1), a2 + hstep, voffA);
            PG8_WAIT_V(8); PG8_WAIT_L(0); PG8_BAR; PG8_MMA(0, 0, At, B0); PG8_MMA(0, 1, At, B1); PG8_BAR; PG8_SCHED;
            PG8_LDA(At, 1, 1); PG8_STAGE(PG8_SB(1, 0), b3, voffB); PG8_STAGE(PG8_SB(1, 1), b3 + hstep, voffB); PG8_STAGE(PG8_SA(1, 0), a3, voffA);
            PG8_WAIT_V(8); PG8_WAIT_L(0); PG8_BAR; PG8_MMA(1, 0, At, B0); PG8_MMA(1, 1, At, B1); PG8_BAR; PG8_SCHED;
            } else {
            PG8_LDB(B0, 0, 0); PG8_SCHED; PG8_LDA(At, 0, 0); PG8_STAGE(PG8_SA(1, 1), a1 + hstep, voffA);
            PG8_WAIT_L(8); PG8_BAR; PG8_WAIT_L(0); PG8_MMA(0, 0, At, B0); PG8_BAR; PG8_SCHED;
            PG8_LDB(B1, 0, 1); PG8_STAGE(PG8_SB(0, 0), b2, voffB);
            PG8_BAR; PG8_WAIT_L(0); PG8_MMA(0, 1, At, B1); PG8_BAR;
            PG8_LDA(At, 0, 1); PG8_STAGE(PG8_SA(0, 0), a2, voffA);
            PG8_BAR; PG8_WAIT_L(0); PG8_MMA(1, 0, At, B0); PG8_BAR; PG8_SCHED;
            PG8_STAGE(PG8_SB(0, 1), b2 + hstep, voffB);
            PG8_WAIT_V(6); PG8_BAR; PG8_MMA(1, 1, At, B1); PG8_BAR;
            PG8_LDB(B0, 1, 0); PG8_SCHED; PG8_LDA(At, 1, 0); PG8_STAGE(PG8_SA(0, 1), a2 + hstep, voffA);
            PG8_WAIT_L(8); PG8_BAR; PG8_WAIT_L(0); PG8_MMA(0, 0, At, B0); PG8_BAR; PG8_SCHED;
            PG8_LDB(B1, 1, 1); PG8_STAGE(PG8_SB(1, 0), b3, voffB);
            PG8_BAR; PG8_WAIT_L(0); PG8_MMA(0, 1, At, B1); PG8_BAR;
            PG8_LDA(At, 1, 1); PG8_STAGE(PG8_SA(1, 0), a3, voffA);
            PG8_BAR; PG8_WAIT_L(0); PG8_MMA(1, 0, At, B0); PG8_BAR; PG8_SCHED;
            PG8_STAGE(PG8_SB(1, 1), b3 + hstep, voffB);
            PG8_WAIT_V(6); PG8_BAR; PG8_MMA(1, 1, At, B1); PG8_BAR;
            }
        }
        if constexpr (ALIGN_EPI) { if (wr == 0) PG8_BAR; }
        if constexpr (!Epi::AFTER_DRAIN) { E(acc, cur, wr, wc, fr, fq); S.done(cur); }
        if (!has_next) break;
#pragma unroll
        for (int a = 0; a < 2; ++a)
#pragma unroll
            for (int b = 0; b < 2; ++b)
#pragma unroll
                for (int m = 0; m < 4; ++m)
#pragma unroll
                    for (int n = 0; n < 2; ++n) acc[a][b][m][n] = (f32x4){0.f, 0.f, 0.f, 0.f};
        cur = nxt; cA = nA; cB = nB; ++ui;
        if constexpr (ALIGN_EPI) { if (wr == 1) PG8_BAR; }
    }
    PG8_WAIT_V(0);
    if constexpr (!ALIGN_EPI) { if (wr == 0) PG8_BAR; }
    PG8_BAR;
    if constexpr (Epi::AFTER_DRAIN) { E.fused(acc, cur, wr, wc, fr, fq, lds, wid, lane); S.done(cur); }
#undef PG8_SA
#undef PG8_SB
#undef PG8_STAGE
#undef PG8_LDA
#undef PG8_LDB
#undef PG8_MMA
#undef PG8_WAIT_V
#undef PG8_WAIT_L
#undef PG8_BAR
#undef PG8_SCHED
}
}
using pg8::bf16x8;
using pg8::f32x4;
#define MFMA32(a, b, c) __builtin_amdgcn_mfma_f32_32x32x16_bf16((a), (b), (c), 0, 0, 0)
#define MFMA16(a, b, c) __builtin_amdgcn_mfma_f32_16x16x32_bf16((a), (b), (c), 0, 0, 0)
#define LDS_WAIT() asm volatile("s_waitcnt lgkmcnt(0)" ::: "memory")

struct Params {
    const float* in[24];
    float* out;
    unsigned char* ws;
    int ph_lo, ph_hi;
};

__device__ __forceinline__ bf16x8 ldg8(const bf16* p) { return *(const bf16x8*)p; }
__device__ __forceinline__ float wave_sum(float v) {
#pragma unroll
    for (int o = 1; o < 64; o <<= 1) v += __shfl_xor(v, o);
    return v;
}

__device__ __forceinline__ int win_src_col(int n) {
    if (n < 5120) return n;
    if (n < 7168) return n + 32;
    if (n < 9216) return n + 104;
    if (n < 9248) return n - 4096;
    if (n < 9320) return n - 2048;
    return -1;
}
template <bool REMAP>
__device__ __forceinline__ void transpose_item(const float* W, int K, int Nsrc, bf16* WT, LAS float* scr, int kb, int nb, int lane) {
    const int k0 = 64 * kb, n0 = 32 * nb;
    int sc = n0 + (lane & 31); if (REMAP) sc = win_src_col(sc);
#pragma unroll 8
    for (int i = 0; i < 32; ++i) { const int kk = 2 * i + (lane >> 5); scr[kk * 33 + (lane & 31)] = (sc >= 0) ? W[(size_t)(k0 + kk) * Nsrc + sc] : 0.f; }
    LDS_WAIT(); asm volatile("" ::: "memory");
    const int c = lane & 7;
#pragma unroll
    for (int j = 0; j < 4; ++j) { const int n = (lane >> 3) + 8 * j; const LAS float* s = scr + (8 * c) * 33 + n;
        u32x4 o; o.x = pk2(s[0 * 33], s[1 * 33]); o.y = pk2(s[2 * 33], s[3 * 33]); o.z = pk2(s[4 * 33], s[5 * 33]); o.w = pk2(s[6 * 33], s[7 * 33]);
        *(u32x4*)(WT + (size_t)(n0 + n) * K + k0 + 8 * c) = o; }
    LDS_WAIT(); asm volatile("" ::: "memory");
}
__device__ __forceinline__ void cvt8(const float* src, bf16* dst) {
    const f32x4 a = *(const f32x4*)src, b = *(const f32x4*)(src + 4);
    u32x4 o; o.x = pk2(a[0], a[1]); o.y = pk2(a[2], a[3]); o.z = pk2(b[0], b[1]); o.w = pk2(b[2], b[3]);
    *(u32x4*)dst = o;
}
__device__ __forceinline__ void phase_prologue(const Params& p, LAS unsigned char* lds, int tid, int wave, int lane) {
    unsigned char* ws = p.ws;
    LAS float* scr = (LAS float*)(lds + wave * 16384);
    const int gw = blockIdx.x * 8 + wave, NGW = gridDim.x * 8;
    constexpr int I_IN = 16 * 296, I_SSD = 32 * 32, I_ATT = 16 * 32, I_OUT = 16 * 32, I_UP = 16 * 128, I_DN = 64 * 32;
    constexpr int NITEMS = I_IN + I_SSD + I_ATT + I_OUT + I_UP + I_DN;
    for (int it = gw; it < NITEMS; it += NGW) {
        int r = it;
        if (r < I_IN) { transpose_item<true>(p.in[8], 1024, 9320, (bf16*)(ws + WS_WIN), scr, r / 296, r % 296, lane); continue; } r -= I_IN;
        if (r < I_SSD) { transpose_item<false>(p.in[15], 2048, 1024, (bf16*)(ws + WS_WSSD), scr, r / 32, r % 32, lane); continue; } r -= I_SSD;
        if (r < I_ATT) { transpose_item<false>(p.in[16], 1024, 1024, (bf16*)(ws + WS_WATT), scr, r / 32, r % 32, lane); continue; } r -= I_ATT;
        if (r < I_OUT) { transpose_item<false>(p.in[17], 1024, 1024, (bf16*)(ws + WS_WOUT), scr, r / 32, r % 32, lane); continue; } r -= I_OUT;
        if (r < I_UP) { transpose_item<false>(p.in[20], 1024, 4096, (bf16*)(ws + WS_WUP), scr, r / 128, r % 128, lane); continue; } r -= I_UP;
        transpose_item<false>(p.in[21], 4096, 1024, (bf16*)(ws + WS_WDN), scr, r / 32, r % 32, lane);
    }
    const size_t gt = (size_t)blockIdx.x * 512 + tid, NT = (size_t)gridDim.x * 512;
    { bf16* XB = (bf16*)(ws + WS_XB);
      for (size_t i = gt; i < (size_t)MT * 128; i += NT) { const size_t e = i * 8; const float* s = (e < (size_t)MP * 1024) ? p.in[0] + e : p.in[1] + (e - (size_t)MP * 1024); cvt8(s, XB + e); } }
}

__device__ __forceinline__ void phase_cache_cvt(const Params& p, LAS unsigned char* lds, int tid) {
    unsigned char* ws = p.ws;
    unsigned* queue = (unsigned*)(ws + WS_CTL) + CW_QUEUE + 256;
    LAS unsigned* slot = (LAS unsigned*)lds;
    unsigned char* KA = ws + WS_KALL; unsigned char* VA = ws + WS_VALL; bf16* KI = (bf16*)(ws + WS_KIALL);
    constexpr unsigned NC1 = (32u * PAST * 16u) / 4096u, NC2 = (32u * PAST * 8u) / 4096u;
    __syncthreads();
#pragma unroll 1
    for (;;) {
        if (tid == 0) slot[0] = __hip_atomic_fetch_add(queue, 1u, __ATOMIC_RELAXED, __HIP_MEMORY_SCOPE_AGENT);
        __syncthreads();
        const unsigned ch = slot[0];
        __syncthreads();
        if (ch >= NC1 + NC2) break;
        if (ch < NC1) {
#pragma unroll 2
            for (int k = 0; k < 8; ++k) { const size_t i = (size_t)ch * 4096 + k * 512 + tid; const size_t row = i >> 4, c16 = (i & 15) * 16; const size_t b = row >> 12, pos = row & 4095;
                const size_t dr = (size_t)MP + b * SKEYS + pos;
                { const float* s = p.in[2] + row * 256 + c16; const f32x4 a = *(const f32x4*)s, b4 = *(const f32x4*)(s + 4), c = *(const f32x4*)(s + 8), d = *(const f32x4*)(s + 12);
                  u32x4 o; o.x = pk4_fp8(a[0], a[1], a[2], a[3]); o.y = pk4_fp8(b4[0], b4[1], b4[2], b4[3]); o.z = pk4_fp8(c[0], c[1], c[2], c[3]); o.w = pk4_fp8(d[0], d[1], d[2], d[3]); *(u32x4*)(KA + dr * 256 + c16) = o; }
                { const float* s = p.in[3] + row * 256 + c16; const f32x4 a = *(const f32x4*)s, b4 = *(const f32x4*)(s + 4), c = *(const f32x4*)(s + 8), d = *(const f32x4*)(s + 12);
                  u32x4 o; o.x = pk4_fp8(a[0], a[1], a[2], a[3]); o.y = pk4_fp8(b4[0], b4[1], b4[2], b4[3]); o.z = pk4_fp8(c[0], c[1], c[2], c[3]); o.w = pk4_fp8(d[0], d[1], d[2], d[3]); *(u32x4*)(VA + dr * 256 + c16) = o; } }
        } else {
#pragma unroll 2
            for (int k = 0; k < 8; ++k) { const size_t i = (size_t)(ch - NC1) * 4096 + k * 512 + tid; const size_t row = i >> 3, c8 = (i & 7) * 8; const size_t b = row >> 12, pos = row & 4095;
                const size_t dr = (size_t)MP + b * SKEYS + pos; cvt8(p.in[4] + row * 64 + c8, KI + dr * 64 + c8); }
        }
    }
}

constexpr int CV_ROW = 2064;
static_assert(64 * CV_ROW <= LDS_BYTES - 256, "conv LDS");
__device__ __forceinline__ void phase_conv(const Params& p, LAS unsigned char* lds, int tid) {
    unsigned char* ws = p.ws;
    const bf16* XBC = (const bf16*)(ws + WS_XBC); const float* DT = (const float*)(ws + WS_DT);
    bf16* XT = (bf16*)(ws + WS_XT); bf16* BN = (bf16*)(ws + WS_BN); bf16* BT = (bf16*)(ws + WS_BT); bf16* CN = (bf16*)(ws + WS_CN);
    float* ACUM = (float*)(ws + WS_ACUM); float* DTS = (float*)(ws + WS_DTS);
    const float* conv_w = p.in[9]; const float* conv_b = p.in[10]; const float* a_log = p.in[12]; const float* state_conv = p.in[6];
    for (int it = blockIdx.x; it < NQC * 3; it += gridDim.x) {
        const int q = it / 3, j = it - 3 * q;
        const bool samp = q >= 512; const int b = samp ? q - 512 : (q >> 8), c = samp ? 0 : (q & 255);
        const int row0 = samp ? MP + b * 32 : q * 64, nvalid = samp ? 32 : 64;
        if (j == 0) {
            const int ln_ = tid & 63, wv_ = tid >> 6; const int rr_ = (ln_ < nvalid) ? ln_ : 0;
            float dvv[4];
#pragma unroll
            for (int k = 0; k < 4; ++k) dvv[k] = DT[(size_t)(row0 + rr_) * 32 + wv_ * 4 + k];
#pragma unroll
            for (int k = 0; k < 4; ++k) { const int h = wv_ * 4 + k; const float A = -__expf(a_log[h]); const float dv = (ln_ < nvalid) ? dvv[k] : 0.f;
                float x = dv * A;
                x += __builtin_bit_cast(float, __builtin_amdgcn_update_dpp(0, __builtin_bit_cast(int, x), 0x111, 0xF, 0xF, true));
                x += __builtin_bit_cast(float, __builtin_amdgcn_update_dpp(0, __builtin_bit_cast(int, x), 0x112, 0xF, 0xF, true));
                x += __builtin_bit_cast(float, __builtin_amdgcn_update_dpp(0, __builtin_bit_cast(int, x), 0x114, 0xF, 0xF, true));
                x += __builtin_bit_cast(float, __builtin_amdgcn_update_dpp(0, __builtin_bit_cast(int, x), 0x118, 0xF, 0xF, true));
                const float T0 = __builtin_bit_cast(float, __builtin_amdgcn_readlane(__builtin_bit_cast(int, x), 15)), T1 = __builtin_bit_cast(float, __builtin_amdgcn_readlane(__builtin_bit_cast(int, x), 31)),
                            T2 = __builtin_bit_cast(float, __builtin_amdgcn_readlane(__builtin_bit_cast(int, x), 47));
                const int row_ = ln_ >> 4; x += (row_ == 1 ? T0 : row_ == 2 ? T0 + T1 : row_ == 3 ? (T0 + T1) + T2 : 0.f);
                ACUM[(q * 32 + h) * 64 + ln_] = x; DTS[(q * 32 + h) * 64 + ln_] = dv; } }
        {
            const int ch = 2 * (tid + 512 * j);
            float w0[4], w1[4];
#pragma unroll
            for (int i = 0; i < 4; ++i) { w0[i] = conv_w[i * 3072 + ch]; w1[i] = conv_w[i * 3072 + ch + 1]; }
            const float bias0 = conv_b[ch], bias1 = conv_b[ch + 1];
            float h0[3], h1[3];
            if (samp) {
#pragma unroll
                for (int k = 0; k < 3; ++k) { h0[k] = state_conv[(size_t)(b * 3 + k) * 3072 + ch]; h1[k] = state_conv[(size_t)(b * 3 + k) * 3072 + ch + 1]; }
            } else if (c == 0) {
#pragma unroll
                for (int k = 0; k < 3; ++k) { h0[k] = 0.f; h1[k] = 0.f; }
            } else {
#pragma unroll
                for (int k = 0; k < 3; ++k) { const unsigned w = *(const unsigned*)(XBC + (size_t)(row0 - 3 + k) * 3072 + ch); h0[k] = lo_f(w); h1[k] = hi_f(w); }
            }
            unsigned rawall[64];
#pragma unroll
            for (int i = 0; i < 64; ++i) rawall[i] = (i < nvalid) ? *(const unsigned*)(XBC + (size_t)(row0 + i) * 3072 + ch) : 0u;
#pragma unroll
            for (int s0 = 0; s0 < 64; s0 += 8) {
                unsigned raw[8];
#pragma unroll
                for (int i = 0; i < 8; ++i) raw[i] = rawall[s0 + i];
                float o0[8], o1[8];
#pragma unroll
                for (int i = 0; i < 8; ++i) {
                    const float c0 = lo_f(raw[i]), c1 = hi_f(raw[i]);
                    const float v0 = bias0 + w0[0] * h0[0] + w0[1] * h0[1] + w0[2] * h0[2] + w0[3] * c0;
                    const float v1 = bias1 + w1[0] * h1[0] + w1[1] * h1[1] + w1[2] * h1[2] + w1[3] * c1;
                    const bool ok = (s0 + i) < nvalid;
                    o0[i] = ok ? siluf_(v0) : 0.f; o1[i] = ok ? siluf_(v1) : 0.f;
                    h0[0] = h0[1]; h0[1] = h0[2]; h0[2] = c0; h1[0] = h1[1]; h1[1] = h1[2]; h1[2] = c1;
                }
                u32x4 t0, t1;
                t0.x = pk2(o0[0], o0[1]); t0.y = pk2(o0[2], o0[3]); t0.z = pk2(o0[4], o0[5]); t0.w = pk2(o0[6], o0[7]);
                t1.x = pk2(o1[0], o1[1]); t1.y = pk2(o1[2], o1[3]); t1.z = pk2(o1[4], o1[5]); t1.w = pk2(o1[6], o1[7]);
                if (ch < 2048) {
                    const int h = ch >> 6, pp = ch & 63;
                    bf16* xp_ = XT + (size_t)(q * 32 + h) * 4096 + ((s0 >> 3) * 64 + pp) * 8; *(u32x4*)xp_ = t0; *(u32x4*)(xp_ + 8) = t1;
                } else if (ch < 2560) {
                    const int g = (ch - 2048) >> 7, n = (ch - 2048) & 127;
                    bf16* bp_ = BT + (size_t)(q * 4 + g) * 8192 + ((s0 >> 3) * 128 + n) * 8; *(u32x4*)bp_ = t0; *(u32x4*)(bp_ + 8) = t1;
#pragma unroll
                    for (int i = 0; i < 8; ++i) *(LAS unsigned*)(lds + (s0 + i) * CV_ROW + (ch - 2048) * 2) = pk2(o0[i], o1[i]);
                } else {
                    const int g = (ch - 2560) >> 7, n = (ch - 2560) & 127;
#pragma unroll
                    for (int i = 0; i < 8; ++i) *(LAS unsigned*)(lds + (s0 + i) * CV_ROW + (ch - 2048) * 2) = pk2(o0[i], o1[i]);
                }
            }
        }
        if (j == 2) {
            __syncthreads();
            const int wv_ = tid >> 6, ln_ = tid & 63;
#pragma unroll 4
            for (int oc = 0; oc < 16; ++oc) { const int octet = wv_ * 16 + oc; const u32x4 v = *(const LAS u32x4*)(lds + ln_ * CV_ROW + octet * 16);
                bf16* dst = ((octet < 64) ? BN : CN) + (size_t)(q * 4 + ((octet & 63) >> 4)) * 8192 + ((octet & 15) * 64 + ln_) * 8; *(u32x4*)dst = v; }
            __syncthreads();
        }
    }
}

__device__ __forceinline__ bf16x8 scale8(bf16x8 v, const float (&w)[8]) {
    const u32x4 u = __builtin_bit_cast(u32x4, v); u32x4 o;
    o.x = pk2(lo_f(u.x) * w[0], hi_f(u.x) * w[1]); o.y = pk2(lo_f(u.y) * w[2], hi_f(u.y) * w[3]);
    o.z = pk2(lo_f(u.z) * w[4], hi_f(u.z) * w[5]); o.w = pk2(lo_f(u.w) * w[6], hi_f(u.w) * w[7]);
    return __builtin_bit_cast(bf16x8, o);
}
__device__ __forceinline__ void phase_s1(const Params& p, int wave, int lane) {
    unsigned char* ws = p.ws;
    const bf16* XT = (const bf16*)(ws + WS_XT); const bf16* BT = (const bf16*)(ws + WS_BT);
    const float* ACUM = (const float*)(ws + WS_ACUM); const float* DTS = (const float*)(ws + WS_DTS);
    bf16* ST = (bf16*)(ws + WS_STATES);
    const int gw = blockIdx.x * 8 + wave, NGW = gridDim.x * 8, l32 = lane & 31, hh = lane >> 5;
#pragma unroll 1
    for (int it = gw; it < NQC * 32; it += NGW) {
        const int q = it >> 5, h = it & 31, g = h >> 3;
        const float* ac = ACUM + (q * 32 + h) * 64 + 8 * hh; const float* dts = DTS + (q * 32 + h) * 64 + 8 * hh;
        f32x4 av[4][2], dv[4][2]; bf16x8 af[2][4], bfr[4][4];
#pragma unroll
        for (int kk = 0; kk < 4; ++kk) { av[kk][0] = *(const f32x4*)(ac + 16 * kk); av[kk][1] = *(const f32x4*)(ac + 16 * kk + 4); dv[kk][0] = *(const f32x4*)(dts + 16 * kk); dv[kk][1] = *(const f32x4*)(dts + 16 * kk + 4); }
        const float alast = ACUM[(q * 32 + h) * 64 + 63];
#pragma unroll
        for (int pb = 0; pb < 2; ++pb)
#pragma unroll
            for (int kk = 0; kk < 4; ++kk) af[pb][kk] = ldg8(XT + (size_t)(q * 32 + h) * 4096 + ((2 * kk + hh) * 64 + pb * 32 + l32) * 8);
        float w[4][8];
#pragma unroll
        for (int kk = 0; kk < 4; ++kk)
#pragma unroll
            for (int e = 0; e < 4; ++e) { w[kk][e] = __expf(alast - av[kk][0][e]) * dv[kk][0][e]; w[kk][4 + e] = __expf(alast - av[kk][1][e]) * dv[kk][1][e]; }
        asm volatile("" ::: "memory");
#pragma unroll
        for (int nb = 0; nb < 4; ++nb)
#pragma unroll
            for (int kk = 0; kk < 4; ++kk) bfr[nb][kk] = ldg8(BT + (size_t)(q * 4 + g) * 8192 + ((2 * kk + hh) * 128 + nb * 32 + l32) * 8);
#pragma unroll
        for (int pb = 0; pb < 2; ++pb) {
            f32x16 acc[4];
#pragma unroll
            for (int n = 0; n < 4; ++n)
#pragma unroll
                for (int e = 0; e < 16; ++e) acc[n][e] = 0.f;
#pragma unroll
            for (int kk = 0; kk < 4; ++kk) { const bf16x8 a = scale8(af[pb][kk], w[kk]);
#pragma unroll
                for (int nb = 0; nb < 4; ++nb) acc[nb] = MFMA32(bfr[nb][kk], a, acc[nb]); }
            bf16* sp = ST + (size_t)(q * 32 + h) * 8192 + (pb * 32 + l32) * 8 + 4 * hh;
#pragma unroll
            for (int nb = 0; nb < 4; ++nb)
#pragma unroll
                for (int e4 = 0; e4 < 4; ++e4) { u32x2 o; o.x = pk2(acc[nb][4 * e4], acc[nb][4 * e4 + 1]); o.y = pk2(acc[nb][4 * e4 + 2], acc[nb][4 * e4 + 3]); *(u32x2*)(sp + (nb * 4 + e4) * 512) = o; }
        }
    }
}

__device__ __forceinline__ void phase_s2(const Params& p, int tid) {
    unsigned char* ws = p.ws;
    bf16* ST = (bf16*)(ws + WS_STATES); const float* ACUM = (const float*)(ws + WS_ACUM);
    const size_t gt = (size_t)blockIdx.x * 512 + tid, NT = (size_t)gridDim.x * 512;
    for (size_t u = gt; u < 131072; u += NT) {
        const int b = (int)(u >> 16), e = (int)(u & 65535) * 4, h = e >> 13;
        f32x4 st = {0.f, 0.f, 0.f, 0.f};
#pragma unroll 1
        for (int c0 = 0; c0 < 256; c0 += 16) {
            u32x2 raw[16]; float dec[16];
#pragma unroll
            for (int i = 0; i < 16; ++i) { const int q = b * 256 + c0 + i; raw[i] = *(const u32x2*)(ST + (size_t)q * 262144 + e); dec[i] = ACUM[(q * 32 + h) * 64 + 63]; }
#pragma unroll
            for (int i = 0; i < 16; ++i) { const int q = b * 256 + c0 + i; u32x2 o; o.x = pk2(st[0], st[1]); o.y = pk2(st[2], st[3]); *(u32x2*)(ST + (size_t)q * 262144 + e) = o;
                const float d = __expf(dec[i]); st[0] = st[0] * d + lo_f(raw[i].x); st[1] = st[1] * d + hi_f(raw[i].x); st[2] = st[2] * d + lo_f(raw[i].y); st[3] = st[3] * d + hi_f(raw[i].y); }
        }
        { const int eh = e & 8191; *(f32x4*)(p.out + OUT_SSMP + (size_t)b * 262144 + (e - eh) + ((eh >> 3) & 63) * 128 + (eh >> 9) * 8 + (eh & 7)) = st; }
    }
    for (size_t u = gt; u < (size_t)32 * 65536; u += NT) {
        const int b = (int)(u >> 16), e = (int)(u & 65535) * 4, h = e >> 13, q = 512 + b;
        const int eh = e & 8191; const size_t nat = (size_t)b * 262144 + (e - eh) + ((eh >> 3) & 63) * 128 + (eh >> 9) * 8 + (eh & 7);
        const f32x4 h0 = *(const f32x4*)(p.in[5] + nat);
        const u32x2 raw = *(const u32x2*)(ST + (size_t)q * 262144 + e);
        const float d = __expf(ACUM[(q * 32 + h) * 64 + 63]);
        u32x2 o; o.x = pk2(h0[0], h0[1]); o.y = pk2(h0[2], h0[3]); *(u32x2*)(ST + (size_t)q * 262144 + e) = o;
        f32x4 r; r[0] = h0[0] * d + lo_f(raw.x); r[1] = h0[1] * d + hi_f(raw.x); r[2] = h0[2] * d + lo_f(raw.y); r[3] = h0[3] * d + hi_f(raw.y);
        *(f32x4*)(p.out + OUT_SSMS + nat) = r;
    }
}

constexpr int S3_MROW = 144;
constexpr int S3_YROW = 272;
constexpr int S3_WBYTES = 64 * S3_YROW;
constexpr int S3_SSQ_OFF = 8 * S3_WBYTES;
constexpr int S3_AC_OFF = S3_SSQ_OFF + 2048;
static_assert(S3_AC_OFF + 4096 <= LDS_BYTES - 256, "S3 LDS");
__device__ __forceinline__ void phase_s3(const Params& p, LAS unsigned char* lds, int wave, int lane) {
    unsigned char* ws = p.ws;
    const bf16* XT = (const bf16*)(ws + WS_XT); const bf16* BN = (const bf16*)(ws + WS_BN); const bf16* CN = (const bf16*)(ws + WS_CN);
    const float* ACUM = (const float*)(ws + WS_ACUM); const float* DTS = (const float*)(ws + WS_DTS); const bf16* ST = (const bf16*)(ws + WS_STATES);
    bf16* ZY = (bf16*)(ws + WS_Z);
    const float* d_skip = p.in[13]; const float* norm_w = p.in[14];
    const int l32 = lane & 31, hh = lane >> 5;
    LAS unsigned char* Mw = lds + wave * S3_WBYTES;
    LAS float* SSQ = (LAS float*)(lds + S3_SSQ_OFF);
    LAS float* acl = (LAS float*)(lds + S3_AC_OFF) + wave * 128; LAS float* dtl = acl + 64;
#pragma unroll 1
    for (int it = blockIdx.x; it < NQC * 4; it += gridDim.x) {
        const int q = it >> 2, g = it & 3, h = g * 8 + wave;
        const bool samp = q >= 512; const int row0 = samp ? MP + (q - 512) * 32 : q * 64, nvalid = samp ? 32 : 64;
        const float* ac = ACUM + (q * 32 + h) * 64; const float* dts = DTS + (q * 32 + h) * 64;
        acl[lane] = ac[lane]; dtl[lane] = dts[lane];
        const bf16* Cb = CN + (size_t)(q * 4 + g) * 8192; const bf16* Bb = BN + (size_t)(q * 4 + g) * 8192;
        const bf16* Xb = XT + (size_t)(q * 32 + h) * 4096; const bf16* Hb = ST + (size_t)(q * 32 + h) * 8192;
        bf16x8 cf[2][8];
#pragma unroll
        for (int tb = 0; tb < 2; ++tb)
#pragma unroll
            for (int kk = 0; kk < 8; ++kk) cf[tb][kk] = ldg8(Cb + ((2 * kk + hh) * 64 + tb * 32 + l32) * 8);
        {
            f32x16 cb00, cb10, cb11;
#pragma unroll
            for (int e = 0; e < 16; ++e) { cb00[e] = 0.f; cb10[e] = 0.f; cb11[e] = 0.f; }
            { bf16x8 bq_[2][8];
#pragma unroll
              for (int kk = 0; kk < 8; ++kk) { bq_[0][kk] = ldg8(Bb + ((2 * kk + hh) * 64 + l32) * 8); bq_[1][kk] = ldg8(Bb + ((2 * kk + hh) * 64 + 32 + l32) * 8); }
#pragma unroll
              for (int kk = 0; kk < 8; ++kk) { cb00 = MFMA32(cf[0][kk], bq_[0][kk], cb00); cb10 = MFMA32(cf[1][kk], bq_[0][kk], cb10); cb11 = MFMA32(cf[1][kk], bq_[1][kk], cb11); } }
            asm volatile("s_waitcnt lgkmcnt(0)" ::: "memory"); __builtin_amdgcn_wave_barrier();
            const float as0 = acl[l32], as1 = acl[32 + l32], ds0 = dtl[l32], ds1 = dtl[32 + l32]; const float Dh = d_skip[h];
#pragma unroll
            for (int e = 0; e < 16; ++e) { const int tl = (e & 3) + 8 * (e >> 2) + 4 * hh; const float at0 = acl[tl], at1 = acl[32 + tl];
                { const int t = tl, s_ = l32; float m = (s_ <= t) ? cb00[e] * __expf(fminf(at0 - as0, 0.f)) * ds0 : 0.f; if (s_ == t) m += Dh; *(LAS unsigned short*)(Mw + t * S3_MROW + s_ * 2) = f2bf(m); }
                { const int t = tl; *(LAS unsigned short*)(Mw + t * S3_MROW + (32 + l32) * 2) = 0; }
                { const int t = 32 + tl, s_ = l32; const float m = cb10[e] * __expf(fminf(at1 - as0, 0.f)) * ds0; *(LAS unsigned short*)(Mw + t * S3_MROW + s_ * 2) = f2bf(m); }
                { const int t = 32 + tl, s_ = 32 + l32; float m = (s_ <= t) ? cb11[e] * __expf(fminf(at1 - as1, 0.f)) * ds1 : 0.f; if (s_ == t) m += Dh; *(LAS unsigned short*)(Mw + t * S3_MROW + s_ * 2) = f2bf(m); } }
        }
        f32x16 y[2][2];
#pragma unroll
        for (int a = 0; a < 2; ++a)
#pragma unroll
            for (int b = 0; b < 2; ++b)
#pragma unroll
                for (int e = 0; e < 16; ++e) y[a][b][e] = 0.f;
        bf16x8 hq_[2][5];
#pragma unroll
        for (int kk = 0; kk < 5; ++kk) { hq_[0][kk] = ldg8(Hb + ((2 * kk + hh) * 64 + l32) * 8); hq_[1][kk] = ldg8(Hb + ((2 * kk + hh) * 64 + 32 + l32) * 8); }
#pragma unroll
        for (int kk = 0; kk < 8; ++kk) {
            const int sl = kk < 5 ? kk : kk - 5;
            const bf16x8 h0 = hq_[0][sl], h1 = hq_[1][sl];
            y[0][0] = MFMA32(cf[0][kk], h0, y[0][0]); y[0][1] = MFMA32(cf[0][kk], h1, y[0][1]);
            y[1][0] = MFMA32(cf[1][kk], h0, y[1][0]); y[1][1] = MFMA32(cf[1][kk], h1, y[1][1]);
            if (kk < 3) { hq_[0][kk] = ldg8(Hb + ((2 * (kk + 5) + hh) * 64 + l32) * 8); hq_[1][kk] = ldg8(Hb + ((2 * (kk + 5) + hh) * 64 + 32 + l32) * 8); }
        }
        __builtin_amdgcn_sched_barrier(0);
        bf16x8 xq[2][4];
#pragma unroll
        for (int kk = 0; kk < 4; ++kk) { xq[0][kk] = ldg8(Xb + ((2 * kk + hh) * 64 + l32) * 8); xq[1][kk] = ldg8(Xb + ((2 * kk + hh) * 64 + 32 + l32) * 8); }
        const int r8 = lane >> 3, c8 = lane & 7;
        u32x4 zq[8];
#pragma unroll
        for (int it8 = 0; it8 < 8; ++it8) { const int t = it8 * 8 + r8; const int tr = (t < nvalid) ? t : 0; zq[it8] = *(const u32x4*)(ZY + (size_t)(row0 + tr) * 2048 + h * 64 + c8 * 8); }
#pragma unroll
        for (int tb = 0; tb < 2; ++tb)
#pragma unroll
            for (int e = 0; e < 16; ++e) { const float sc = __expf(acl[tb * 32 + (e & 3) + 8 * (e >> 2) + 4 * hh]); y[tb][0][e] *= sc; y[tb][1][e] *= sc; }
        __syncthreads();
#pragma unroll
        for (int kk = 0; kk < 4; ++kk) {
            const bf16x8 x0 = xq[0][kk], x1 = xq[1][kk];
            const bf16x8 m0 = *(const LAS bf16x8*)(Mw + (l32) * S3_MROW + (16 * kk + 8 * hh) * 2), m1 = *(const LAS bf16x8*)(Mw + (32 + l32) * S3_MROW + (16 * kk + 8 * hh) * 2);
            y[0][0] = MFMA32(m0, x0, y[0][0]); y[0][1] = MFMA32(m0, x1, y[0][1]);
            y[1][0] = MFMA32(m1, x0, y[1][0]); y[1][1] = MFMA32(m1, x1, y[1][1]);
        }
        asm volatile("s_waitcnt lgkmcnt(0)" ::: "memory"); __builtin_amdgcn_wave_barrier();
#pragma unroll
        for (int tb = 0; tb < 2; ++tb)
#pragma unroll
            for (int pb = 0; pb < 2; ++pb)
#pragma unroll
                for (int e = 0; e < 16; ++e) *(LAS float*)(Mw + (tb * 32 + (e & 3) + 8 * (e >> 2) + 4 * hh) * S3_YROW + (pb * 32 + l32) * 4) = y[tb][pb][e];
        asm volatile("s_waitcnt lgkmcnt(0)" ::: "memory"); __builtin_amdgcn_wave_barrier();
        float hv[8][8];
#pragma unroll
        for (int it = 0; it < 8; ++it) { const int t = it * 8 + r8; const int tr = (t < nvalid) ? t : 0;
            const f32x4 y0 = *(const LAS f32x4*)(Mw + t * S3_YROW + c8 * 32), y1 = *(const LAS f32x4*)(Mw + t * S3_YROW + c8 * 32 + 16);
            const u32x4 zw = zq[it]; (void)tr;
            float zf[8]; zf[0] = lo_f(zw.x); zf[1] = hi_f(zw.x); zf[2] = lo_f(zw.y); zf[3] = hi_f(zw.y); zf[4] = lo_f(zw.z); zf[5] = hi_f(zw.z); zf[6] = lo_f(zw.w); zf[7] = hi_f(zw.w);
            float sq = 0.f;
#pragma unroll
            for (int k = 0; k < 4; ++k) { hv[it][k] = y0[k] * siluf_(zf[k]); hv[it][4 + k] = y1[k] * siluf_(zf[4 + k]); sq += hv[it][k] * hv[it][k] + hv[it][4 + k] * hv[it][4 + k]; }
            sq += __shfl_xor(sq, 1); sq += __shfl_xor(sq, 2); sq += __shfl_xor(sq, 4);
            if (c8 == 0) SSQ[wave * 64 + t] = sq; }
        __syncthreads();
        float nw[8];
        { const f32x4 n0 = *(const f32x4*)(norm_w + h * 64 + c8 * 8), n1 = *(const f32x4*)(norm_w + h * 64 + c8 * 8 + 4);
#pragma unroll
          for (int k = 0; k < 4; ++k) { nw[k] = n0[k]; nw[4 + k] = n1[k]; } }
#pragma unroll
        for (int it = 0; it < 8; ++it) { const int t = it * 8 + r8;
            float sm = 0.f;
#pragma unroll
            for (int w = 0; w < 8; ++w) sm += SSQ[w * 64 + t];
            const float rs = rsqrtf(sm * (1.0f / 512.0f) + RMS_EPS);
            if (t < nvalid) { u32x4 o; o.x = pk2(hv[it][0] * rs * nw[0], hv[it][1] * rs * nw[1]); o.y = pk2(hv[it][2] * rs * nw[2], hv[it][3] * rs * nw[3]);
                o.z = pk2(hv[it][4] * rs * nw[4], hv[it][5] * rs * nw[5]); o.w = pk2(hv[it][6] * rs * nw[6], hv[it][7] * rs * nw[7]);
                *(u32x4*)(ZY + (size_t)(row0 + t) * 2048 + h * 64 + c8 * 8) = o; } }
    }
}

constexpr int IX_CAP = 896, IX_THR = 768, IX_KEEP = 320;
constexpr int IX_RING_OFF = 32 * IX_CAP * 4;
constexpr int IX_HIST_OFF = IX_RING_OFF + 32768;
constexpr int IX_CNT_OFF = IX_HIST_OFF + 8192;
constexpr int IX_TAU_OFF = IX_CNT_OFF + 128;
constexpr int IX_TAUF_OFF = IX_TAU_OFF + 128;
constexpr int IX_MISC_OFF = IX_TAUF_OFF + 128;
constexpr int IX_NITEMS = 1056;
static_assert(IX_MISC_OFF + 16 <= LDS_BYTES - 256, "indexer LDS");
#define WAVE_LDS_FENCE() do { asm volatile("s_waitcnt lgkmcnt(0)" ::: "memory"); __builtin_amdgcn_wave_barrier(); } while (0)

__device__ __forceinline__ float ix_tau_float(unsigned tau) {
    const unsigned m = tau & 0xFFFFC000u;
    const unsigned u = (m & 0x80000000u) ? (m ^ 0x80000000u) : ~m;
    return tau == 0u ? -INFINITY : __uint_as_float(u);
}
__device__ __forceinline__ unsigned wave_max_u32(unsigned x) {
    unsigned t;
    t = (unsigned)__builtin_amdgcn_update_dpp(0, (int)x, 0xB1, 0xF, 0xF, true); x = x > t ? x : t;
    t = (unsigned)__builtin_amdgcn_update_dpp(0, (int)x, 0x4E, 0xF, 0xF, true); x = x > t ? x : t;
    t = (unsigned)__builtin_amdgcn_update_dpp(0, (int)x, 0x141, 0xF, 0xF, true); x = x > t ? x : t;
    t = (unsigned)__builtin_amdgcn_update_dpp(0, (int)x, 0x140, 0xF, 0xF, true); x = x > t ? x : t;
    { const auto r = __builtin_amdgcn_permlane16_swap(x, x, false, false); x = r[0] > r[1] ? r[0] : r[1]; }
    { const auto r = __builtin_amdgcn_permlane32_swap(x, x, false, false); x = r[0] > r[1] ? r[0] : r[1]; }
    return x;
}
__device__ __forceinline__ unsigned wave_suffix_sum_u32(unsigned s, int lane) {
    s += (unsigned)__builtin_amdgcn_update_dpp(0, (int)s, 0x101, 0xF, 0xF, true);
    s += (unsigned)__builtin_amdgcn_update_dpp(0, (int)s, 0x102, 0xF, 0xF, true);
    s += (unsigned)__builtin_amdgcn_update_dpp(0, (int)s, 0x104, 0xF, 0xF, true);
    s += (unsigned)__builtin_amdgcn_update_dpp(0, (int)s, 0x108, 0xF, 0xF, true);
    const unsigned T1 = (unsigned)__builtin_amdgcn_readlane((int)s, 16), T2 = (unsigned)__builtin_amdgcn_readlane((int)s, 32), T3 = (unsigned)__builtin_amdgcn_readlane((int)s, 48);
    const int row = lane >> 4;
    return s + (row == 0 ? T1 + T2 + T3 : row == 1 ? T2 + T3 : row == 2 ? T3 : 0u);
}
__device__ __forceinline__ void ix_select(LAS unsigned* cr, LAS unsigned* hist, LAS unsigned* cntp, LAS unsigned* taup, LAS float* taufp, int n, unsigned tau_old, bool exact, int lane) {
    unsigned v[14]; unsigned mx = 0u;
#pragma unroll
    for (int i = 0; i < 14; ++i) { const int idx = lane + 64 * i; v[i] = (idx < n) ? cr[idx] : 0u; mx = v[i] > mx ? v[i] : mx; }
    mx = wave_max_u32(mx);
    unsigned lo = tau_old, hi = mx, kth = 256u, above_total = 0u;
#pragma unroll 1
    for (int round = 0; round < 6; ++round) {
        const unsigned span = hi - lo - 1u;
        const int shift = (span >> 8) ? (32 - __clz(span) - 8) : 0;
#pragma unroll
        for (int j = 0; j < 4; ++j) hist[lane * 4 + j] = 0u;
        WAVE_LDS_FENCE();
#pragma unroll
        for (int i = 0; i < 14; ++i) if (v[i] > lo && v[i] <= hi) __hip_atomic_fetch_add(&hist[(v[i] - lo - 1u) >> shift], 1u, __ATOMIC_RELAXED, __HIP_MEMORY_SCOPE_WORKGROUP);
        WAVE_LDS_FENCE();
        const unsigned h0 = hist[lane * 4 + 0], h1 = hist[lane * 4 + 1], h2 = hist[lane * 4 + 2], h3 = hist[lane * 4 + 3];
        const unsigned lsum = h0 + h1 + h2 + h3;
        const unsigned s = wave_suffix_sum_u32(lsum, lane);
        const unsigned a3 = s - lsum, a2 = a3 + h3, a1 = a2 + h2, a0 = a1 + h1;
        int found = -1; unsigned abv = 0u, inb = 0u;
        if (a3 < kth && kth <= a3 + h3) { found = 3; abv = a3; inb = h3; }
        else if (a2 < kth && kth <= a2 + h2) { found = 2; abv = a2; inb = h2; }
        else if (a1 < kth && kth <= a1 + h1) { found = 1; abv = a1; inb = h1; }
        else if (a0 < kth && kth <= a0 + h0) { found = 0; abv = a0; inb = h0; }
        const unsigned long long bal = __ballot(found >= 0);
        const int src = (bal != 0ull) ? (__ffsll((long long)bal) - 1) : 0;
        const unsigned bin = (unsigned)__builtin_amdgcn_readlane(lane * 4 + (found < 0 ? 0 : found), src); const unsigned ab = (unsigned)__builtin_amdgcn_readlane((int)abv, src), ib = (unsigned)__builtin_amdgcn_readlane((int)inb, src);
        WAVE_LDS_FENCE();
        kth -= ab; above_total += ab;
        const unsigned nlo = lo + (bin << shift);
        hi = (shift == 0) ? nlo + 1u : lo + ((bin + 1u) << shift); if (hi > mx) hi = mx;
        lo = nlo;
        if (shift == 0) break;
        if (!exact && above_total + ib <= (unsigned)IX_KEEP) break;
        if (exact && ib <= 64u) {
            unsigned base_ = 0u;
#pragma unroll
            for (int i = 0; i < 14; ++i) { const bool in_ = v[i] > lo && v[i] <= hi; const unsigned long long bal_ = __ballot(in_);
                const unsigned pos_ = base_ + (unsigned)__popcll(bal_ & ((1ull << lane) - 1ull)); if (in_) hist[pos_] = v[i]; base_ += (unsigned)__popcll(bal_); }
            WAVE_LDS_FENCE();
            const unsigned x_ = ((unsigned)lane < ib) ? hist[lane] : 0u; unsigned rank_ = 0u;
            for (unsigned m_ = 0; m_ < ib; ++m_) rank_ += (hist[m_] > x_) ? 1u : 0u;
            const unsigned long long hit_ = __ballot((unsigned)lane < ib && rank_ == kth - 1u);
            const int src_ = (hit_ != 0ull) ? (__ffsll((long long)hit_) - 1) : 0;
            lo = (unsigned)__builtin_amdgcn_readlane((int)x_, src_) - 1u;
            WAVE_LDS_FENCE();
            break;
        }
    }
    unsigned base = 0u;
#pragma unroll
    for (int i = 0; i < 14; ++i) { const bool keep = v[i] > lo; const unsigned long long bal = __ballot(keep);
        const unsigned pos = base + (unsigned)__popcll(bal & ((1ull << lane) - 1ull)); if (keep) cr[pos] = v[i]; base += (unsigned)__popcll(bal); }
    if (lane == 0) { *cntp = base; *taup = lo; *taufp = ix_tau_float(lo); }
    WAVE_LDS_FENCE();
}

#ifdef IXT
#define IXT_BEGIN(k) unsigned long long _t##k = (IXT == k) ? __builtin_amdgcn_s_memrealtime() : 0ull
#define IXT_END(k) do { if (IXT == k) ixt_acc += __builtin_amdgcn_s_memrealtime() - _t##k; } while (0)
#else
#define IXT_BEGIN(k) do {} while (0)
#define IXT_END(k) do {} while (0)
#endif
template <int VARIANT>
__device__ __forceinline__ void phase_indexer(const Params& p, LAS unsigned char* lds, int tid, int wave, int lane) {
    unsigned char* ws = p.ws;
    const bf16* QI = (const bf16*)(ws + WS_QI); const bf16* KI = (const bf16*)(ws + WS_KIALL); const float* WI = (const float*)(ws + WS_WI);
    unsigned short* SEL = (unsigned short*)(ws + WS_SEL);
    unsigned* queue = (unsigned*)(ws + WS_CTL) + CW_QUEUE + 64 * VARIANT;
    LAS unsigned* cand = (LAS unsigned*)lds; LAS unsigned* hist = (LAS unsigned*)(lds + IX_HIST_OFF) + wave * 256;
    LAS unsigned* cnt = (LAS unsigned*)(lds + IX_CNT_OFF); LAS unsigned* tau = (LAS unsigned*)(lds + IX_TAU_OFF); LAS float* tauf = (LAS float*)(lds + IX_TAUF_OFF);
    LAS unsigned* misc = (LAS unsigned*)(lds + IX_MISC_OFF);
    const int fr = lane & 15, fq = lane >> 4, rb = wave >> 2, cq = wave & 3;
    unsigned long long ixt_acc = 0ull; (void)ixt_acc;
#pragma unroll 1
    for (;;) {
        if (tid == 0) misc[0] = __hip_atomic_fetch_add(queue, 1u, __ATOMIC_RELAXED, __HIP_MEMORY_SCOPE_AGENT);
        __syncthreads();
        const int item = (int)misc[0];
        __syncthreads();
        if (item >= IX_NITEMS) break;
        bool samp = false; int b, c = 0, hf = 0;
        if (item < 764) { b = item & 1; hf = (item >> 1) & 1; c = 255 - (item >> 2); }
        else if (item < 796) { samp = true; b = item - 764; }
        else { const int j = item - 32; b = j & 1; hf = (j >> 1) & 1; c = 255 - (j >> 2); }
        const int qrow0 = samp ? MP + b * 32 : b * SEQP + c * 64 + hf * 32;
        const int krow0 = samp ? MP + b * SKEYS : b * SEQP, nkeys = samp ? SKEYS : 64 * (c + 1), nsteps = (nkeys + 127) >> 7;
        if (tid < 32) { cnt[tid] = 0u; tau[tid] = (VARIANT >= 1) ? 0xFFFFFFFFu : 0u; tauf[tid] = (VARIANT >= 1) ? __uint_as_float(0x7FFFC000u) : -INFINITY; }
        if (tid >= 32 && tid < 34) misc[tid - 30] = 0u;
        bf16x8 af[8][2], qt[2]; float wh[8][4];
        { const bf16* qp = QI + (size_t)(qrow0 + rb * 16 + fr) * 512 + 8 * fq;
#pragma unroll
          for (int h = 0; h < 8; ++h) { af[h][0] = ldg8(qp + h * 64); af[h][1] = ldg8(qp + h * 64 + 32); }
#pragma unroll
          for (int r = 0; r < 4; ++r) { const float* wp = WI + (size_t)(qrow0 + rb * 16 + 4 * fq + r) * 8;
              const f32x4 w0 = *(const f32x4*)wp, w1 = *(const f32x4*)(wp + 4);
#pragma unroll
              for (int e = 0; e < 4; ++e) { wh[e][r] = 0.5f * w0[e]; wh[4 + e][r] = 0.5f * w1[e]; } }
          const float* wp = WI + (size_t)(qrow0 + rb * 16 + fr) * 8; const f32x4 w0 = *(const f32x4*)wp, w1 = *(const f32x4*)(wp + 4);
          float wr_[8]; wr_[0] = w0[0]; wr_[1] = w0[1]; wr_[2] = w0[2]; wr_[3] = w0[3]; wr_[4] = w1[0]; wr_[5] = w1[1]; wr_[6] = w1[2]; wr_[7] = w1[3];
#pragma unroll
          for (int ks = 0; ks < 2; ++ks) { float a8[8];
#pragma unroll
              for (int e = 0; e < 8; ++e) a8[e] = 0.f;
#pragma unroll
              for (int h = 0; h < 8; ++h) { const u32x4 u = __builtin_bit_cast(u32x4, af[h][ks]); const float s_ = 0.5f * wr_[h];
                  a8[0] += s_ * lo_f(u.x); a8[1] += s_ * hi_f(u.x); a8[2] += s_ * lo_f(u.y); a8[3] += s_ * hi_f(u.y);
                  a8[4] += s_ * lo_f(u.z); a8[5] += s_ * hi_f(u.z); a8[6] += s_ * lo_f(u.w); a8[7] += s_ * hi_f(u.w); }
              u32x4 o; o.x = pk2(a8[0], a8[1]); o.y = pk2(a8[2], a8[3]); o.z = pk2(a8[4], a8[5]); o.w = pk2(a8[6], a8[7]); qt[ks] = __builtin_bit_cast(bf16x8, o); } }
        __syncthreads();
        const char* kib = (const char*)(KI + (size_t)krow0 * 64);
        const int srow = tid >> 3, sch = tid & 7;
#define IX_GLOAD(R, step) do { _Pragma("unroll") for (int i = 0; i < 2; ++i) { int key = (step) * 128 + srow + 64 * i; if (key > nkeys - 1) key = nkeys - 1; \
            R[i] = *(const u32x4*)(kib + ((unsigned)key * 128u + (unsigned)sch * 16u)); } } while (0)
#define IX_SWRITE(R, slot) do { _Pragma("unroll") for (int i = 0; i < 2; ++i) { const int k = srow + 64 * i; \
            *(LAS u32x4*)(lds + IX_RING_OFF + (slot) * 16384 + k * 128 + ((sch ^ (k & 7)) << 4)) = R[i]; } } while (0)
#define IX_COMPUTE(slot, step) do { \
            float sc[2][4]; unsigned long long pm = 0ull; \
            _Pragma("unroll") for (int cbi = 0; cbi < 2; ++cbi) { const int kl = cq * 32 + 16 * cbi + fr; \
                const bf16x8 b0 = *(const LAS bf16x8*)(lds + IX_RING_OFF + (slot) * 16384 + kl * 128 + ((fq ^ (kl & 7)) << 4)); \
                const bf16x8 b1 = *(const LAS bf16x8*)(lds + IX_RING_OFF + (slot) * 16384 + kl * 128 + (((4 + fq) ^ (kl & 7)) << 4)); \
                f32x4 acc = {0.f, 0.f, 0.f, 0.f}; acc = MFMA16(qt[0], b0, acc); acc = MFMA16(qt[1], b1, acc); \
                f32x4 dq = {0.f, 0.f, 0.f, 0.f}; dq = MFMA16(af[0][0], b0, dq); dq = MFMA16(af[0][1], b1, dq); \
                float a0_ = acc[0], a1_ = acc[1], a2_ = acc[2], a3_ = acc[3]; \
                  \
                _Pragma("unroll") for (int h = 0; h < (VARIANT == 2 ? 4 : 8); ++h) { f32x4 dn = {0.f, 0.f, 0.f, 0.f}; \
                    if (h + 1 < (VARIANT == 2 ? 4 : 8)) { dn = MFMA16(af[(h + 1) & 7][0], b0, dn); dn = MFMA16(af[(h + 1) & 7][1], b1, dn); } \
                    __builtin_amdgcn_sched_barrier(0); \
                    a0_ = __builtin_fmaf(wh[h][0], __builtin_fabsf(dq[0]), a0_); asm("" : "+v"(a0_)); a1_ = __builtin_fmaf(wh[h][1], __builtin_fabsf(dq[1]), a1_); asm("" : "+v"(a1_)); \
                    a2_ = __builtin_fmaf(wh[h][2], __builtin_fabsf(dq[2]), a2_); asm("" : "+v"(a2_)); a3_ = __builtin_fmaf(wh[h][3], __builtin_fabsf(dq[3]), a3_); asm("" : "+v"(a3_)); \
                    __builtin_amdgcn_sched_barrier(0); \
                    dq = dn; } \
                sc[cbi][0] = a0_; sc[cbi][1] = a1_; sc[cbi][2] = a2_; sc[cbi][3] = a3_; \
                pm |= __ballot(a0_ >= tf[0]) | __ballot(a1_ >= tf[1]) | __ballot(a2_ >= tf[2]) | __ballot(a3_ >= tf[3]); } \
            if (pm != 0ull) { IXT_BEGIN(2); \
                unsigned pk[2][4], sl[2][4]; bool ps[2][4]; \
                _Pragma("unroll") for (int cbi = 0; cbi < 2; ++cbi) { const int kidx = (step) * 128 + cq * 32 + 16 * cbi + fr; const bool inr = kidx < nkeys; const unsigned low = (unsigned)(16383 - kidx); \
                    _Pragma("unroll") for (int r = 0; r < 4; ++r) { const unsigned u = __float_as_uint(sc[cbi][r]); const unsigned mono = u ^ ((unsigned)((int)u >> 31) | 0x80000000u); \
                        pk[cbi][r] = (mono & 0xFFFFC000u) | low; ps[cbi][r] = inr && (pk[cbi][r] > tq[r]); sl[cbi][r] = 0u; \
                        if (ps[cbi][r]) sl[cbi][r] = __hip_atomic_fetch_add(cntw + r, 1u, __ATOMIC_RELAXED, __HIP_MEMORY_SCOPE_WORKGROUP); } } \
                _Pragma("unroll") for (int cbi = 0; cbi < 2; ++cbi) _Pragma("unroll") for (int r = 0; r < 4; ++r) if (ps[cbi][r]) candw[r * IX_CAP + sl[cbi][r]] = pk[cbi][r]; \
            IXT_END(2); } } while (0)
#define IX_THRESH() do { _Pragma("unroll") for (int r = 0; r < 4; ++r) { tf[r] = tauf[rb * 16 + 4 * fq + r]; tq[r] = tau[rb * 16 + 4 * fq + r]; } } while (0)
#define IX_CHECK(cp, t) do { const unsigned E_ = misc[2 + ((t) & 1)]; \
            if ((cp) || E_ != 0u) { _Pragma("unroll 1") for (int rr = 0; rr < 4; ++rr) { const int row = wave * 4 + rr; const int n_ = (int)cnt[row]; \
                    if (n_ > ((cp) ? 256 : 512)) ix_select(cand + row * IX_CAP, hist, cnt + row, tau + row, tauf + row, n_, tau[row], false, lane); } \
                __syncthreads(); IX_THRESH(); } \
            if (wave == 0) { const unsigned cv = (lane < 32) ? cnt[lane] : 0u; const unsigned long long over = __ballot(cv > 640u); if (lane == 0) misc[2 + (((t) + 1) & 1)] = (over != 0ull) ? 1u : 0u; } } while (0)
        LAS unsigned* cntw = cnt + rb * 16 + 4 * fq; LAS unsigned* candw = cand + (rb * 16 + 4 * fq) * IX_CAP;
        float tf[4]; unsigned tq[4]; IX_THRESH();
        u32x4 RA[2], RB[2];
        IX_GLOAD(RA, 0); IX_GLOAD(RB, 1);
        IX_SWRITE(RA, 0); IX_GLOAD(RA, 2);
        __syncthreads();
#define IX_CP(done) (((done) == 4 || (done) == 8 || (done) == 16 || (done) == 32 || (done) == 64) && (done) < nsteps)
#pragma unroll 1
        for (int t0 = 0; t0 < nsteps; t0 += 2) {
            IX_SWRITE(RB, 1); IX_GLOAD(RB, t0 + 3);
            IX_COMPUTE(0, t0);
            __syncthreads();
            { IXT_BEGIN(1); const bool cp = IX_CP(t0 + 1); IX_CHECK(cp, t0); IXT_END(1); }
            IX_SWRITE(RA, 0); IX_GLOAD(RA, t0 + 4);
            if (t0 + 1 < nsteps) IX_COMPUTE(1, t0 + 1);
            __syncthreads();
            { IXT_BEGIN(1); const bool cp = IX_CP(t0 + 2); IX_CHECK(cp, t0 + 1); IXT_END(1); }
        }
        IXT_BEGIN(3);
#pragma unroll 1
        for (int rr = 0; rr < 4; ++rr) { const int row = wave * 4 + rr;
            int n = (int)cnt[row]; if (n > 256) { ix_select(cand + row * IX_CAP, hist, cnt + row, tau + row, tauf + row, n, tau[row], true, lane); n = (int)cnt[row]; if (n > 256) n = 256; }
            unsigned short* sp = SEL + (size_t)(qrow0 + row) * 256;
#pragma unroll
            for (int i = 0; i < 4; ++i) { const int k = lane + 64 * i; if (k < n) sp[k] = (unsigned short)(16383u - (cand[row * IX_CAP + k] & 16383u)); } }
        IXT_END(3);
        __syncthreads();
#undef IX_GLOAD
#undef IX_SWRITE
#undef IX_COMPUTE
#undef IX_THRESH
#undef IX_CP
#undef IX_CHECK
    }
#ifdef IXT
    if (VARIANT == 0 && tid == 0) *(LAS unsigned long long*)(lds + LDS_BYTES - 8) = ixt_acc;
#endif
}

constexpr int AT_BIAS_OFF = 131072;
constexpr int AT_T5_OFF = AT_BIAS_OFF + 2048;
constexpr int AT_SEL_OFF = AT_T5_OFF + 512 + 64;
static_assert(AT_SEL_OFF + 4096 <= LDS_BYTES, "attention LDS");
__device__ __forceinline__ void unpack8(const u32x4 w, float (&f)[8]) { f[0] = lo_f(w.x); f[1] = hi_f(w.x); f[2] = lo_f(w.y); f[3] = hi_f(w.y); f[4] = lo_f(w.z); f[5] = hi_f(w.z); f[6] = lo_f(w.w); f[7] = hi_f(w.w); }
__device__ __forceinline__ float oct_add(float x) {
    x += __builtin_bit_cast(float, __builtin_amdgcn_update_dpp(0, __builtin_bit_cast(int, x), 0xB1, 0xF, 0xF, true));
    x += __builtin_bit_cast(float, __builtin_amdgcn_update_dpp(0, __builtin_bit_cast(int, x), 0x4E, 0xF, 0xF, true));
    x += __builtin_bit_cast(float, __builtin_amdgcn_update_dpp(0, __builtin_bit_cast(int, x), 0x141, 0xF, 0xF, true));
    return x;
}
__device__ __forceinline__ void unpack8_fp8(const u32x2 w, float (&f)[8]) {
    const f32x2v a0 = __builtin_amdgcn_cvt_pk_f32_fp8((int)w.x, false), a1 = __builtin_amdgcn_cvt_pk_f32_fp8((int)w.x, true), b0 = __builtin_amdgcn_cvt_pk_f32_fp8((int)w.y, false), b1 = __builtin_amdgcn_cvt_pk_f32_fp8((int)w.y, true);
    f[0] = a0.x; f[1] = a0.y; f[2] = a1.x; f[3] = a1.y; f[4] = b0.x; f[5] = b0.y; f[6] = b1.x; f[7] = b1.y;
}
__device__ __forceinline__ unsigned xb_xcc_id();
__device__ __forceinline__ unsigned xb_ld(unsigned* p);
constexpr int AT_BK_OFF = AT_SEL_OFF + 4096;
constexpr int AT_PIMG = 32 * 272;
static_assert(AT_PIMG + 16 * 272 <= 16384, "attention images");
static_assert(AT_BK_OFF + 2048 <= LDS_BYTES - 256, "attention LDS");
typedef long i64_t;
__device__ __forceinline__ void phase_attn(const Params& p, LAS unsigned char* lds, int tid, int wave, int lane) {
    unsigned char* ws = p.ws;
    bf16* QO = (bf16*)(ws + WS_Q); const unsigned char* KA = ws + WS_KALL; const unsigned char* VA = ws + WS_VALL;
    const unsigned short* SEL = (const unsigned short*)(ws + WS_SEL);
    LAS float* bias = (LAS float*)(lds + AT_BIAS_OFF); LAS int* t5 = (LAS int*)(lds + AT_T5_OFF);
    LAS float* L = (LAS float*)lds + wave * 4096; LAS unsigned short* S = (LAS unsigned short*)(lds + AT_SEL_OFF) + wave * 256;
    LAS unsigned char* BK = lds + AT_BK_OFF + wave * 256;
    bias[tid] = p.in[7][tid];
    if (tid < 128) { const int n = tid; int v; if (n < 8) v = n; else { int k2 = 0; while (k2 < 12 && n * n >= (64 << (k2 + 1))) ++k2; v = 8 + k2; if (v > 15) v = 15; } t5[n] = v; }
    __syncthreads();
    const int half = lane >> 5, l32 = lane & 31, j = l32 >> 3, sub = l32 & 7, d0 = 8 * sub;
    const int fr = lane & 15, fq = lane >> 4;
    const int G = gridDim.x;
    if (tid == 0) { unsigned* ctl = (unsigned*)(ws + WS_CTL); const unsigned x = xb_xcc_id(); bool even = (G == 256);
        for (int jx = 0; jx < 8; ++jx) even = even && (xb_ld(ctl + CW_BAR + 256 + 64 * jx) == 32u);
        const unsigned t = even ? __hip_atomic_fetch_add(ctl + CW_ATT + 64 * (x & 7u), 1u, __ATOMIC_RELAXED, __HIP_MEMORY_SCOPE_AGENT) : 0u;
        t5[128 + 0] = even ? 1 : 0; t5[128 + 1] = (int)(x & 7u); t5[128 + 2] = (int)t; }
    __syncthreads();
    const bool xcd_order = t5[128] != 0;
    const int xl = t5[129], lw = t5[130] * 8 + wave;
    const int niter = xcd_order ? 17 : (MT + G * 8 - 1) / (G * 8);
    auto qr_at = [&](int itq) -> int {
        if (xcd_order) { return itq < 8 ? 2048 * xl + itq * 256 + lw : itq < 16 ? SEQP + 2048 * (7 - xl) + (itq - 8) * 256 + lw : MP + xl * 128 + lw; }
        return itq * (G * 8) + blockIdx.x * 8 + wave; };
    int nq = niter;
    if (xcd_order) { if (lw >= 128) nq = 16; } else { while (nq > 0 && qr_at(nq - 1) >= MT) --nq; }
    u32x2 sw_n = {0u, 0u};
    const unsigned o_lo = (unsigned)(4 * j * 64 + d0) * 2u;
    const unsigned sel_lo = (unsigned)lane * 8u, q_lo = (unsigned)(fr * 64 + 16 * fq) * 2u;
    if (nq > 0) { const int q0_ = qr_at(0); sw_n = *(const u32x2*)((const unsigned char*)(SEL + (size_t)q0_ * 256) + sel_lo); }
#pragma unroll 1
    for (int itq = 0; itq < nq; ++itq) {
        const int qr = qr_at(itq);
        const u32x2 sw = sw_n;
        const unsigned char* qp_ = (const unsigned char*)(QO + (size_t)qr * 1024); const u32x4 w0 = *(const u32x4*)(qp_ + q_lo), w1 = *(const u32x4*)(qp_ + (q_lo + 16u));
        int krow0, pos, nsel;
        if (qr < MP) { const int b = qr >> 14, t = qr & 16383; krow0 = b * SEQP; pos = t; nsel = 64 * ((t >> 6) + 1); if (nsel > 256) nsel = 256; }
        else { const int rs = qr - MP, b = rs >> 5, t = rs & 31; krow0 = MP + b * SKEYS; pos = PAST + t; nsel = 256; }
        const int ntile = nsel >> 4;
        {
          int bw_ = 0; unsigned short id4[4];
#pragma unroll
          for (int i = 0; i < 4; ++i) { const int k = 4 * lane + i; const unsigned raw = ((i & 2) ? sw.y : sw.x) >> (16 * (i & 1)) & 0xffffu; const int idx = (k < nsel) ? (int)raw : 0; id4[i] = (unsigned short)idx;
              const int rel = idx - pos, n = rel < 0 ? -rel : rel; const int t5v = t5[n < 128 ? n : 127]; const int bk = (rel > 0 ? 16 : 0) + (n < 128 ? t5v : 15); bw_ |= bk << (8 * i); }
          u32x2 so; so.x = (unsigned)id4[0] | ((unsigned)id4[1] << 16); so.y = (unsigned)id4[2] | ((unsigned)id4[3] << 16);
          *(LAS u32x2*)(S + 4 * lane) = so; *(LAS int*)(BK + 4 * lane) = bw_; }
        i64_t bq[4][2];
        { float t0[8], t1[8]; unpack8(w0, t0); unpack8(w1, t1);
          const unsigned a0 = pk4_fp8(t0[0] * 0.125f, t0[1] * 0.125f, t0[2] * 0.125f, t0[3] * 0.125f), a1 = pk4_fp8(t0[4] * 0.125f, t0[5] * 0.125f, t0[6] * 0.125f, t0[7] * 0.125f);
          const unsigned c0 = pk4_fp8(t1[0] * 0.125f, t1[1] * 0.125f, t1[2] * 0.125f, t1[3] * 0.125f), c1 = pk4_fp8(t1[4] * 0.125f, t1[5] * 0.125f, t1[6] * 0.125f, t1[7] * 0.125f);
          const i64_t q0 = (i64_t)(((unsigned long long)a1 << 32) | a0), q1 = (i64_t)(((unsigned long long)c1 << 32) | c0);
#pragma unroll
          for (int m = 0; m < 4; ++m) { const bool mine = (fr >> 2) == m; bq[m][0] = mine ? q0 : (i64_t)0; bq[m][1] = mine ? q1 : (i64_t)0; } }
        WAVE_LDS_FENCE();
        const unsigned char* kbase = KA + (size_t)krow0 * 256; const unsigned char* vbase = VA + (size_t)krow0 * 256;
        u32x4 kA[2][4], kB[2][4];
#define AT_KISSUE(buf, tb) do { _Pragma("unroll") for (int u = 0; u < 2; ++u) { const unsigned idx = (unsigned)S[16 * (2 * (tb) + u) + fr]; \
            _Pragma("unroll") for (int m = 0; m < 4; ++m) buf[u][m] = *(const u32x4*)(kbase + (idx * 256u + (unsigned)(64 * m + 16 * fq))); } } while (0)
#define AT_KMMA(buf, tb) do { _Pragma("unroll") for (int u = 0; u < 2; ++u) { f32x4 acc = {0.f, 0.f, 0.f, 0.f}; \
            _Pragma("unroll") for (int m = 0; m < 4; ++m) { const i64_t lo_ = (i64_t)(((unsigned long long)buf[u][m].y << 32) | buf[u][m].x), hi_ = (i64_t)(((unsigned long long)buf[u][m].w << 32) | buf[u][m].z); \
                acc = __builtin_amdgcn_mfma_f32_16x16x32_fp8_fp8(lo_, bq[m][0], acc, 0, 0, 0); acc = __builtin_amdgcn_mfma_f32_16x16x32_fp8_fp8(hi_, bq[m][1], acc, 0, 0, 0); } \
            _Pragma("unroll") for (int r = 0; r < 4; ++r) L[(16 * (2 * (tb) + u) + 4 * fq + r) * 16 + fr] = acc[r]; } } while (0)
        const int ntb = ntile >> 1;
        AT_KISSUE(kA, 0);
#pragma unroll 1
        for (int tb = 0; tb < ntb; tb += 2) {
            AT_KISSUE(kB, tb + 1);
            AT_KMMA(kA, tb);
            { const int tx = (tb + 2 < ntb) ? tb + 2 : ntb - 1; AT_KISSUE(kA, tx); }
            AT_KMMA(kB, tb + 1);
        }
        u32x2 bA[16], bB[16];
#define AT_ISSUE(buf, bi, base) do { _Pragma("unroll") for (int u = 0; u < 16; ++u) { const unsigned idx = (unsigned)S[2 * (16 * (bi) + u) + half]; buf[u] = *(const u32x2*)((base) + (idx * 256u + (unsigned)l32 * 8u)); } } while (0)
        AT_ISSUE(bA, 0, vbase);
        { const int qn = qr_at(itq + 1 < nq ? itq + 1 : itq);
          sw_n = *(const u32x2*)((const unsigned char*)(SEL + (size_t)qn * 256) + sel_lo); }
        WAVE_LDS_FENCE();
        { const int h = lane & 15, kq = lane >> 4; LAS float* lp = L + (kq * 64) * 16 + h; LAS unsigned char* bp = BK + kq * 64;
          float v[64]; float mx = -INFINITY;
          const bool ok = kq * 64 < nsel;
          u32x4 bw[4];
#pragma unroll
          for (int i = 0; i < 4; ++i) bw[i] = *(const LAS u32x4*)(bp + 16 * i);
#pragma unroll
          for (int c = 0; c < 4; ++c) { float bb[16], ll[16]; __builtin_amdgcn_sched_barrier(0);
#pragma unroll
              for (int k = 0; k < 16; ++k) ll[k] = lp[(16 * c + k) * 16];
#pragma unroll
              for (int k = 0; k < 16; ++k) { const unsigned w_ = bw[c][k >> 2]; const unsigned bk_ = (w_ >> (8 * (k & 3))) & 0xffu; bb[k] = bias[bk_ * 16 + h]; }
#pragma unroll
              for (int k = 0; k < 16; ++k) { asm volatile("" : "+v"(ll[k]), "+v"(bb[k])); v[16 * c + k] = ok ? ll[k] + bb[k] : -INFINITY; mx = fmaxf(mx, v[16 * c + k]); } }
          mx = fmaxf(mx, __shfl_xor(mx, 16)); mx = fmaxf(mx, __shfl_xor(mx, 32));
          float sm = 0.f;
#pragma unroll
          for (int k = 0; k < 64; ++k) { v[k] = __expf(v[k] - mx); sm += v[k]; }
          sm += __shfl_xor(sm, 16); sm += __shfl_xor(sm, 32);
          const float inv = 1.0f / sm;
          { const float sc_ = inv * 256.f; LAS unsigned char* pw = (LAS unsigned char*)L + AT_PIMG + h * 272 + kq * 64;
#pragma unroll
            for (int i = 0; i < 4; ++i) { u32x4 w_; w_.x = pk4_fp8(v[16 * i + 0] * sc_, v[16 * i + 1] * sc_, v[16 * i + 2] * sc_, v[16 * i + 3] * sc_); w_.y = pk4_fp8(v[16 * i + 4] * sc_, v[16 * i + 5] * sc_, v[16 * i + 6] * sc_, v[16 * i + 7] * sc_);
                w_.z = pk4_fp8(v[16 * i + 8] * sc_, v[16 * i + 9] * sc_, v[16 * i + 10] * sc_, v[16 * i + 11] * sc_); w_.w = pk4_fp8(v[16 * i + 12] * sc_, v[16 * i + 13] * sc_, v[16 * i + 14] * sc_, v[16 * i + 15] * sc_);
                *(LAS u32x4*)(pw + 16 * i) = w_; } } }
        WAVE_LDS_FENCE();
        const int nbat = (nsel + 31) >> 5;
        f32x4 oc[16];
#pragma unroll
        for (int c = 0; c < 16; ++c) oc[c] = f32x4{0.f, 0.f, 0.f, 0.f};
        LAS unsigned char* Vimg = (LAS unsigned char*)L;
        const unsigned vw_addr = (unsigned)(size_t)(Vimg + half * 272 + l32 * 8);
        const unsigned tr_addr = (unsigned)(size_t)(Vimg + (8 * fq + ((lane & 15) >> 1)) * 272 + 8 * (lane & 1));
        const unsigned pa_addr = (unsigned)(size_t)(Vimg + AT_PIMG + fr * 272 + 8 * fq);
#define AT_PV(buf, bi) do { _Pragma("unroll") for (int u = 0; u < 16; ++u) *(LAS u32x2*)(size_t)(vw_addr + (unsigned)(2 * u * 272)) = buf[u]; \
            const u32x2 pa2 = *(const LAS u32x2*)(size_t)(pa_addr + (unsigned)(32 * (bi))); const i64_t pa = (i64_t)(((unsigned long long)pa2.y << 32) | pa2.x); \
            u32x2 tt[16];     \
            asm volatile("ds_read_b64_tr_b8 %0, %16\n\tds_read_b64_tr_b8 %1, %16 offset:16\n\tds_read_b64_tr_b8 %2, %16 offset:32\n\tds_read_b64_tr_b8 %3, %16 offset:48\n\t" \
                         "ds_read_b64_tr_b8 %4, %16 offset:64\n\tds_read_b64_tr_b8 %5, %16 offset:80\n\tds_read_b64_tr_b8 %6, %16 offset:96\n\tds_read_b64_tr_b8 %7, %16 offset:112\n\t" \
                         "ds_read_b64_tr_b8 %8, %16 offset:128\n\tds_read_b64_tr_b8 %9, %16 offset:144\n\tds_read_b64_tr_b8 %10, %16 offset:160\n\tds_read_b64_tr_b8 %11, %16 offset:176\n\t" \
                         "ds_read_b64_tr_b8 %12, %16 offset:192\n\tds_read_b64_tr_b8 %13, %16 offset:208\n\tds_read_b64_tr_b8 %14, %16 offset:224\n\tds_read_b64_tr_b8 %15, %16 offset:240\n\ts_waitcnt lgkmcnt(0)" \
                : "=&v"(tt[0]), "=&v"(tt[1]), "=&v"(tt[2]), "=&v"(tt[3]), "=&v"(tt[4]), "=&v"(tt[5]), "=&v"(tt[6]), "=&v"(tt[7]), \
                  "=&v"(tt[8]), "=&v"(tt[9]), "=&v"(tt[10]), "=&v"(tt[11]), "=&v"(tt[12]), "=&v"(tt[13]), "=&v"(tt[14]), "=&v"(tt[15]) : "v"(tr_addr) : "memory"); \
            _Pragma("unroll") for (int c = 0; c < 16; ++c) oc[c] = __builtin_amdgcn_mfma_f32_16x16x32_fp8_fp8(pa, (i64_t)(((unsigned long long)tt[c].y << 32) | tt[c].x), oc[c], 0, 0, 0); } while (0)
#pragma unroll 1
        for (int bi = 0; bi < nbat; bi += 2) {
            AT_ISSUE(bB, bi + 1, vbase);
            AT_PV(bA, bi);
            { const int bx = (bi + 2 < nbat) ? bi + 2 : nbat - 1; AT_ISSUE(bA, bx, vbase); }
            AT_PV(bB, bi + 1);
        }
        { unsigned short* orow = (unsigned short*)((unsigned char*)(QO + (size_t)qr * 1024)) ;
#pragma unroll
          for (int cc = 0; cc < 4; ++cc) { const f32x4 sel_ = (fq == 0) ? oc[cc] : (fq == 1) ? oc[4 + cc] : (fq == 2) ? oc[8 + cc] : oc[12 + cc];
#pragma unroll
              for (int r = 0; r < 4; ++r) orow[(unsigned)((4 * fq + r) * 64 + 16 * cc + fr)] = f2bf(sel_[r] * 0.00390625f); } }
        WAVE_LDS_FENCE();
    }
#undef AT_KISSUE
#undef AT_KMMA
#undef AT_ISSUE
#undef AT_PV
}

template <bool TO_BF16>
__device__ __forceinline__ void phase_ln(const bf16* src, void* dst, const float* gam, const float* bet, int wave, int lane, const float* slab, int nslab, const float* resx, const bf16* resh) {
    const int gw = blockIdx.x * 8 + wave, NGW = gridDim.x * 8;
    f32x4 gv[4], bv[4];
#pragma unroll
    for (int jj = 0; jj < 4; ++jj) { gv[jj] = *(const f32x4*)(gam + lane * 4 + 256 * jj); bv[jj] = *(const f32x4*)(bet + lane * 4 + 256 * jj); }
#define LN_LOAD(V, r_) do { const int rr_ = (r_); if (rr_ < MP) { const bf16* xr = src + (size_t)rr_ * 1024 + lane * 4; \
            _Pragma("unroll") for (int jj = 0; jj < 4; ++jj) { const u32x2 w = *(const u32x2*)(xr + 256 * jj); V[jj][0] = lo_f(w.x); V[jj][1] = hi_f(w.x); V[jj][2] = lo_f(w.y); V[jj][3] = hi_f(w.y); } } \
        else if (rr_ < MT) {     \
            _Pragma("unroll") for (int jj = 0; jj < 4; ++jj) { const size_t o = (size_t)(rr_ - MP) * 1024 + lane * 4 + 256 * jj; \
                if (resx) V[jj] = *(const f32x4*)(resx + o) * ALPHA; \
                else { const u32x2 hv = *(const u32x2*)(resh + (size_t)rr_ * 1024 + lane * 4 + 256 * jj); V[jj][0] = lo_f(hv.x) * ALPHA; V[jj][1] = hi_f(hv.x) * ALPHA; V[jj][2] = lo_f(hv.y) * ALPHA; V[jj][3] = hi_f(hv.y) * ALPHA; } \
                for (int k = 0; k < nslab; ++k) V[jj] += *(const f32x4*)(slab + (size_t)k * MS * 1024 + o); } } } while (0)
    f32x4 vn[4];
    LN_LOAD(vn, gw);
#pragma unroll 1
    for (int r = gw; r < MT; r += NGW) {
        f32x4 v[4]; float s = 0.f;
#pragma unroll
        for (int jj = 0; jj < 4; ++jj) v[jj] = vn[jj];
        LN_LOAD(vn, r + NGW);
#pragma unroll
        for (int jj = 0; jj < 4; ++jj) s += (v[jj][0] + v[jj][1]) + (v[jj][2] + v[jj][3]);
        const float mean = wave_sum(s) * (1.0f / 1024.0f); float s2 = 0.f;
#pragma unroll
        for (int jj = 0; jj < 4; ++jj) { v[jj] = v[jj] - mean; s2 += (v[jj][0] * v[jj][0] + v[jj][1] * v[jj][1]) + (v[jj][2] * v[jj][2] + v[jj][3] * v[jj][3]); }
        const float rstd = rsqrtf(wave_sum(s2) * (1.0f / 1024.0f) + LN_EPS);
#pragma unroll
        for (int jj = 0; jj < 4; ++jj) { const f32x4 o = v[jj] * rstd * gv[jj] + bv[jj];
            if (TO_BF16) { u32x2 w; w.x = pk2(o[0], o[1]); w.y = pk2(o[2], o[3]); *(u32x2*)((bf16*)dst + (size_t)r * 1024 + lane * 4 + 256 * jj) = w; }
            else *(f32x4*)((float*)dst + (size_t)r * 1024 + lane * 4 + 256 * jj) = o; }
    }
#undef LN_LOAD
}

#define XB_TMO      128
#define XB_XCNT(j)  (256  + 64 * (j))
#define XB_XSUB(j)  (1280 + 64 * (j))
#define XB_XGEN(j)  (2304 + 64 * (j))
#define XB_TOP      3328
#define XB_TOPGEN   3392
#define XCD_BAR_WORDS 3456
#define XB_SPIN_CAP (1u << 18)

__device__ __forceinline__ unsigned xb_ld(unsigned* p)              { return __hip_atomic_load(p, __ATOMIC_RELAXED, __HIP_MEMORY_SCOPE_AGENT); }
__device__ __forceinline__ unsigned xb_add(unsigned* p, unsigned v) { return __hip_atomic_fetch_add(p, v, __ATOMIC_RELAXED, __HIP_MEMORY_SCOPE_AGENT); }
__device__ __forceinline__ unsigned xb_xcc_id() { return (unsigned)__builtin_amdgcn_s_getreg((3 << 11) | 20) & 0xFu; }
#define XB_SPIN(cond, bar) do { unsigned _sp = 0; while (cond) { __builtin_amdgcn_s_sleep(1); \
    if ((++_sp & 255u) == 0u) { if (xb_ld(&(bar)[XB_TMO])) break; if (_sp > XB_SPIN_CAP) { atomicAdd(&(bar)[XB_TMO], 1u); break; } } } } while (0)

struct XcdBarrier {
    unsigned* bar; unsigned x;
    volatile LAS unsigned* st;
};

__device__ __forceinline__ XcdBarrier xcd_barrier_post(unsigned* bar, volatile LAS unsigned* st) {
    XcdBarrier b; b.bar = bar; b.x = xb_xcc_id(); b.st = st;
    if (threadIdx.x == 0) (void)xb_add(&bar[XB_XCNT(b.x)], 1u);
    return b;
}
__device__ __forceinline__ void xcd_barrier_complete(unsigned* bar, unsigned x, unsigned& nloc, unsigned& nx) {
    const unsigned G = gridDim.x * gridDim.y * gridDim.z;
    unsigned sum, cnt, mine, sp = 0u;
    for (;;) {
        sum = 0u; cnt = 0u; mine = 0u;
#pragma unroll
        for (unsigned j = 0; j < 16; ++j) { const unsigned c = xb_ld(&bar[XB_XCNT(j)]); sum += c; cnt += (c > 0u) ? 1u : 0u; mine = (j == x) ? c : mine; }
        if (sum == G) break;
        __builtin_amdgcn_s_sleep(1);
        if ((++sp & 255u) == 0u) { if (xb_ld(&bar[XB_TMO])) break; if (sp > XB_SPIN_CAP) { atomicAdd(&bar[XB_TMO], 1u); break; } }
    }
    nloc = mine > 0u ? mine : 1u; nx = cnt > 0u ? cnt : 1u;
}

__device__ __forceinline__ void xcd_barrier(const XcdBarrier& b) {
    asm volatile("s_waitcnt vmcnt(0)" ::: "memory");
    __syncthreads();
    if (threadIdx.x == 0) {
        unsigned* bar = b.bar;
        __builtin_amdgcn_s_waitcnt(0);
        unsigned nloc = b.st[0], nx = b.st[1];
        if (nloc == 0u) { xcd_barrier_complete(bar, b.x, nloc, nx); b.st[0] = nloc; b.st[1] = nx; }
        const unsigned old = xb_add(&bar[XB_XSUB(b.x)], 1u);
        const unsigned gen = old / nloc;
        if (old + 1u == (gen + 1u) * nloc) {
            __builtin_amdgcn_fence(__ATOMIC_RELEASE, "agent");
            asm volatile("s_waitcnt vmcnt(0)" ::: "memory");
            const unsigned og = xb_add(&bar[XB_TOP], 1u);
            const unsigned tg = og / nx;
            if (og + 1u == (tg + 1u) * nx) xb_add(&bar[XB_TOPGEN], 1u);
            else XB_SPIN(xb_ld(&bar[XB_TOPGEN]) == tg, bar);
            __builtin_amdgcn_fence(__ATOMIC_ACQUIRE, "agent");
            xb_add(&bar[XB_XGEN(b.x)], 1u);
            asm volatile("s_waitcnt vmcnt(0)" ::: "memory");
        } else {
            XB_SPIN(xb_ld(&bar[XB_XGEN(b.x)]) == gen, bar);
            __builtin_amdgcn_fence(__ATOMIC_ACQUIRE, "agent");
            asm volatile("s_waitcnt vmcnt(0)" ::: "memory");
        }
    }
    __syncthreads();
}

__global__ void __launch_bounds__(512, 2) hybrid_fwd(Params p) {
    extern __shared__ __attribute__((aligned(16))) unsigned char lds_raw[];
    LAS unsigned char* lds = (LAS unsigned char*)lds_raw;
    cg::grid_group grid = cg::this_grid();
    const int tid = threadIdx.x, lane = tid & 63, wave = __builtin_amdgcn_readfirstlane(tid >> 6);
    unsigned char* ws = p.ws;
    if (tid < 2) ((volatile LAS unsigned*)(lds + LDS_BYTES - 32))[tid] = 0u;
    __syncthreads();
    const XcdBarrier xbar = xcd_barrier_post((unsigned*)(ws + WS_CTL) + CW_BAR, (volatile LAS unsigned*)(lds + LDS_BYTES - 32));
#ifdef PROBE_A
    LAS unsigned long long* tsl = (LAS unsigned long long*)(lds + LDS_BYTES - 256);
    int tsn = 0;
#define STAMP() do { if (blockIdx.x == 0 && tid == 0) tsl[tsn] = __builtin_amdgcn_s_memrealtime(); ++tsn; } while (0)
#else
#define STAMP() do {} while (0)
#endif
    STAMP();
#ifndef PHASE_MASK
#define PHASE_MASK 0x7fff
#endif
#define IN(k) (((PHASE_MASK >> (k)) & 1) && p.ph_lo <= (k) && (k) < p.ph_hi)
    if (IN(0)) phase_prologue(p, lds, tid, wave, lane);
    grid.sync(); STAMP();
    if (IN(1)) {
        pg8::Gemm g{(const bf16*)(ws + WS_XB), (const bf16*)(ws + WS_WIN), MT, NIN, 1024}; pg8::StaticOrder S; S.init(MT, NIN, gridDim.x, blockIdx.x);
        pg8::EpiInProj E{(bf16*)(ws + WS_Z), (bf16*)(ws + WS_XBC), (bf16*)(ws + WS_Q), ws + WS_KALL, ws + WS_VALL, (bf16*)(ws + WS_QI), (bf16*)p.out, (bf16*)(ws + WS_KIALL),
                         (float*)(ws + WS_DT), (float*)(ws + WS_WI), p.out, p.in[11]};
        pg8::gemm_phase<pg8::EpiInProj, pg8::StaticOrder, true, true>(lds, g, S, E);
        phase_cache_cvt(p, lds, tid);
    }
    xcd_barrier(xbar); STAMP();
#ifdef IX_DUMMY
    if (IN(2)) phase_indexer<IX_DUMMY>(p, lds, tid, wave, lane);
    xcd_barrier(xbar);
#endif
    if (IN(2)) phase_indexer<0>(p, lds, tid, wave, lane);
    xcd_barrier(xbar); STAMP();
    if (IN(3)) phase_attn(p, lds, tid, wave, lane);
    xcd_barrier(xbar); STAMP();
    if (IN(4)) phase_conv(p, lds, tid);
    xcd_barrier(xbar); STAMP();
    if (IN(5)) phase_s1(p, wave, lane);
    xcd_barrier(xbar); STAMP();
    if (IN(6)) phase_s2(p, tid);
    xcd_barrier(xbar); STAMP();
    if (IN(7)) phase_s3(p, lds, wave, lane);
    xcd_barrier(xbar); STAMP();
    if (IN(8)) {
        pg8::Gemm g{(const bf16*)(ws + WS_Z), (const bf16*)(ws + WS_WSSD), MT, 1024, 2048}; pg8::SlicedOrder S; S.init(MP, MT, 1024, 2048, 256, gridDim.x, blockIdx.x);
        pg8::EpiMixA E{(const bf16*)p.out, (bf16*)(ws + WS_T), (float*)(ws + WS_R57)};
        pg8::gemm_phase<pg8::EpiMixA, pg8::SlicedOrder, true, true>(lds, g, S, E);
    }
    xcd_barrier(xbar); STAMP();
    if (IN(9)) {
        pg8::Gemm g{(const bf16*)(ws + WS_Q), (const bf16*)(ws + WS_WATT), MT, 1024, 1024}; pg8::SlicedOrder S; S.init(MP, MT, 1024, 1024, 256, gridDim.x, blockIdx.x);
        pg8::EpiMixB E{(const bf16*)p.out, (const bf16*)(ws + WS_T), (bf16*)(ws + WS_MIX), (float*)(ws + WS_R57) + (size_t)8 * MS * 1024};
        pg8::gemm_phase<pg8::EpiMixB, pg8::SlicedOrder, true, true>(lds, g, S, E);
    }
    xcd_barrier(xbar);
    if (IN(9)) {
        const float* SA = (const float*)(ws + WS_R57); const float* SB = SA + (size_t)8 * MS * 1024; const bf16* Gt = (const bf16*)p.out; bf16* MX = (bf16*)(ws + WS_MIX);
        for (int i = blockIdx.x * 512 + tid; i < MS * 256; i += gridDim.x * 512) { const int r = i >> 8, c = (i & 255) * 4; const size_t o = (size_t)r * 1024 + c;
            f32x4 a = *(const f32x4*)(SA + o), b = *(const f32x4*)(SB + o);
#pragma unroll
            for (int k = 1; k < 8; ++k) a += *(const f32x4*)(SA + (size_t)k * MS * 1024 + o);
#pragma unroll
            for (int k = 1; k < 4; ++k) b += *(const f32x4*)(SB + (size_t)k * MS * 1024 + o);
            const u32x2 g1 = *(const u32x2*)(Gt + (size_t)(MP + r) * 2048 + c), g2 = *(const u32x2*)(Gt + (size_t)(MP + r) * 2048 + 1024 + c);
            u32x2 w; w.x = pk2(a[0] * lo_f(g1.x) + b[0] * lo_f(g2.x), a[1] * hi_f(g1.x) + b[1] * hi_f(g2.x)); w.y = pk2(a[2] * lo_f(g1.y) + b[2] * lo_f(g2.y), a[3] * hi_f(g1.y) + b[3] * hi_f(g2.y));
            *(u32x2*)(MX + (size_t)(MP + r) * 1024 + c) = w; }
    }
    xcd_barrier(xbar); STAMP();
    if (IN(10)) {
        pg8::Gemm g{(const bf16*)(ws + WS_MIX), (const bf16*)(ws + WS_WOUT), MT, 1024, 1024}; pg8::SlicedOrder S; S.init(MP, MT, 1024, 1024, 256, gridDim.x, blockIdx.x);
        pg8::EpiResX E{p.in[0], p.in[1], (bf16*)(ws + WS_PRE1), (float*)(ws + WS_Z)};
        pg8::gemm_phase<pg8::EpiResX, pg8::SlicedOrder, true, true>(lds, g, S, E);
    }
    xcd_barrier(xbar); STAMP();
    if (IN(11)) phase_ln<true>((const bf16*)(ws + WS_PRE1), (void*)(ws + WS_H1), p.in[18], p.in[19], wave, lane, (const float*)(ws + WS_Z), 4, p.in[1], nullptr);
    xcd_barrier(xbar); STAMP();
    if (IN(12)) {
        pg8::Gemm g{(const bf16*)(ws + WS_H1), (const bf16*)(ws + WS_WUP), MT, 4096, 1024}; pg8::StaticOrder S; S.init(MT, 4096, gridDim.x, blockIdx.x);
        pg8::EpiSqRelu E{(bf16*)(ws + WS_HID)};
        pg8::gemm_phase<pg8::EpiSqRelu, pg8::StaticOrder, true, true>(lds, g, S, E);
    }
    xcd_barrier(xbar); STAMP();
    if (IN(13)) {
        pg8::Gemm g{(const bf16*)(ws + WS_HID), (const bf16*)(ws + WS_WDN), MT, 1024, 4096}; pg8::SlicedOrder S; S.init(MP, MT, 1024, 4096, 256, gridDim.x, blockIdx.x);
        pg8::EpiResH E{(const bf16*)(ws + WS_H1), (bf16*)(ws + WS_Q), (float*)(ws + WS_Z)};
        pg8::gemm_phase<pg8::EpiResH, pg8::SlicedOrder, true, true>(lds, g, S, E);
    }
    xcd_barrier(xbar); STAMP();
    if (IN(14)) phase_ln<false>((const bf16*)(ws + WS_Q), (void*)p.out, p.in[22], p.in[23], wave, lane, (const float*)(ws + WS_Z), 16, nullptr, (const bf16*)(ws + WS_H1));
    STAMP();
#ifdef IXT
    if (blockIdx.x == 0 && tid == 0) { const unsigned long long d = *(LAS unsigned long long*)(lds + LDS_BYTES - 8), t0 = __builtin_amdgcn_s_memrealtime();
        while (__builtin_amdgcn_s_memrealtime() - t0 < d) __builtin_amdgcn_s_sleep(8); }
#endif
#ifdef PROBE_A
    if (blockIdx.x == 0 && tid == 0) { const unsigned long long d = (tsl[PROBE_B] - tsl[PROBE_A]) * PROBE_MULT, t0 = __builtin_amdgcn_s_memrealtime();
        while (__builtin_amdgcn_s_memrealtime() - t0 < d) __builtin_amdgcn_s_sleep(8); }
#endif
#undef IN
}

extern "C" void kernel_launch(void* const* d_in, const int* in_sizes, int n_in, void* d_out, int out_size, void* d_ws, size_t ws_size, hipStream_t stream) {
    static int grid = 0;
    if (grid == 0) {
        int dev = 0, cus = 0, per_cu = 0;
        if (n_in != 24 || out_size != OUT_TOTAL || ws_size < WS_END) { fprintf(stderr, "kernel_launch: unexpected shapes (n_in %d out %d ws %zu, need %zu)\n", n_in, out_size, ws_size, (size_t)WS_END); grid = -1; return; }
        (void)hipGetDevice(&dev);
        (void)hipDeviceGetAttribute(&cus, hipDeviceAttributeMultiprocessorCount, dev);
        (void)hipFuncSetAttribute((const void*)hybrid_fwd, hipFuncAttributeMaxDynamicSharedMemorySize, LDS_BYTES);
        (void)hipOccupancyMaxActiveBlocksPerMultiprocessor(&per_cu, (const void*)hybrid_fwd, 512, LDS_BYTES);
        if (per_cu < 1) { fprintf(stderr, "kernel_launch: occupancy query says %d blocks per CU\n", per_cu); grid = -1; return; }
        grid = cus;
    }
    if (grid < 0) return;
    (void)hipMemsetAsync(d_ws, 0, 65536, stream);
    Params p{};
    for (int i = 0; i < 24; ++i) p.in[i] = (const float*)d_in[i];
    p.out = (float*)d_out; p.ws = (unsigned char*)d_ws; p.ph_lo = 0; p.ph_hi = 100;
    void* args[] = {&p};
    hipError_t e = hipLaunchCooperativeKernel((const void*)hybrid_fwd, dim3(grid), dim3(512), args, LDS_BYTES, stream);
    if (e != hipSuccess) fprintf(stderr, "cooperative launch failed: %s (grid %d)\n", hipGetErrorString(e), grid);
}
```
